# Optimizing an MI355X kernel written in HIP

```python
import math
import jax, jax.numpy as jnp
from jax import lax
import numpy as np

D_MODEL = 4096
BATCH = 2
SEQ = 8192
DEPTH = 4

HEAD_DIM = 128
N_HEADS = D_MODEL // HEAD_DIM
HEADS_NA = N_HEADS // 4
HEADS_DIL = 3 * N_HEADS // 8
HEADS_GQA = N_HEADS - HEADS_NA - HEADS_DIL
KV_HEADS_GQA = HEADS_GQA // 3
MIX_WIDTH = N_HEADS * HEAD_DIM
KV_WIDTH = (HEADS_NA + HEADS_DIL + KV_HEADS_GQA) * HEAD_DIM
D_FF = 4 * D_MODEL
GRID_W = 64
NA_ROWS = 8
NA_COLS = 16
DIL_PATTERNS = ((128, 1), (512, 4), (2048, 16))
T5_BUCKETS = 32
T5_MAX_DIST = 1024
ROPE_THETA = 10000.0
QUERY_BLOCK = 128
N_MOD = 6
EPS = 1e-6
NEG_INF = -1e30
ATTN_SCALE = HEAD_DIM ** -0.5

kernel_name = "hybrid_parallel_heads_bidir_encoder"


def rms_norm(x, g):
    xf = x.astype(jnp.float32)
    y = xf * lax.rsqrt(jnp.mean(xf * xf, axis=-1, keepdims=True) + EPS)
    return (y * g.astype(jnp.float32)).astype(x.dtype)


def modulate(h, shift, scale):
    return h * (1.0 + scale[:, None, :]) + shift[:, None, :]


def t5_bucket(rel):
    nb = T5_BUCKETS // 2
    max_exact = nb // 2
    ret = jnp.where(rel > 0, nb, 0)
    n = jnp.abs(rel)
    nf = jnp.maximum(n, 1).astype(jnp.float32)
    large = max_exact + (jnp.log(nf / max_exact) / math.log(T5_MAX_DIST / max_exact)
                         * (nb - max_exact)).astype(jnp.int32)
    large = jnp.minimum(large, nb - 1)
    return ret + jnp.where(n < max_exact, n, large)


def axial_rope(x):
    S = x.shape[1]
    t = jnp.arange(S)
    half = HEAD_DIM // 2
    inv = jnp.exp(-math.log(ROPE_THETA) * jnp.arange(0, half, 2, dtype=jnp.float32) / half)

    def rot(xa, pos):
        ang = pos.astype(jnp.float32)[:, None] * inv[None, :]
        cos = jnp.cos(ang)[None, :, None, :]
        sin = jnp.sin(ang)[None, :, None, :]
        x1, x2 = jnp.split(xa.astype(jnp.float32), 2, axis=-1)
        return jnp.concatenate([x1 * cos - x2 * sin, x1 * sin + x2 * cos], axis=-1)

    out = jnp.concatenate([rot(x[..., :half], t // GRID_W), rot(x[..., half:], t % GRID_W)], axis=-1)
    return out.astype(x.dtype)


def neighborhood_attention(q, k, v, rpb):
    Bn, H, S, hd = q.shape
    rows = S // GRID_W
    kr = min(NA_ROWS, rows)
    qg = q.reshape(Bn, H, rows, GRID_W, hd)
    kg = k.reshape(Bn, H, rows, GRID_W, hd)
    vg = v.reshape(Bn, H, rows, GRID_W, hd)
    col = jnp.arange(GRID_W)
    cs = jnp.clip(col - NA_COLS // 2, 0, GRID_W - NA_COLS)
    cidx = cs[:, None] + jnp.arange(NA_COLS)[None, :]
    coff = cidx - col[:, None] + NA_COLS - 1

    def row_fn(args):
        q_row, r = args
        rs = jnp.clip(r - kr // 2, 0, rows - kr)
        k_rows = lax.dynamic_slice_in_dim(kg, rs, kr, axis=2)
        v_rows = lax.dynamic_slice_in_dim(vg, rs, kr, axis=2)
        k_nb = k_rows[:, :, :, cidx, :]
        v_nb = v_rows[:, :, :, cidx, :]
        roff = rs + jnp.arange(kr) - r + NA_ROWS - 1
        bias = rpb[:, roff[None, :, None], coff[:, None, :]]
        s = jnp.einsum('bhqd,bhrqcd->bhqrc', q_row, k_nb).astype(jnp.float32) + bias.astype(jnp.float32)
        p = jax.nn.softmax(s.reshape(Bn, H, GRID_W, kr * NA_COLS), axis=-1).reshape(s.shape)
        return jnp.einsum('bhqrc,bhrqcd->bhqd', p.astype(v.dtype), v_nb)

    o = lax.map(row_fn, (qg.transpose(2, 0, 1, 3, 4), jnp.arange(rows)))
    return o.transpose(1, 2, 0, 3, 4).reshape(Bn, H, S, hd)


def dilated_window_attention(q, k, v, t5_table, d, half):
    Bn, H, S, hd = q.shape
    L = S // d
    qb = math.gcd(L, QUERY_BLOCK)
    nb = L // qb
    win = qb + 2 * half

    def regroup(a):
        return a.reshape(Bn, H, L, d, hd).transpose(0, 1, 3, 2, 4)

    qr = regroup(q).reshape(Bn, H, d, nb, qb, hd)
    pad_cfg = ((0, 0), (0, 0), (0, 0), (half, half), (0, 0))
    kp = jnp.pad(regroup(k), pad_cfg)
    vp = jnp.pad(regroup(v), pad_cfg)
    idx = (jnp.arange(nb) * qb)[:, None] + jnp.arange(win)[None, :]
    kw = kp[:, :, :, idx, :]
    vw = vp[:, :, :, idx, :]
    j = jnp.arange(win)[None, :] - half - jnp.arange(qb)[:, None]
    key_pos = idx - half
    valid = ((jnp.abs(j) <= half)[None]
             & (key_pos >= 0)[:, None, :] & (key_pos < L)[:, None, :])
    bias = t5_table[t5_bucket(j * d)].transpose(2, 0, 1).astype(jnp.float32)
    s = jnp.einsum('bhrnqd,bhrnkd->bhrnqk', qr, kw).astype(jnp.float32) + bias[None, :, None, None]
    s = jnp.where(valid[None, None, None], s, NEG_INF)
    m = jnp.max(s, axis=-1, keepdims=True)
    p = jnp.exp(s - m)
    den = jnp.sum(p, axis=-1, keepdims=True)
    o = jnp.einsum('bhrnqk,bhrnkd->bhrnqd', p, vw.astype(jnp.float32)) / den
    lse = (m + jnp.log(den))[..., 0]
    o = o.reshape(Bn, H, d, L, hd).transpose(0, 1, 3, 2, 4).reshape(Bn, H, S, hd)
    lse = lse.reshape(Bn, H, d, L).transpose(0, 1, 3, 2).reshape(Bn, H, S)
    return o, lse


def dilated_mixture_attention(q, k, v, t5_table):
    outs, lses = [], []
    for window, d in DIL_PATTERNS:
        o, lse = dilated_window_attention(q, k, v, t5_table, d, window // (2 * d))
        outs.append(o)
        lses.append(lse)
    w = jax.nn.softmax(jnp.stack(lses, axis=0), axis=0)
    return jnp.sum(w[..., None] * jnp.stack(outs, axis=0), axis=0)


def gqa_attention(q, k, v):
    Bn, H, S, hd = q.shape
    kvh = k.shape[1]
    grp = H // kvh
    nblk = S // QUERY_BLOCK
    qblocks = q.reshape(Bn, kvh, grp, nblk, QUERY_BLOCK, hd).transpose(3, 0, 1, 2, 4, 5)

    def block(q_blk):
        s = jnp.einsum('bkgqd,bksd->bkgqs', q_blk, k).astype(jnp.float32)
        p = jax.nn.softmax(s, axis=-1)
        return jnp.einsum('bkgqs,bksd->bkgqd', p.astype(v.dtype), v)

    o = lax.map(block, qblocks)
    return o.transpose(1, 2, 3, 0, 4, 5).reshape(Bn, H, S, hd)


def token_mixer(h, w_in, w_out, q_gain, k_gain, na_rpb, t5_table):
    Bn, S, _ = h.shape
    qkv = h @ w_in
    q, k, v = jnp.split(qkv, [MIX_WIDTH, MIX_WIDTH + KV_WIDTH], axis=-1)
    cut = [HEADS_NA * HEAD_DIM, (HEADS_NA + HEADS_DIL) * HEAD_DIM]
    q_na, q_dil, q_gqa = jnp.split(q, cut, axis=-1)
    k_na, k_dil, k_gqa = jnp.split(k, cut, axis=-1)
    v_na, v_dil, v_gqa = jnp.split(v, cut, axis=-1)

    def heads(a):
        return a.reshape(Bn, S, -1, HEAD_DIM).transpose(0, 2, 1, 3)

    o_na = neighborhood_attention(heads(q_na * ATTN_SCALE), heads(k_na), heads(v_na), na_rpb)
    o_dil = dilated_mixture_attention(heads(q_dil * ATTN_SCALE), heads(k_dil), heads(v_dil), t5_table)
    qg = axial_rope(rms_norm(q_gqa.reshape(Bn, S, HEADS_GQA, HEAD_DIM), q_gain)) * ATTN_SCALE
    kg = axial_rope(rms_norm(k_gqa.reshape(Bn, S, KV_HEADS_GQA, HEAD_DIM), k_gain))
    o_gqa = gqa_attention(qg.transpose(0, 2, 1, 3), kg.transpose(0, 2, 1, 3), heads(v_gqa))

    def merge(o):
        return o.transpose(0, 2, 1, 3).reshape(Bn, S, -1).astype(h.dtype)

    o = jnp.concatenate([merge(o_na), merge(o_dil), merge(o_gqa)], axis=-1)
    return o @ w_out


def squared_relu_mlp(h, w1, w2):
    return jnp.square(jax.nn.relu(h @ w1)) @ w2


def setup_inputs(seed: int = 0) -> dict:
    key = jax.random.key(seed)
    ks = jax.random.split(key, 14)
    f32 = jnp.float32
    nrm = jax.random.normal
    x = nrm(ks[0], (BATCH, SEQ, D_MODEL), f32)
    c = nrm(ks[1], (BATCH, D_MODEL), f32)
    ada_w = nrm(ks[2], (D_MODEL, N_MOD * D_MODEL), f32) * D_MODEL ** -0.5
    ada_b = 0.01 * nrm(ks[3], (N_MOD * D_MODEL,), f32)
    ada_layer_emb = 0.1 * nrm(ks[4], (DEPTH, N_MOD, D_MODEL), f32)
    norm_gains = 1.0 + 0.05 * nrm(ks[5], (DEPTH, 4, D_MODEL), f32)
    w_in = nrm(ks[6], (DEPTH, D_MODEL, MIX_WIDTH + 2 * KV_WIDTH), f32) * D_MODEL ** -0.5
    w_out = nrm(ks[7], (DEPTH, MIX_WIDTH, D_MODEL), f32) * MIX_WIDTH ** -0.5
    q_gain = 1.0 + 0.05 * nrm(ks[8], (DEPTH, HEAD_DIM), f32)
    k_gain = 1.0 + 0.05 * nrm(ks[9], (DEPTH, HEAD_DIM), f32)
    na_rpb = 0.2 * nrm(ks[10], (DEPTH, HEADS_NA, 2 * NA_ROWS - 1, 2 * NA_COLS - 1), f32)
    t5_table = 0.2 * nrm(ks[11], (T5_BUCKETS, HEADS_DIL), f32)
    w_mlp_in = nrm(ks[12], (DEPTH, D_MODEL, D_FF), f32) * D_MODEL ** -0.5
    w_mlp_out = nrm(ks[13], (DEPTH, D_FF, D_MODEL), f32) * D_FF ** -0.5
    return {"x": x, "c": c, "ada_w": ada_w, "ada_b": ada_b, "ada_layer_emb": ada_layer_emb,
            "norm_gains": norm_gains, "w_in": w_in, "w_out": w_out, "q_gain": q_gain,
            "k_gain": k_gain, "na_rpb": na_rpb, "t5_table": t5_table,
            "w_mlp_in": w_mlp_in, "w_mlp_out": w_mlp_out}


def reference(x, c, ada_w, ada_b, ada_layer_emb, norm_gains, w_in, w_out, q_gain, k_gain,
              na_rpb, t5_table, w_mlp_in, w_mlp_out):
    mod = (jax.nn.silu(c) @ ada_w + ada_b).reshape(c.shape[0], N_MOD, D_MODEL)
    for l in range(DEPTH):
        m = mod + ada_layer_emb[l][None]
        sh1, sc1, g1, sh2, sc2, g2 = m[:, 0], m[:, 1], m[:, 2], m[:, 3], m[:, 4], m[:, 5]
        h = modulate(rms_norm(x, norm_gains[l, 0]), sh1, sc1)
        y = token_mixer(h, w_in[l], w_out[l], q_gain[l], k_gain[l], na_rpb[l], t5_table)
        x = x + g1[:, None, :] * rms_norm(y, norm_gains[l, 1])
        h = modulate(rms_norm(x, norm_gains[l, 2]), sh2, sc2)
        y = squared_relu_mlp(h, w_mlp_in[l], w_mlp_out[l])
        x = x + g2[:, None, :] * rms_norm(y, norm_gains[l, 3])
    return x
```

```cpp
#include <hip/hip_runtime.h>
#include <cstdio>
#include <cstdint>
namespace pg8 {
#define PG8_LAS __attribute__((address_space(3)))
typedef unsigned short bf16_t;
typedef short bf16x8 __attribute__((ext_vector_type(8)));
typedef float f32x4 __attribute__((ext_vector_type(4)));
typedef unsigned u32x4 __attribute__((ext_vector_type(4)));
constexpr int BM = 256, BK = 64, HALF = 128, HTB = HALF * BK * 2  , STAGE_BYTES = 8 * HTB, NXCD = 8, WGM = 8;

__host__ __device__ __forceinline__ int lds_byte(int r, int c) { const int st = (r >> 4) * 2 + (c >> 5), rr = r & 15, cc = c & 31, ob = rr * 64 + cc * 2; return st * 1024 + (ob ^ (((ob >> 9) & 1) << 5)); }
__host__ __device__ __forceinline__ void stage_rc(int b, int& R, int& C) { const int st = b / 1024, sb = b % 1024, swz = sb ^ (((sb >> 9) & 1) << 5); R = (st >> 1) * 16 + swz / 64; C = (st & 1) * 32 + (swz % 64) / 2; }
__host__ __device__ __forceinline__ int perm32(int rho) { const int n = rho >> 4, i = rho & 15; return 8 * (i >> 2) + 4 * n + (i & 3); }

struct Unit { int pm, pn; };
struct Gemm { const bf16_t* A; const bf16_t* Bt; int M, N, K; };

struct StaticOrder {
    int nM, nN, nwg, G, c;
    __host__ __device__ void init(int M, int N, int G_, int c_) { nM = M / BM; nN = N / BM; nwg = nM * nN; G = G_; c = c_; }
    __host__ __device__ bool next(int i, Unit& u) const {
        const long L = (long)i * G + c; if (L >= nwg) return false;
        int wgid = (int)L; { const int q = nwg / NXCD, r = nwg % NXCD, xcd = wgid % NXCD, off = wgid / NXCD; wgid = (xcd < r ? xcd * (q + 1) : r * (q + 1) + (xcd - r) * q) + off; }
        const int nig = WGM * nN, gid = wgid / nig, fm = gid * WGM, gsz = (nM - fm) < WGM ? (nM - fm) : WGM;
        u.pm = fm + ((wgid % nig) % gsz); u.pn = (wgid % nig) / gsz; return true;
    }
    __device__ __forceinline__ void a_ready(const Unit&) const {}
    __device__ __forceinline__ void done(const Unit&) const {}
};

__device__ __forceinline__ unsigned cvt_pk_bf16(float lo, float hi) { unsigned r; asm volatile("v_cvt_pk_bf16_f32 %0, %1, %2" : "=v"(r) : "v"(lo), "v"(hi)); return r; }
typedef float f32x2 __attribute__((ext_vector_type(2)));
struct EpiF32 {
    static constexpr bool PERM = false, AFTER_DRAIN = false;
    float* C; int ldc;
    __device__ __forceinline__ void operator()(const f32x4 (&acc)[2][2][4][2], const Unit& u, int wr, int wc, int fr, int fq) const {
        const int row0 = u.pm * BM + wr * 64 + fr, col0 = u.pn * BM + wc * 32 + 4 * fq;
#pragma unroll
        for (int ai = 0; ai < 2; ++ai)
#pragma unroll
            for (int m = 0; m < 4; ++m) { float* rowp = C + (size_t)(row0 + ai * HALF + m * 16) * ldc + col0;
#pragma unroll
                for (int bj = 0; bj < 2; ++bj)
#pragma unroll
                    for (int n = 0; n < 2; ++n) *(f32x4*)(rowp + bj * HALF + n * 16) = acc[ai][bj][m][n]; }
    }
};
template <int ACT  > struct EpiBf16 {
    static constexpr bool PERM = true, AFTER_DRAIN = false;
    bf16_t* O; int ldc;
    __device__ __forceinline__ void operator()(const f32x4 (&acc)[2][2][4][2], const Unit& u, int wr, int wc, int fr, int fq) const {
        const int row0 = u.pm * BM + wr * 64 + fr; const int col0 = u.pn * BM + wc * 32 + 8 * fq;
#pragma unroll
        for (int ai = 0; ai < 2; ++ai)
#pragma unroll
            for (int m = 0; m < 4; ++m) { bf16_t* rowp = O + (size_t)(row0 + ai * HALF + m * 16) * ldc + col0;
#pragma unroll
                for (int bj = 0; bj < 2; ++bj) { f32x4 v0 = acc[ai][bj][m][0], v1 = acc[ai][bj][m][1];
                    if (ACT == 3) {
#pragma unroll
                        for (int j = 0; j < 4; ++j) { const float a = fmaxf(v0[j], 0.f), b = fmaxf(v1[j], 0.f); v0[j] = a * a; v1[j] = b * b; } }
                    u32x4 w; w.x = cvt_pk_bf16(v0[0], v0[1]); w.y = cvt_pk_bf16(v0[2], v0[3]); w.z = cvt_pk_bf16(v1[0], v1[1]); w.w = cvt_pk_bf16(v1[2], v1[3]);
                    *(u32x4*)(rowp + bj * HALF) = w; } }
    }
};
template <class Epi, class Sched, bool ALIGN_EPI = false, bool SP2 = false>
__device__ __forceinline__ void gemm_phase(PG8_LAS unsigned char* lds, const Gemm g, const Sched& S, const Epi& E) {
    int tid_ = threadIdx.x; asm volatile("" : "+v"(tid_));
    const int tid = tid_, wid = __builtin_amdgcn_readfirstlane(tid >> 6), lane = tid & 63, wr = wid >> 2, wc = wid & 3, fr = lane & 15, fq = lane >> 4;
    const int K = g.K, nt = K / BK;
    unsigned voffA[2], voffB[2];
#pragma unroll
    for (int i = 0; i < 2; ++i) { int R, C; stage_rc(tid * 16 + i * 8192, R, C); const int Rb = Epi::PERM ? ((R & ~31) + perm32(R & 31)) : R;
        voffA[i] = (unsigned)(R * K + C) * 2u; voffB[i] = (unsigned)(Rb * K + C) * 2u; }
    const size_t kstep = (size_t)(BK * 2);
    const size_t hstep = (size_t)HALF * K * 2;
    const size_t tstep = 2 * hstep;
    const unsigned ldsw = (unsigned)wid * 1024u;
    const int aoff = lds_byte(wr * 64 + fr, fq * 8), boff = lds_byte(wc * 32 + fr, fq * 8);
#define PG8_SA(b, h) (((b) * 2 + (h)) * HTB)
#define PG8_SB(b, h) ((4 + (b) * 2 + (h)) * HTB)
#define PG8_STAGE(bufoff, gbase, voff) do { _Pragma("unroll") for (int _i = 0; _i < 2; ++_i) \
        __builtin_amdgcn_global_load_lds((const unsigned*)((const char*)(gbase) + (voff)[_i]), (PG8_LAS unsigned*)(lds + (bufoff) + ldsw + _i * 8192), 16, 0, 0); } while (0)
#define PG8_LDA(dst, b, h) do { _Pragma("unroll") for (int m = 0; m < 4; ++m) _Pragma("unroll") for (int k = 0; k < 2; ++k) dst[m][k] = *(const PG8_LAS bf16x8*)(lds + PG8_SA(b, h) + aoff + m * 2048 + k * 1024); } while (0)
#define PG8_LDB(dst, b, h) do { _Pragma("unroll") for (int n = 0; n < 2; ++n) _Pragma("unroll") for (int k = 0; k < 2; ++k) dst[n][k] = *(const PG8_LAS bf16x8*)(lds + PG8_SB(b, h) + boff + n * 2048 + k * 1024); } while (0)
#define PG8_MMA(ai, bj, At, Bt) do { __builtin_amdgcn_s_setprio(1); _Pragma("unroll") for (int m = 0; m < 4; ++m) _Pragma("unroll") for (int n = 0; n < 2; ++n) _Pragma("unroll") for (int k = 0; k < 2; ++k) \
        acc[ai][bj][m][n] = __builtin_amdgcn_mfma_f32_16x16x32_bf16(Bt[n][k], At[m][k], acc[ai][bj][m][n], 0, 0, 0); __builtin_amdgcn_s_setprio(0); } while (0)
#define PG8_WAIT_V(n) asm volatile("s_waitcnt vmcnt(" #n ")" ::: "memory")
#define PG8_WAIT_L(n) asm volatile("s_waitcnt lgkmcnt(" #n ")" ::: "memory")
#define PG8_BAR __builtin_amdgcn_s_barrier()
#define PG8_SCHED __builtin_amdgcn_sched_barrier(0)
    Unit cur, nxt; int ui = 0;
    if (!S.next(0, cur)) return;
    f32x4 acc[2][2][4][2];
#pragma unroll
    for (int a = 0; a < 2; ++a)
#pragma unroll
        for (int b = 0; b < 2; ++b)
#pragma unroll
            for (int m = 0; m < 4; ++m)
#pragma unroll
                for (int n = 0; n < 2; ++n) acc[a][b][m][n] = (f32x4){0.f, 0.f, 0.f, 0.f};
    bf16x8 At[4][2], B0[2][2], B1[2][2];
    const char* cA = (const char*)g.A + (size_t)cur.pm * tstep; const char* cB = (const char*)g.Bt + (size_t)cur.pn * tstep;
    S.a_ready(cur);
    if constexpr (SP2) {
        PG8_STAGE(PG8_SB(0, 0), cB, voffB); PG8_STAGE(PG8_SB(0, 1), cB + hstep, voffB); PG8_STAGE(PG8_SA(0, 0), cA, voffA); PG8_STAGE(PG8_SA(0, 1), cA + hstep, voffA);
        if (wr == 1) PG8_BAR;
        PG8_WAIT_V(2); PG8_BAR;
        PG8_STAGE(PG8_SB(1, 0), cB + kstep, voffB); PG8_STAGE(PG8_SA(1, 0), cA + kstep, voffA); PG8_STAGE(PG8_SB(1, 1), cB + hstep + kstep, voffB);
        PG8_WAIT_V(6); PG8_BAR;
    } else {
        PG8_STAGE(PG8_SB(0, 0), cB, voffB); PG8_STAGE(PG8_SA(0, 0), cA, voffA); PG8_STAGE(PG8_SB(0, 1), cB + hstep, voffB); PG8_STAGE(PG8_SA(0, 1), cA + hstep, voffA);
        if (wr == 1) PG8_BAR;
        PG8_WAIT_V(4); PG8_BAR;
        PG8_STAGE(PG8_SB(1, 0), cB + kstep, voffB); PG8_STAGE(PG8_SA(1, 0), cA + kstep, voffA); PG8_STAGE(PG8_SB(1, 1), cB + hstep + kstep, voffB);
        PG8_WAIT_V(6); PG8_BAR;
    }
    for (;;) {
        const bool has_next = S.next(ui + 1, nxt);
        const char* nA = has_next ? (const char*)g.A + (size_t)nxt.pm * tstep : cA; const char* nB = has_next ? (const char*)g.Bt + (size_t)nxt.pn * tstep : cB;
        for (int t = 0; t < nt; t += 2) {
            const bool last = (t == nt - 2);
            const char* a1 = cA + (size_t)(t + 1) * kstep;
            const char* a2 = last ? nA : cA + (size_t)(t + 2) * kstep; const char* b2 = last ? nB : cB + (size_t)(t + 2) * kstep;
            const char* a3 = a2 + kstep; const char* b3 = b2 + kstep;
            if (last && has_next) S.a_ready(nxt);
            if constexpr (SP2) {
            PG8_LDB(B0, 0, 0); PG8_LDB(B1, 0, 1); PG8_SCHED; PG8_LDA(At, 0, 0); PG8_STAGE(PG8_SA(1, 1), a1 + hstep, voffA);
            PG8_WAIT_V(8); PG8_WAIT_L(0); PG8_BAR; PG8_MMA(0, 0, At, B0); PG8_MMA(0, 1, At, B1); PG8_BAR; PG8_SCHED;
            PG8_LDA(At, 0, 1); PG8_STAGE(PG8_SB(0, 0), b2, voffB); PG8_STAGE(PG8_SB(0, 1), b2 + hstep, voffB); PG8_STAGE(PG8_SA(0, 0), a2, voffA);
            PG8_WAIT_V(8); PG8_WAIT_L(0); PG8_BAR; PG8_MMA(1, 0, At, B0); PG8_MMA(1, 1, At, B1); PG8_BAR; PG8_SCHED;
            PG8_LDB(B0, 1, 0); PG8_LDB(B1, 1, 1); PG8_SCHED; PG8_LDA(At, 1, 0); PG8_STAGE(PG8_SA(0, 1), a2 + hstep, voffA);
            PG8_WAIT_V(8); PG8_WAIT_L(0); PG8_BAR; PG8_MMA(0, 0, At, B0); PG8_MMA(0, 1, At, B1); PG8_BAR; PG8_SCHED;
            PG8_LDA(At, 1, 1); PG8_STAGE(PG8_SB(1, 0), b3, voffB); PG8_STAGE(PG8_SB(1, 1), b3 + hstep, voffB); PG8_STAGE(PG8_SA(1, 0), a3, voffA);
            PG8_WAIT_V(8); PG8_WAIT_L(0); PG8_BAR; PG8_MMA(1, 0, At, B0); PG8_MMA(1, 1, At, B1); PG8_BAR; PG8_SCHED;
            } else {
            PG8_LDB(B0, 0, 0); PG8_SCHED; PG8_LDA(At, 0, 0); PG8_STAGE(PG8_SA(1, 1), a1 + hstep, voffA);
            PG8_WAIT_L(8); PG8_BAR; PG8_WAIT_L(0); PG8_MMA(0, 0, At, B0); PG8_BAR; PG8_SCHED;
            PG8_LDB(B1, 0, 1); PG8_STAGE(PG8_SB(0, 0), b2, voffB);
            PG8_BAR; PG8_WAIT_L(0); PG8_MMA(0, 1, At, B1); PG8_BAR;
            PG8_LDA(At, 0, 1); PG8_STAGE(PG8_SA(0, 0), a2, voffA);
            PG8_BAR; PG8_WAIT_L(0); PG8_MMA(1, 0, At, B0); PG8_BAR; PG8_SCHED;
            PG8_STAGE(PG8_SB(0, 1), b2 + hstep, voffB);
            PG8_WAIT_V(6); PG8_BAR; PG8_MMA(1, 1, At, B1); PG8_BAR;
            PG8_LDB(B0, 1, 0); PG8_SCHED; PG8_LDA(At, 1, 0); PG8_STAGE(PG8_SA(0, 1), a2 + hstep, voffA);
            PG8_WAIT_L(8); PG8_BAR; PG8_WAIT_L(0); PG8_MMA(0, 0, At, B0); PG8_BAR; PG8_SCHED;
            PG8_LDB(B1, 1, 1); PG8_STAGE(PG8_SB(1, 0), b3, voffB);
            PG8_BAR; PG8_WAIT_L(0); PG8_MMA(0, 1, At, B1); PG8_BAR;
            PG8_LDA(At, 1, 1); PG8_STAGE(PG8_SA(1, 0), a3, voffA);
            PG8_BAR; PG8_WAIT_L(0); PG8_MMA(1, 0, At, B0); PG8_BAR; PG8_SCHED;
            PG8_STAGE(PG8_SB(1, 1), b3 + hstep, voffB);
            PG8_WAIT_V(6); PG8_BAR; PG8_MMA(1, 1, At, B1); PG8_BAR;
            }
        }
        if constexpr (ALIGN_EPI) { if (wr == 0) PG8_BAR; }
        if constexpr (!Epi::AFTER_DRAIN) { E(acc, cur, wr, wc, fr, fq); S.done(cur); }
        if (!has_next) break;
#pragma unroll
        for (int a = 0; a < 2; ++a)
#pragma unroll
            for (int b = 0; b < 2; ++b)
#pragma unroll
                for (int m = 0; m < 4; ++m)
#pragma unroll
                    for (int n = 0; n < 2; ++n) acc[a][b][m][n] = (f32x4){0.f, 0.f, 0.f, 0.f};
        cur = nxt; cA = nA; cB = nB; ++ui;
        if constexpr (ALIGN_EPI) { if (wr == 1) PG8_BAR; }
    }
    PG8_WAIT_V(0);
    if constexpr (!ALIGN_EPI) { if (wr == 0) PG8_BAR; }
    PG8_BAR;
    if constexpr (Epi::AFTER_DRAIN) { E.fused(acc, cur, wr, wc, fr, fq, lds, wid, lane); S.done(cur); }
#undef PG8_SA
#undef PG8_SB
#undef PG8_STAGE
#undef PG8_LDA
#undef PG8_LDB
#undef PG8_MMA
#undef PG8_WAIT_V
#undef PG8_WAIT_L
#undef PG8_BAR
#undef PG8_SCHED
}
}
namespace att {
typedef unsigned short bf16;
using bf16x8 = __attribute__((ext_vector_type(8))) short;
using s16x4  = __attribute__((ext_vector_type(4))) short;
using f32x16 = __attribute__((ext_vector_type(16))) float;
using u32x4  = __attribute__((ext_vector_type(4))) unsigned;
constexpr int   D = 128, NW = 8, QBLK = 32, KVBLK = 64;
constexpr float SCALE = 0.088388347648318440f;
constexpr float LOG2E = 1.4426950408889634f;
constexpr float C2 = SCALE * LOG2E;
constexpr float THR = 8.f;
constexpr int SHM_V = KVBLK * D * 2, SHM_K = KVBLK * D * 2;
constexpr int LDS_WS = 2 * SHM_V + 2 * SHM_K, LDS_TB = LDS_WS + NW * 64 * 4, LDS_ATT_BYTES = LDS_TB + 4096;
#define KSWZ(row, colB) ((row) * 256 + ((colB) ^ (((row) & 7) << 4)))
#define SBAR() __builtin_amdgcn_sched_barrier(0)
__device__ __forceinline__ int crow(int r, int hi) { return (r & 3) + 8 * (r >> 2) + 4 * hi; }
__device__ __forceinline__ unsigned cvtpk(float lo, float hi) { unsigned r; asm volatile("v_cvt_pk_bf16_f32 %0, %1, %2" : "=v"(r) : "v"(lo), "v"(hi)); return r; }
__device__ __forceinline__ bf16x8 ld8(const bf16* p) { return *reinterpret_cast<const bf16x8*>(p); }

struct MaskCtx { int a, v, d; const float* tbl; };
constexpr int TB_ORG = 256;

__device__ __forceinline__ void partialSM(f32x16& p0, f32x16& p1, float& m_reg, float& mn, float& alpha) {
  float pmax = p0[0];
#pragma unroll
  for (int r = 1; r < 16; ++r) pmax = fmaxf(pmax, p0[r]);
#pragma unroll
  for (int r = 0; r < 16; ++r) pmax = fmaxf(pmax, p1[r]);
  { auto rr = __builtin_amdgcn_permlane32_swap(__float_as_uint(pmax), __float_as_uint(pmax), false, false);
    pmax = fmaxf(__uint_as_float(rr[0]), __uint_as_float(rr[1])); }
  if (__builtin_expect(__all(pmax - m_reg <= THR / SCALE), 1)) { mn = m_reg; alpha = 1.f; }
  else { mn = fmaxf(m_reg, pmax); alpha = __builtin_amdgcn_exp2f((m_reg - mn) * C2); m_reg = mn; }
  float mnC = -mn * C2;
#pragma unroll
  for (int r = 0; r < 16; ++r) p0[r] = fmaf(p0[r], C2, mnC);
#pragma unroll
  for (int r = 0; r < 16; ++r) p1[r] = fmaf(p1[r], C2, mnC);
#pragma unroll
  for (int r = 0; r < 16; ++r) p0[r] = __builtin_amdgcn_exp2f(p0[r]);
}
template <int KIND>
__device__ __forceinline__ void partialSM_m(f32x16& p0, f32x16& p1, float& m_reg, float& mn, float& alpha, int jt, const MaskCtx& mc) {
  if (KIND == 1) {
    const bool rowok = (unsigned)(jt - min(max(mc.a - 4, 0), 120)) <= 7u;
    const float* tp = mc.tbl + (jt - mc.a + 7) * 31;
#pragma unroll
    for (int r = 0; r < 16; ++r) { const int kc = (r & 3) + 8 * (r >> 2);
      { const bool ok = rowok && (unsigned)(kc - mc.v) <= 15u; const float bb = tp[kc]; p0[r] = ok ? fmaf(p0[r], C2, bb) : -1e30f; }
      { const bool ok = rowok && (unsigned)(kc + 32 - mc.v) <= 15u; const float bb = tp[kc + 32]; p1[r] = ok ? fmaf(p1[r], C2, bb) : -1e30f; } }
  } else {
    const bool tok = (unsigned)jt < (unsigned)mc.d;
    const float* tp = mc.tbl + jt * 64; const int db = jt * 64 + mc.v;
#pragma unroll
    for (int r = 0; r < 16; ++r) { const int kc = (r & 3) + 8 * (r >> 2);
      { const bool ok = tok && (unsigned)(db + kc) <= 128u; const float bb = tp[kc]; p0[r] = ok ? fmaf(p0[r], C2, bb) : -1e30f; }
      { const bool ok = tok && (unsigned)(db + kc + 32) <= 128u; const float bb = tp[kc + 32]; p1[r] = ok ? fmaf(p1[r], C2, bb) : -1e30f; } }
  }
  float pmax = p0[0];
#pragma unroll
  for (int r = 1; r < 16; ++r) pmax = fmaxf(pmax, p0[r]);
#pragma unroll
  for (int r = 0; r < 16; ++r) pmax = fmaxf(pmax, p1[r]);
  { auto rr = __builtin_amdgcn_permlane32_swap(__float_as_uint(pmax), __float_as_uint(pmax), false, false);
    pmax = fmaxf(__uint_as_float(rr[0]), __uint_as_float(rr[1])); }
  if (__builtin_expect(__all(pmax - m_reg <= THR * LOG2E), 1)) { mn = m_reg; alpha = 1.f; }
  else { mn = fmaxf(m_reg, pmax); alpha = __builtin_amdgcn_exp2f(m_reg - mn); m_reg = mn; }
#pragma unroll
  for (int r = 0; r < 16; ++r) p0[r] -= mn;
#pragma unroll
  for (int r = 0; r < 16; ++r) p1[r] -= mn;
#pragma unroll
  for (int r = 0; r < 16; ++r) p0[r] = __builtin_amdgcn_exp2f(p0[r]);
}
__device__ __forceinline__ void finishSM(f32x16& p0, f32x16& p1, float alpha, float& l_reg, bf16x8& pa0, bf16x8& pa1, bf16x8& pa2, bf16x8& pa3) {
#pragma unroll
  for (int r = 0; r < 16; ++r) p1[r] = __builtin_amdgcn_exp2f(p1[r]);
  float ps = 0;
#pragma unroll
  for (int r = 0; r < 16; ++r) ps += p0[r];
#pragma unroll
  for (int r = 0; r < 16; ++r) ps += p1[r];
  { auto rr = __builtin_amdgcn_permlane32_swap(__float_as_uint(ps), __float_as_uint(ps), false, false);
    ps = __uint_as_float(rr[0]) + __uint_as_float(rr[1]); }
  l_reg = l_reg * alpha + ps;
#define PK4(P, BASE, OUT) do { unsigned a0 = cvtpk(P[BASE + 0], P[BASE + 1]), a1 = cvtpk(P[BASE + 2], P[BASE + 3]);   \
    unsigned b0 = cvtpk(P[BASE + 4], P[BASE + 5]), b1 = cvtpk(P[BASE + 6], P[BASE + 7]);                              \
    auto r0 = __builtin_amdgcn_permlane32_swap(a0, b0, false, false); auto r1 = __builtin_amdgcn_permlane32_swap(a1, b1, false, false); \
    u32x4 w = {r0[0], r1[0], r0[1], r1[1]}; OUT = *reinterpret_cast<bf16x8*>(&w); } while (0)
  PK4(p0, 0, pa0); PK4(p0, 8, pa1); PK4(p1, 0, pa2); PK4(p1, 8, pa3);
#undef PK4
}
__device__ __forceinline__ void qkt(f32x16& p0, f32x16& p1, const bf16* Ks, const bf16x8* qr, int r32, int hi) {
  p0 = f32x16{}; p1 = f32x16{};
#pragma unroll
  for (int d0 = 0; d0 < 8; ++d0) { int cb = (d0 * 16 + hi * 8) * 2;
    bf16x8 b0 = *reinterpret_cast<const bf16x8*>((const char*)Ks + KSWZ(r32, cb));
    bf16x8 b1 = *reinterpret_cast<const bf16x8*>((const char*)Ks + KSWZ(32 + r32, cb));
    p0 = __builtin_amdgcn_mfma_f32_32x32x16_bf16(b0, qr[d0], p0, 0, 0, 0);
    p1 = __builtin_amdgcn_mfma_f32_32x32x16_bf16(b1, qr[d0], p1, 0, 0, 0); }
}
__device__ __forceinline__ int v_st(int k, int c) { const int kk = (k & ~0xC) | ((k & 4) << 1) | ((k & 8) >> 1); return ((kk >> 3) * 4 + (c >> 5)) * 512 + ((kk & 7) * 32 + (c & 31)) * 2; }
__device__ __forceinline__ int v_rd_base(int lane) { return ((lane & 3) << 3) | (((lane >> 2) & 3) << 6) | (((lane >> 4) & 1) << 5) | (((lane >> 5) & 1) << 8); }
constexpr int v_rd_off(int d0, int ks, int half) { return d0 * 512 + ks * 4096 + half * 2048; }
template <int OFF> __device__ __forceinline__ s16x4 tr_read(int vb) {
  s16x4 r; asm volatile("ds_read_b64_tr_b16 %0, %1 offset:%2" : "=&v"(r) : "v"(vb), "i"(OFF) : "memory"); return r;
}
template <int D0> __device__ __forceinline__ void pv_one(f32x16& od, int vb, bf16x8 pa0, bf16x8 pa1, bf16x8 pa2, bf16x8 pa3) {
  const s16x4 l0 = tr_read<v_rd_off(D0, 0, 0)>(vb), h0 = tr_read<v_rd_off(D0, 0, 1)>(vb), l1 = tr_read<v_rd_off(D0, 1, 0)>(vb), h1 = tr_read<v_rd_off(D0, 1, 1)>(vb);
  const s16x4 l2 = tr_read<v_rd_off(D0, 2, 0)>(vb), h2 = tr_read<v_rd_off(D0, 2, 1)>(vb), l3 = tr_read<v_rd_off(D0, 3, 0)>(vb), h3 = tr_read<v_rd_off(D0, 3, 1)>(vb);
  asm volatile("s_waitcnt lgkmcnt(0)" ::: "memory"); SBAR();
#define PK(L, H) (bf16x8){L[0], L[1], L[2], L[3], H[0], H[1], H[2], H[3]}
  od = __builtin_amdgcn_mfma_f32_32x32x16_bf16(pa0, PK(l0, h0), od, 0, 0, 0);
  od = __builtin_amdgcn_mfma_f32_32x32x16_bf16(pa1, PK(l1, h1), od, 0, 0, 0);
  od = __builtin_amdgcn_mfma_f32_32x32x16_bf16(pa2, PK(l2, h2), od, 0, 0, 0);
  od = __builtin_amdgcn_mfma_f32_32x32x16_bf16(pa3, PK(l3, h3), od, 0, 0, 0);
#undef PK
}
__device__ __forceinline__ void pv_d0(f32x16* o, int vb, bf16x8 pa0, bf16x8 pa1, bf16x8 pa2, bf16x8 pa3) {
  pv_one<0>(o[0], vb, pa0, pa1, pa2, pa3); pv_one<1>(o[1], vb, pa0, pa1, pa2, pa3); pv_one<2>(o[2], vb, pa0, pa1, pa2, pa3); pv_one<3>(o[3], vb, pa0, pa1, pa2, pa3);
}

template <int KIND>
__device__ __forceinline__ void attn_unit(const bf16* __restrict__ Qb, long qs, const bf16* __restrict__ Kh, const bf16* __restrict__ Vh, long ks,
                                          int kt0, int NT, int ktmax, bf16* __restrict__ Ob, long os, float* __restrict__ stp, long sts,
                                          int mq0, const float* __restrict__ tbsrc, int tbn, char* lds) {
  int tid_ = threadIdx.x; asm volatile("" : "+v"(tid_));
  const int tid = tid_, wid = __builtin_amdgcn_readfirstlane(tid >> 6), lane = tid & 63, r32 = lane & 31, hi = lane >> 5;
  bf16* V_lds = (bf16*)lds; bf16* K_lds = (bf16*)(lds + 2 * SHM_V);
  float* ws = (float*)(lds + LDS_WS) + wid * 64; float* li_l = ws; float* al_l = ws + 32;
  float* tb = (float*)(lds + LDS_TB);
  MaskCtx mc; mc.a = 0; mc.v = 0; mc.d = 0; mc.tbl = tb;
  if (KIND == 1) { const int r = mq0 + (wid >> 1), c = (wid & 1) * 32 + r32; mc.a = r; mc.v = min(max(c - 8, 0), 48) - 4 * hi; mc.tbl = tb + TB_ORG + 15 - c + 4 * hi; }
  if (KIND == 2) { mc.v = 64 - (mq0 + wid * 32 + r32) + 4 * hi; mc.d = ktmax; mc.tbl = tb + TB_ORG + mc.v; }
  if (KIND != 0) { for (int i = tid; i < tbn; i += 64 * NW) tb[TB_ORG + i] = tbsrc[i] * LOG2E; }
  float m_reg = -1e30f, l_reg = 0; f32x16 o[4] = {}; bf16x8 qr[8];
  const bf16* Qw = Qb + (long)(wid * QBLK + r32) * qs + hi * 8;
#pragma unroll
  for (int d0 = 0; d0 < 8; ++d0) qr[d0] = ld8(Qw + d0 * 16);
  const int sr = tid >> 4, sc = (tid & 15) * 8, vst0 = v_st(sr, sc), vst1 = v_st(32 + sr, sc);
  const int vb0 = (int)(uintptr_t)V_lds + v_rd_base(lane);
  const bf16* Kp = Kh + (long)sr * ks + sc; const bf16* Vp = Vh + (long)sr * ks + sc; const long o32 = 32 * ks, tstep = 64 * ks;
  struct { bf16x8 vs0, vs1, ks0, ks1; } sr_[2];
#define TCL(j) ((long)min(max(kt0 + (j), 0), ktmax - 1))
#define SLOAD(i, j) do { const long off_ = TCL(j) * tstep; sr_[i].vs0 = ld8(Vp + off_); sr_[i].vs1 = ld8(Vp + off_ + o32); sr_[i].ks0 = ld8(Kp + off_); sr_[i].ks1 = ld8(Kp + off_ + o32); } while (0)
#define SWRITE(b, i) do { *(bf16x8*)((char*)V_lds + (b) * SHM_V + vst0) = sr_[i].vs0;          \
    *(bf16x8*)((char*)V_lds + (b) * SHM_V + vst1) = sr_[i].vs1; int kc = sc * 2;               \
    *(bf16x8*)((char*)K_lds + (b) * SHM_K + KSWZ(sr, kc)) = sr_[i].ks0;                       \
    *(bf16x8*)((char*)K_lds + (b) * SHM_K + KSWZ(32 + sr, kc)) = sr_[i].ks1; } while (0)
#define SWAIT() asm volatile("s_waitcnt vmcnt(4)" ::: "memory")
#define RESC(a) do { if (__any((a) < 1.f)) { if (hi == 0) al_l[r32] = (a); asm volatile("s_waitcnt lgkmcnt(0)" ::: "memory"); \
    _Pragma("unroll") for (int d = 0; d < 4; ++d) _Pragma("unroll") for (int r = 0; r < 16; ++r) o[d][r] *= al_l[crow(r, hi)]; } } while (0)
#define PSM(P0, P1, MN, AL, J) do { if (KIND == 0) partialSM(P0, P1, m_reg, MN, AL); else partialSM_m<KIND>(P0, P1, m_reg, MN, AL, kt0 + (J), mc); } while (0)
  f32x16 pA0, pA1, pB0, pB1; float mnA, mnB, alA, alB; bf16x8 pa0, pa1, pa2, pa3;
  constexpr int SE = 0, SO = 1;
  SLOAD(SE, 0); asm volatile("s_waitcnt vmcnt(0)" ::: "memory"); SWRITE(0, SE); __syncthreads();
  qkt(pA0, pA1, K_lds, qr, r32, hi); PSM(pA0, pA1, mnA, alA, 0);
  SLOAD(SO, 1); if (2 < NT) SLOAD(SE, 2);
  SWAIT(); SWRITE(1, SO); __syncthreads();
  for (int j = 1; j + 1 < NT; j += 2) {
    SBAR(); qkt(pB0, pB1, (bf16*)((char*)K_lds + SHM_K), qr, r32, hi);
    finishSM(pA0, pA1, alA, l_reg, pa0, pa1, pa2, pa3); SBAR();
    SLOAD(SO, j + 2); SBAR();
    pv_d0(o, vb0, pa0, pa1, pa2, pa3); PSM(pB0, pB1, mnB, alB, j);
    __syncthreads(); SWAIT(); SWRITE(0, SE);
    RESC(alB); __syncthreads();
    SBAR(); qkt(pA0, pA1, K_lds, qr, r32, hi);
    finishSM(pB0, pB1, alB, l_reg, pa0, pa1, pa2, pa3); SBAR();
    if (j + 3 < NT) SLOAD(SE, j + 3); SBAR();
    pv_d0(o, vb0 + (int)SHM_V, pa0, pa1, pa2, pa3); PSM(pA0, pA1, mnA, alA, j + 1);
    __syncthreads(); SWAIT(); SWRITE(1, SO);
    RESC(alA); __syncthreads();
  }
  SBAR(); qkt(pB0, pB1, (bf16*)((char*)K_lds + SHM_K), qr, r32, hi);
  finishSM(pA0, pA1, alA, l_reg, pa0, pa1, pa2, pa3); SBAR();
  pv_d0(o, vb0, pa0, pa1, pa2, pa3); PSM(pB0, pB1, mnB, alB, NT - 1);
  __syncthreads(); RESC(alB);
  finishSM(pB0, pB1, alB, l_reg, pa0, pa1, pa2, pa3); SBAR();
  pv_d0(o, vb0 + (int)SHM_V, pa0, pa1, pa2, pa3);
  if (hi == 0) li_l[r32] = l_reg; asm volatile("s_waitcnt lgkmcnt(0)" ::: "memory");
  if (KIND == 2) { if (hi == 0) { float* sp = stp + (long)(wid * QBLK + r32) * sts; sp[0] = m_reg; sp[1] = l_reg; } }
  float rli[16];
#pragma unroll
  for (int r = 0; r < 16; ++r) rli[r] = __builtin_amdgcn_rcpf(li_l[crow(r, hi)]);
  bf16* Ow = Ob + (long)(wid * QBLK) * os;
#pragma unroll
  for (int r = 0; r < 16; ++r) { const int orow = crow(r, hi);
#pragma unroll
    for (int d0 = 0; d0 < 4; ++d0) { const float v = o[d0][r] * rli[r]; Ow[(long)orow * os + d0 * 32 + r32] = (bf16)(cvtpk(v, v) & 0xffffu); } }
#undef TCL
#undef SLOAD
#undef SWRITE
#undef SWAIT
#undef RESC
#undef PSM
}
}
#define GAS __attribute__((address_space(1)))
#define LAS __attribute__((address_space(3)))
typedef unsigned short bf16;
typedef unsigned v4u __attribute__((ext_vector_type(4)));
typedef float f32x4 __attribute__((ext_vector_type(4)));
typedef short bf16x8 __attribute__((ext_vector_type(8)));
typedef GAS unsigned gu32;
typedef GAS unsigned long long gu64;
#define RLX_AGENT __ATOMIC_RELAXED, __HIP_MEMORY_SCOPE_AGENT
#define LDS_WAIT() asm volatile("s_waitcnt lgkmcnt(0)" ::: "memory")
#define VM_WAIT() asm volatile("s_waitcnt vmcnt(0)" ::: "memory")
__device__ __forceinline__ unsigned long long rt() { return __builtin_amdgcn_s_memrealtime(); }
__device__ __forceinline__ unsigned f2bf(float f) { unsigned u = __builtin_bit_cast(unsigned, f); return (u + 0x7fffu + ((u >> 16) & 1u)) >> 16; }
__device__ __forceinline__ unsigned pk2(float lo, float hi) { return f2bf(lo) | (f2bf(hi) << 16); }

#define XB_TMO      128
#define XB_XCNT(j)  (256  + 64 * (j))
#define XB_XSUB(j)  (1280 + 64 * (j))
#define XB_XGEN(j)  (2304 + 64 * (j))
#define XB_TOP      3328
#define XB_TOPGEN   3392
#define XCD_BAR_WORDS 3456
#define XB_SPIN_CAP (1u << 18)

__device__ __forceinline__ unsigned xb_ld(unsigned* p)              { return __hip_atomic_load(p, __ATOMIC_RELAXED, __HIP_MEMORY_SCOPE_AGENT); }
__device__ __forceinline__ unsigned xb_add(unsigned* p, unsigned v) { return __hip_atomic_fetch_add(p, v, __ATOMIC_RELAXED, __HIP_MEMORY_SCOPE_AGENT); }
__device__ __forceinline__ unsigned xb_xcc_id() { return (unsigned)__builtin_amdgcn_s_getreg((3 << 11) | 20) & 0xFu; }
#define XB_SPIN(cond, bar) do { unsigned _sp = 0; while (cond) { __builtin_amdgcn_s_sleep(1); \
    if ((++_sp & 255u) == 0u) { if (xb_ld(&(bar)[XB_TMO])) break; if (_sp > XB_SPIN_CAP) { atomicAdd(&(bar)[XB_TMO], 1u); break; } } } } while (0)

struct XcdBarrier {
    unsigned* bar; unsigned x;
    volatile LAS unsigned* st;
};

__device__ __forceinline__ XcdBarrier xcd_barrier_post(unsigned* bar, volatile LAS unsigned* st) {
    XcdBarrier b; b.bar = bar; b.x = xb_xcc_id(); b.st = st;
    if (threadIdx.x == 0) (void)xb_add(&bar[XB_XCNT(b.x)], 1u);
    return b;
}
__device__ __forceinline__ void xcd_barrier_complete(unsigned* bar, unsigned x, unsigned& nloc, unsigned& nx) {
    const unsigned G = gridDim.x * gridDim.y * gridDim.z;
    unsigned sum, cnt, mine, sp = 0u;
    for (;;) {
        sum = 0u; cnt = 0u; mine = 0u;
#pragma unroll
        for (unsigned j = 0; j < 16; ++j) { const unsigned c = xb_ld(&bar[XB_XCNT(j)]); sum += c; cnt += (c > 0u) ? 1u : 0u; mine = (j == x) ? c : mine; }
        if (sum == G) break;
        __builtin_amdgcn_s_sleep(1);
        if ((++sp & 255u) == 0u) { if (xb_ld(&bar[XB_TMO])) break; if (sp > XB_SPIN_CAP) { atomicAdd(&bar[XB_TMO], 1u); break; } }
    }
    nloc = mine > 0u ? mine : 1u; nx = cnt > 0u ? cnt : 1u;
}

__device__ __forceinline__ void xcd_barrier(const XcdBarrier& b) {
    asm volatile("s_waitcnt vmcnt(0)" ::: "memory");
    __syncthreads();
    if (threadIdx.x == 0) {
        unsigned* bar = b.bar;
        __builtin_amdgcn_s_waitcnt(0);
        unsigned nloc = b.st[0], nx = b.st[1];
        if (nloc == 0u) { xcd_barrier_complete(bar, b.x, nloc, nx); b.st[0] = nloc; b.st[1] = nx; }
        const unsigned old = xb_add(&bar[XB_XSUB(b.x)], 1u);
        const unsigned gen = old / nloc;
        if (old + 1u == (gen + 1u) * nloc) {
            __builtin_amdgcn_fence(__ATOMIC_RELEASE, "agent");
            asm volatile("s_waitcnt vmcnt(0)" ::: "memory");
            const unsigned og = xb_add(&bar[XB_TOP], 1u);
            const unsigned tg = og / nx;
            if (og + 1u == (tg + 1u) * nx) xb_add(&bar[XB_TOPGEN], 1u);
            else XB_SPIN(xb_ld(&bar[XB_TOPGEN]) == tg, bar);
            __builtin_amdgcn_fence(__ATOMIC_ACQUIRE, "agent");
            xb_add(&bar[XB_XGEN(b.x)], 1u);
            asm volatile("s_waitcnt vmcnt(0)" ::: "memory");
        } else {
            XB_SPIN(xb_ld(&bar[XB_XGEN(b.x)]) == gen, bar);
            __builtin_amdgcn_fence(__ATOMIC_ACQUIRE, "agent");
            asm volatile("s_waitcnt vmcnt(0)" ::: "memory");
        }
    }
    __syncthreads();
}
constexpr int BATCH = 2, SEQ = 8192, DM = 4096, DEPTH = 4, HDIM = 128, H_NA = 8, H_DIL = 12, H_GQA = 12, KV_GQA = 4;
constexpr int NQKV = 10240, DFF = 16384, M = BATCH * SEQ, NMOD = 6;
constexpr int Q_NA = 0, Q_DIL = 1024, Q_GQA = 2560, K_NA = 4096, K_DIL = 5120, K_GQA = 6656, V_NA = 7168, V_DIL = 8192, V_GQA = 9728;
constexpr int O_NA = 0, O_DIL = 1024, O_GQA = 2560, DILW = H_DIL * HDIM;
constexpr float EPS = 1e-6f;
constexpr size_t MiB = 1u << 20;
constexpr size_t WS_CTL = 0, CTL_ZERO_BYTES = 1 * MiB;
constexpr size_t WS_MODP = 1 * MiB;
constexpr size_t WS_MODV = 4 * MiB;
constexpr size_t WS_ROPE = 5 * MiB;
constexpr size_t WS_DILTB = 5 * MiB + 64 * 1024;
constexpr size_t WS_DILST = 6 * MiB;
constexpr size_t WS_WIN = 16 * MiB, WS_WOUT = 336 * MiB, WS_W1 = 464 * MiB, WS_W2 = 976 * MiB;
constexpr size_t WS_H = 1488 * MiB, WS_QKV = 1616 * MiB, WS_O = 1936 * MiB, WS_Y = 2064 * MiB, WS_U = 2320 * MiB, WS_DILP = 2832 * MiB, WS_END = 2976 * MiB;
static_assert(WS_DILST + (size_t)3 * M * 12 * 2 * 4 <= WS_WIN, "ws map");
constexpr int CW_BAR = 4096;
constexpr int RING_OFF = 0, RING_BYTES = 131072, LDSCTL_OFF = RING_BYTES, MISC_OFF = LDSCTL_OFF + 320, LDS_BYTES = 147456;
constexpr int NWAVES = 8;

struct Frame {
    LAS unsigned char* lds; volatile LAS unsigned* MISC;
    int G;
};
__device__ __forceinline__ float wave_sum(float v) {
#pragma unroll
    for (int o = 1; o < 64; o <<= 1) v += __shfl_xor(v, o);
    return v;
}
__device__ __forceinline__ float bf2f(unsigned short b) { return __uint_as_float(((unsigned)b) << 16); }
__device__ __forceinline__ void p0_transpose_item(const float* W, int K, int N, bf16* WT, LAS float* scr, int item, int lane) {
    const int nblk = N / 32, kb = item / nblk, nb = item % nblk, k0 = 64 * kb, n0 = 32 * nb;
#pragma unroll 8
    for (int i = 0; i < 32; ++i) { const int kk = 2 * i + (lane >> 5); scr[kk * 33 + (lane & 31)] = W[(size_t)(k0 + kk) * N + n0 + (lane & 31)]; }
    LDS_WAIT(); asm volatile("" ::: "memory");
    const int c = lane & 7;
#pragma unroll
    for (int j = 0; j < 4; ++j) { const int n = (lane >> 3) + 8 * j; const LAS float* s = scr + (8 * c) * 33 + n;
        v4u o; o.x = pk2(s[0 * 33], s[1 * 33]); o.y = pk2(s[2 * 33], s[3 * 33]); o.z = pk2(s[4 * 33], s[5 * 33]); o.w = pk2(s[6 * 33], s[7 * 33]);
        *(GAS v4u*)(WT + (size_t)(n0 + n) * K + k0 + 8 * c) = o; }
    LDS_WAIT(); asm volatile("" ::: "memory");
}
__device__ __forceinline__ int t5_bucket_dev(int rel) {
    const int n = rel < 0 ? -rel : rel; int b;
    if (n < 8) b = n; else b = 8 + (n >= 15) + (n >= 27) + (n >= 50) + (n >= 91) + (n >= 166) + (n >= 305) + (n >= 559);
    return (rel > 0 ? 16 : 0) + b;
}

#ifndef PH_MASK
#define PH_MASK 0xFFF
#endif
#define ON(k) (((PH_MASK) >> (k)) & 1)
struct Args { const float* in[14]; float* out; unsigned char* ws; };

template <bool HAS_Y>
__device__ __forceinline__ void norm_phase(Frame& F, const float* xin, const float* y, float* xout, bf16* h, const float* Gv, const float* Av, const float* Bv, int bstride) {
    int tid_ = threadIdx.x; asm volatile("" : "+v"(tid_)); const int tid = tid_, lane = tid & 63, wave = __builtin_amdgcn_readfirstlane(tid >> 6);
    LAS f32x4* Gs = (LAS f32x4*)(F.lds); LAS f32x4* As = (LAS f32x4*)(F.lds + 16384); LAS f32x4* Bs = (LAS f32x4*)(F.lds + 32768);
    for (int chunk = blockIdx.x; chunk < M / 64; chunk += F.G) {
        const int b = chunk / (SEQ / 64);
        __syncthreads();
        for (int i = tid; i < 1024; i += NWAVES * 64) { if (HAS_Y) Gs[i] = ((const f32x4*)(Gv + (size_t)b * bstride))[i]; if (h) { As[i] = ((const f32x4*)(Av + (size_t)b * bstride))[i]; Bs[i] = ((const f32x4*)(Bv + (size_t)b * bstride))[i]; } }
        __syncthreads();
        for (int rr = wave; rr < 64; rr += NWAVES) {
            const size_t row = (size_t)chunk * 64 + rr;
            const f32x4* xr = (const f32x4*)(xin + row * DM) + lane;
            f32x4 xv[16];
            if (HAS_Y) {
                const f32x4* yr = (const f32x4*)(y + row * DM) + lane; f32x4 yv[16]; float ss = 0.f;
#pragma unroll
                for (int j = 0; j < 16; ++j) { yv[j] = yr[64 * j]; ss += (yv[j].x * yv[j].x + yv[j].y * yv[j].y) + (yv[j].z * yv[j].z + yv[j].w * yv[j].w); }
                const float ry = 1.0f / sqrtf(wave_sum(ss) * (1.0f / DM) + EPS);
                f32x4* xo = (f32x4*)(xout + row * DM) + lane;
#pragma unroll
                for (int j = 0; j < 16; ++j) { xv[j] = xr[64 * j]; const f32x4 g = Gs[lane + 64 * j]; xv[j] = xv[j] + g * (yv[j] * ry); xo[64 * j] = xv[j]; }
            } else {
#pragma unroll
                for (int j = 0; j < 16; ++j) xv[j] = xr[64 * j];
            }
            if (h) {
                float ss = 0.f;
#pragma unroll
                for (int j = 0; j < 16; ++j) ss += (xv[j].x * xv[j].x + xv[j].y * xv[j].y) + (xv[j].z * xv[j].z + xv[j].w * xv[j].w);
                const float rx = 1.0f / sqrtf(wave_sum(ss) * (1.0f / DM) + EPS);
                unsigned long long* ho = (unsigned long long*)(h + row * DM) + lane;
#pragma unroll
                for (int j = 0; j < 16; ++j) { const f32x4 a = As[lane + 64 * j], bb = Bs[lane + 64 * j]; const f32x4 v = a * (xv[j] * rx) + bb;
                    ho[64 * j] = (unsigned long long)pg8::cvt_pk_bf16(v.x, v.y) | ((unsigned long long)pg8::cvt_pk_bf16(v.z, v.w) << 32); }
            }
        }
    }
}

typedef __attribute__((address_space(4))) const unsigned char ckb_t;
__device__ __forceinline__ const void* karg(int i) { ckb_t* kp = (ckb_t*)__builtin_amdgcn_kernarg_segment_ptr(); asm volatile("" : "+s"(kp)); return *(const void* const __attribute__((address_space(4)))*)(kp + 8 * i); }
#define KIN(i) ((const float*)karg(i))
#define KOUT() ((float*)karg(14))
#define KWS() ((unsigned char*)karg(15))
__global__ void __launch_bounds__(NWAVES * 64, 2) mega_fwd(Args args_unused) {
    extern __shared__ __attribute__((aligned(16))) unsigned char lds[];
    Frame F;
    F.lds = (LAS unsigned char*)lds; F.MISC = (volatile LAS unsigned*)(F.lds + MISC_OFF); F.G = gridDim.x;
    for (int u = threadIdx.x; u < (LDS_BYTES - LDSCTL_OFF) / 4; u += NWAVES * 64) ((LAS unsigned*)(F.lds + LDSCTL_OFF))[u] = 0u;
    __syncthreads();
    (void)xcd_barrier_post((unsigned*)((gu32*)(KWS() + WS_CTL) + CW_BAR), F.MISC + 8);
#define GRID_BAR() do { XcdBarrier bar_; bar_.bar = (unsigned*)((gu32*)(KWS() + WS_CTL) + CW_BAR); bar_.x = xb_xcc_id(); bar_.st = (volatile LAS unsigned*)(F.lds + MISC_OFF) + 8; xcd_barrier(bar_); } while (0)
#define FRESH_IDS() int tid_ = threadIdx.x; asm volatile("" : "+v"(tid_)); const int ftid = tid_, flane = ftid & 63, fwave = __builtin_amdgcn_readfirstlane(ftid >> 6); \
    const int gw = blockIdx.x * NWAVES + fwave, NGW = F.G * NWAVES, gtid = blockIdx.x * (NWAVES * 64) + ftid, NGT = F.G * NWAVES * 64; (void)flane; (void)gw; (void)NGW; (void)gtid; (void)NGT
#define WSP(T, off) ((T*)(ws + (off)))

    if (ON(0))
    {
        FRESH_IDS(); unsigned char* ws = KWS(); const float* in_c = KIN(1); const float* ada_w = KIN(2); float* MODP = WSP(float, WS_MODP);
        for (int task = gw; task < 96 * 16; task += NGW) {
            const int cg = task % 96, kc = task / 96; const int col = cg * 256 + flane * 4;
            f32x4 a0 = {0.f, 0.f, 0.f, 0.f}, a1 = {0.f, 0.f, 0.f, 0.f};
            const float* wp = ada_w + (size_t)(kc * 256) * (NMOD * DM) + col;
#pragma unroll 8
            for (int k = 0; k < 256; ++k) {
                const f32x4 w = *(const f32x4*)(wp + (size_t)k * (NMOD * DM));
                const float c0 = in_c[kc * 256 + k], c1 = in_c[DM + kc * 256 + k];
                const float s0 = c0 / (1.0f + __expf(-c0)), s1 = c1 / (1.0f + __expf(-c1));
                a0 = a0 + w * s0; a1 = a1 + w * s1;
            }
            *(f32x4*)(MODP + ((size_t)(kc * 2 + 0) * (NMOD * DM)) + col) = a0;
            *(f32x4*)(MODP + ((size_t)(kc * 2 + 1) * (NMOD * DM)) + col) = a1;
        }
        LAS float* scr = (LAS float*)(F.lds + RING_OFF + fwave * 16384);
        const float* w_in = KIN(6); const float* w_out = KIN(7); const float* w_mlp_in = KIN(12); const float* w_mlp_out = KIN(13);
        bf16* WIN = WSP(bf16, WS_WIN); bf16* WOUT = WSP(bf16, WS_WOUT); bf16* W1 = WSP(bf16, WS_W1); bf16* W2 = WSP(bf16, WS_W2);
        constexpr int I_IN = (DM / 64) * (NQKV / 32), I_OUT = (DM / 64) * (DM / 32), I_1 = (DM / 64) * (DFF / 32), I_2 = (DFF / 64) * (DM / 32);
        constexpr int I_LAYER = I_IN + I_OUT + I_1 + I_2;
        for (int it = gw; it < DEPTH * I_LAYER; it += NGW) {
            const int l = it / I_LAYER; int r = it % I_LAYER;
            if (r < I_IN) { p0_transpose_item(w_in + (size_t)l * DM * NQKV, DM, NQKV, WIN + (size_t)l * NQKV * DM, scr, r, flane); continue; } r -= I_IN;
            if (r < I_OUT) { p0_transpose_item(w_out + (size_t)l * DM * DM, DM, DM, WOUT + (size_t)l * DM * DM, scr, r, flane); continue; } r -= I_OUT;
            if (r < I_1) { p0_transpose_item(w_mlp_in + (size_t)l * DM * DFF, DM, DFF, W1 + (size_t)l * DFF * DM, scr, r, flane); continue; } r -= I_1;
            p0_transpose_item(w_mlp_out + (size_t)l * DFF * DM, DFF, DM, W2 + (size_t)l * DM * DFF, scr, r, flane);
        }
    }
    GRID_BAR();
    if (ON(1))
    {
        FRESH_IDS(); unsigned char* ws = KWS(); const float* ada_b = KIN(3); const float* ada_emb = KIN(4); const float* gains = KIN(5); const float* t5_table = KIN(11);
        float* MODP = WSP(float, WS_MODP); float* MODV = WSP(float, WS_MODV); float* ROPE = WSP(float, WS_ROPE); float* DILTB = WSP(float, WS_DILTB);
        for (int i = gtid; i < DEPTH * 2 * NMOD * DM; i += NGT) {
            const int col = i % DM, j = (i / DM) % NMOD, b = (i / (DM * NMOD)) % 2, l = i / (DM * NMOD * 2);
            float m = ada_b[j * DM + col];
#pragma unroll
            for (int kc = 0; kc < 16; ++kc) m += MODP[(size_t)(kc * 2 + b) * (NMOD * DM) + j * DM + col];
            m += ada_emb[((size_t)l * NMOD + j) * DM + col];
            const float* gl = gains + (size_t)l * 4 * DM;
            float v;
            if (j == 0) v = m; else if (j == 1) v = gl[0 * DM + col] * (1.0f + m); else if (j == 2) v = m * gl[1 * DM + col];
            else if (j == 3) v = m; else if (j == 4) v = gl[2 * DM + col] * (1.0f + m); else v = m * gl[3 * DM + col];
            MODV[i] = v;
        }
        if (blockIdx.x == 0 && ftid < 32) {
            const int f = ftid; const double th = (double)__builtin_amdgcn_exp2f(-(float)f * 0.41524101186092029f);
            double c1 = 1.0, s1 = th, tc = 1.0, ts = th; const double x2 = th * th;
            for (int n = 1; n <= 12; ++n) { tc *= -x2 / (double)((2 * n - 1) * (2 * n)); ts *= -x2 / (double)((2 * n) * (2 * n + 1)); c1 += tc; s1 += ts; }
            double c = 1.0, s = 0.0;
            for (int pos = 0; pos < 128; ++pos) { ROPE[pos * 32 + f] = (float)c; ROPE[4096 + pos * 32 + f] = (float)s; const double cn = c * c1 - s * s1; s = s * c1 + c * s1; c = cn; }
        }
        if (blockIdx.x == 1 || F.G == 1) {
            for (int i = ftid; i < 3 * H_DIL * 129; i += NWAVES * 64) { const int p = i / (H_DIL * 129), hh = (i / 129) % H_DIL, jj = i % 129 - 64; const int d = p == 0 ? 1 : (p == 1 ? 4 : 16);
                DILTB[i] = t5_table[t5_bucket_dev(jj * d) * H_DIL + hh]; }
        }
    }
    GRID_BAR();
    if (ON(2))
    { unsigned char* ws = KWS(); float* MODV = WSP(float, WS_MODV);
      norm_phase<false>(F, KIN(0), nullptr, nullptr, WSP(bf16, WS_H), nullptr, MODV + 1 * DM, MODV + 0 * DM, NMOD * DM); }
    GRID_BAR();

    for (int l = 0; l < DEPTH; ++l) {
    if (ON(3))
        {
            unsigned char* ws = KWS();
            pg8::Gemm g{WSP(bf16, WS_H), WSP(bf16, WS_WIN) + (size_t)l * NQKV * DM, M, NQKV, DM}; pg8::StaticOrder S; S.init(M, NQKV, F.G, (int)blockIdx.x);
            pg8::EpiBf16<0> E{WSP(bf16, WS_QKV), NQKV};
            pg8::gemm_phase<pg8::EpiBf16<0>, pg8::StaticOrder, true, true>(F.lds + RING_OFF, g, S, E);
        }
        GRID_BAR();
    if (ON(4))
        {
            FRESH_IDS(); const int i16 = ftid & 15; const int g16 = gtid >> 4, NG16 = NGT >> 4;
            unsigned char* ws = KWS(); bf16* QKV = WSP(bf16, WS_QKV); const float* ROPE = WSP(float, WS_ROPE); const float* q_gain = KIN(8); const float* k_gain = KIN(9);
            for (int task = g16; task < M * 16; task += NG16) {
                const int row = task >> 4, hh = task & 15;
                const int col = hh < H_GQA ? Q_GQA + hh * HDIM : K_GQA + (hh - H_GQA) * HDIM;
                const float* gp = (hh < H_GQA ? q_gain : k_gain) + l * HDIM + 8 * i16;
                bf16* p = QKV + (size_t)row * NQKV + col + 8 * i16;
                const v4u raw = *(const v4u*)p;
                float x[8];
                x[0] = __uint_as_float(raw.x << 16); x[1] = __uint_as_float(raw.x & 0xffff0000u); x[2] = __uint_as_float(raw.y << 16); x[3] = __uint_as_float(raw.y & 0xffff0000u);
                x[4] = __uint_as_float(raw.z << 16); x[5] = __uint_as_float(raw.z & 0xffff0000u); x[6] = __uint_as_float(raw.w << 16); x[7] = __uint_as_float(raw.w & 0xffff0000u);
                float ss = 0.f;
#pragma unroll
                for (int e = 0; e < 8; ++e) ss += x[e] * x[e];
                ss += __shfl_xor(ss, 1); ss += __shfl_xor(ss, 2); ss += __shfl_xor(ss, 4); ss += __shfl_xor(ss, 8);
                const float rstd = 1.0f / sqrtf(ss * (1.0f / HDIM) + EPS);
                const f32x4 g0 = *(const f32x4*)gp, g1 = *(const f32x4*)(gp + 4);
                x[0] *= rstd * g0.x; x[1] *= rstd * g0.y; x[2] *= rstd * g0.z; x[3] *= rstd * g0.w; x[4] *= rstd * g1.x; x[5] *= rstd * g1.y; x[6] *= rstd * g1.z; x[7] *= rstd * g1.w;
                const int t = row & (SEQ - 1); const int pos = (i16 < 8) ? (t >> 6) : (t & 63); const int jj = i16 & 7, fb = 8 * (jj & 3);
                const f32x4 c0 = *(const f32x4*)(ROPE + pos * 32 + fb), c1 = *(const f32x4*)(ROPE + pos * 32 + fb + 4);
                const f32x4 s0 = *(const f32x4*)(ROPE + 4096 + pos * 32 + fb), s1 = *(const f32x4*)(ROPE + 4096 + pos * 32 + fb + 4);
                const float cs[8] = {c0.x, c0.y, c0.z, c0.w, c1.x, c1.y, c1.z, c1.w}; const float sn[8] = {s0.x, s0.y, s0.z, s0.w, s1.x, s1.y, s1.z, s1.w};
                float o[8];
#pragma unroll
                for (int e = 0; e < 8; ++e) { const float pv = __shfl_xor(x[e], 4); o[e] = (jj < 4) ? (x[e] * cs[e] - pv * sn[e]) : (pv * sn[e] + x[e] * cs[e]); }
                v4u w; w.x = pg8::cvt_pk_bf16(o[0], o[1]); w.y = pg8::cvt_pk_bf16(o[2], o[3]); w.z = pg8::cvt_pk_bf16(o[4], o[5]); w.w = pg8::cvt_pk_bf16(o[6], o[7]);
                *(v4u*)p = w;
            }
        }
        GRID_BAR();
    if (ON(5))
        {
            char* alds = (char*)lds + RING_OFF;

#ifndef NO_ATT0
            { unsigned char* ws = KWS(); bf16* QKV = WSP(bf16, WS_QKV); bf16* O = WSP(bf16, WS_O);
            for (int u = blockIdx.x; u < 768; u += F.G) {
                const int x = u & 7, loc = (u >> 3) & 31, i = u >> 8; const int b = x >> 2, kvh = x & 3, hq = kvh * 3 + i, qb = loc;
                const size_t r0 = (size_t)b * SEQ + (size_t)qb * 256;
                att::attn_unit<0>(QKV + r0 * NQKV + Q_GQA + hq * HDIM, NQKV, QKV + (size_t)b * SEQ * NQKV + K_GQA + kvh * HDIM, QKV + (size_t)b * SEQ * NQKV + V_GQA + kvh * HDIM, NQKV,
                                  0, SEQ / 64, SEQ / 64, O + r0 * DM + O_GQA + hq * HDIM, DM, nullptr, 0, 0, nullptr, 0, alds);
            } }
#endif
#ifndef NO_ATT1
            { unsigned char* ws = KWS(); bf16* QKV = WSP(bf16, WS_QKV); bf16* O = WSP(bf16, WS_O); const float* na_rpb = KIN(10);
            for (int u = blockIdx.x; u < 512; u += F.G) {
                const int x = u & 7, loc = (u >> 3) & 31, i = u >> 8; const int b = i, hh = x, qb = loc;
                const size_t r0 = (size_t)b * SEQ + (size_t)qb * 256;
                att::attn_unit<1>(QKV + r0 * NQKV + Q_NA + hh * HDIM, NQKV, QKV + (size_t)b * SEQ * NQKV + K_NA + hh * HDIM, QKV + (size_t)b * SEQ * NQKV + V_NA + hh * HDIM, NQKV,
                                  qb * 4 - 4, 12, SEQ / 64, O + r0 * DM + O_NA + hh * HDIM, DM, nullptr, 0, qb * 4, na_rpb + ((size_t)l * H_NA + hh) * 465, 465, alds);
            } }
#endif
#ifndef NO_ATT2
            { unsigned char* ws = KWS(); bf16* QKV = WSP(bf16, WS_QKV); bf16* DILP = WSP(bf16, WS_DILP); float* DILST = WSP(float, WS_DILST); const float* DILTB = WSP(float, WS_DILTB);
            for (int u = blockIdx.x; u < 2304; u += F.G) {
                const int x = u & 7, loc = (u >> 3) & 31, i = u >> 8; const int p = i % 3, pair = x + 8 * (i / 3), b = pair / H_DIL, hh = pair % H_DIL;
                const int d = p == 0 ? 1 : (p == 1 ? 4 : 16), nub = 32 / d, res = loc / nub, ub = loc % nub, u0 = ub * 256, L = SEQ / d;
                const size_t rq = (size_t)b * SEQ + (size_t)u0 * d + res, rk = (size_t)b * SEQ + res;
                att::attn_unit<2>(QKV + rq * NQKV + Q_DIL + hh * HDIM, (long)d * NQKV, QKV + rk * NQKV + K_DIL + hh * HDIM, QKV + rk * NQKV + V_DIL + hh * HDIM, (long)d * NQKV,
                                  u0 / 64 - 1, 6, L / 64, DILP + (size_t)p * M * DILW + rq * DILW + hh * HDIM, (long)d * DILW,
                                  DILST + (((size_t)p * M + rq) * H_DIL + hh) * 2, (long)d * H_DIL * 2, u0, DILTB + (p * H_DIL + hh) * 129, 129, alds);
            } }
#endif
        }
        GRID_BAR();
    if (ON(6))
        {
            FRESH_IDS(); const int i16 = ftid & 15; const int g16 = gtid >> 4, NG16 = NGT >> 4;
            unsigned char* ws = KWS(); bf16* O = WSP(bf16, WS_O); const bf16* DILP = WSP(bf16, WS_DILP); const float* DILST = WSP(float, WS_DILST);
            for (int task = g16; task < M * H_DIL; task += NG16) {
                const int row = task / H_DIL, hh = task % H_DIL;
                float mm[3], ll[3];
#pragma unroll
                for (int p = 0; p < 3; ++p) { const float* sp = DILST + (((size_t)p * M + row) * H_DIL + hh) * 2; mm[p] = sp[0]; ll[p] = sp[1]; }
                const float mx = fmaxf(mm[0], fmaxf(mm[1], mm[2]));
                float wv[3]; float wsum = 0.f;
#pragma unroll
                for (int p = 0; p < 3; ++p) { wv[p] = ll[p] * __builtin_amdgcn_exp2f(mm[p] - mx); wsum += wv[p]; }
                const float inv = 1.0f / wsum;
                float acc[8] = {0.f, 0.f, 0.f, 0.f, 0.f, 0.f, 0.f, 0.f};
#pragma unroll
                for (int p = 0; p < 3; ++p) { const v4u raw = *(const v4u*)(DILP + (size_t)p * M * DILW + (size_t)row * DILW + hh * HDIM + 8 * i16); const float wp = wv[p] * inv;
                    acc[0] += wp * __uint_as_float(raw.x << 16); acc[1] += wp * __uint_as_float(raw.x & 0xffff0000u); acc[2] += wp * __uint_as_float(raw.y << 16); acc[3] += wp * __uint_as_float(raw.y & 0xffff0000u);
                    acc[4] += wp * __uint_as_float(raw.z << 16); acc[5] += wp * __uint_as_float(raw.z & 0xffff0000u); acc[6] += wp * __uint_as_float(raw.w << 16); acc[7] += wp * __uint_as_float(raw.w & 0xffff0000u); }
                v4u w; w.x = pg8::cvt_pk_bf16(acc[0], acc[1]); w.y = pg8::cvt_pk_bf16(acc[2], acc[3]); w.z = pg8::cvt_pk_bf16(acc[4], acc[5]); w.w = pg8::cvt_pk_bf16(acc[6], acc[7]);
                *(v4u*)(O + (size_t)row * DM + O_DIL + hh * HDIM + 8 * i16) = w;
            }
        }
        GRID_BAR();
    if (ON(7))
        {
            unsigned char* ws = KWS();
            pg8::Gemm g{WSP(bf16, WS_O), WSP(bf16, WS_WOUT) + (size_t)l * DM * DM, M, DM, DM}; pg8::StaticOrder S; S.init(M, DM, F.G, (int)blockIdx.x);
            pg8::EpiF32 E{WSP(float, WS_Y), DM};
            pg8::gemm_phase<pg8::EpiF32, pg8::StaticOrder, true, true>(F.lds + RING_OFF, g, S, E);
        }
        GRID_BAR();
    if (ON(8))
        { unsigned char* ws = KWS(); const float* mv = WSP(float, WS_MODV) + (size_t)l * 2 * NMOD * DM; float* out = KOUT();
          norm_phase<true>(F, l == 0 ? KIN(0) : out, WSP(float, WS_Y), out, WSP(bf16, WS_H), mv + 2 * DM, mv + 4 * DM, mv + 3 * DM, NMOD * DM); }
        GRID_BAR();
    if (ON(9))
        {
            unsigned char* ws = KWS();
            pg8::Gemm g{WSP(bf16, WS_H), WSP(bf16, WS_W1) + (size_t)l * DFF * DM, M, DFF, DM}; pg8::StaticOrder S; S.init(M, DFF, F.G, (int)blockIdx.x);
            pg8::EpiBf16<3> E{WSP(bf16, WS_U), DFF};
            pg8::gemm_phase<pg8::EpiBf16<3>, pg8::StaticOrder, true, true>(F.lds + RING_OFF, g, S, E);
        }
        GRID_BAR();
    if (ON(10))
        {
            unsigned char* ws = KWS();
            pg8::Gemm g{WSP(bf16, WS_U), WSP(bf16, WS_W2) + (size_t)l * DM * DFF, M, DM, DFF}; pg8::StaticOrder S; S.init(M, DM, F.G, (int)blockIdx.x);
            pg8::EpiF32 E{WSP(float, WS_Y), DM};
            pg8::gemm_phase<pg8::EpiF32, pg8::StaticOrder, true, true>(F.lds + RING_OFF, g, S, E);
        }
        GRID_BAR();
    if (ON(11))
        {
            unsigned char* ws = KWS(); const float* mv = WSP(float, WS_MODV) + (size_t)l * 2 * NMOD * DM; float* out = KOUT();
            const float* mvn = WSP(float, WS_MODV) + (size_t)(l + 1 < DEPTH ? l + 1 : l) * 2 * NMOD * DM;
            norm_phase<true>(F, out, WSP(float, WS_Y), out, (l + 1 < DEPTH) ? WSP(bf16, WS_H) : (bf16*)nullptr, mv + 5 * DM, mvn + 1 * DM, mvn + 0 * DM, NMOD * DM);
        }
        if (l + 1 < DEPTH) GRID_BAR();
    }
    __syncthreads();
    if (__hip_atomic_load((gu32*)(KWS() + WS_CTL) + CW_BAR + XB_TMO, RLX_AGENT) != 0u) {
        const float q = __builtin_nanf(""); float* out = KOUT();
        for (int chunk = blockIdx.x; chunk < M / 64; chunk += F.G) for (int i = threadIdx.x; i < 64 * DM / 4; i += NWAVES * 64) ((f32x4*)(out + (size_t)chunk * 64 * DM))[i] = (f32x4){q, q, q, q};
    }
}

extern "C" void kernel_launch(void* const* d_in, const int* in_sizes, int n_in, void* d_out, int out_size, void* d_ws, size_t ws_size, hipStream_t stream) {
    static int grid = 0;
    if (grid == 0) {
        if (n_in != 14 || in_sizes[0] != M * DM || out_size != M * DM || ws_size < WS_END) { fprintf(stderr, "kernel_launch: shape/workspace mismatch (n_in %d, in0 %d, out %d, ws %zu, need %zu)\n", n_in, n_in > 0 ? in_sizes[0] : -1, out_size, ws_size, (size_t)WS_END); grid = -1; return; }
        int dev = 0, cus = 0, per_cu = 0;
        if (hipGetDevice(&dev) != hipSuccess || hipDeviceGetAttribute(&cus, hipDeviceAttributeMultiprocessorCount, dev) != hipSuccess) { grid = -1; return; }
        if (hipFuncSetAttribute((const void*)mega_fwd, hipFuncAttributeMaxDynamicSharedMemorySize, LDS_BYTES) != hipSuccess) { fprintf(stderr, "kernel_launch: hipFuncSetAttribute failed\n"); grid = -1; return; }
        if (hipOccupancyMaxActiveBlocksPerMultiprocessor(&per_cu, (const void*)mega_fwd, NWAVES * 64, LDS_BYTES) != hipSuccess || per_cu < 1) { fprintf(stderr, "kernel_launch: occupancy query reports %d blocks per CU\n", per_cu); }
        (void)hipGetLastError();
        grid = cus;
    }
    if (grid < 0) return;
    if (hipMemsetAsync((char*)d_ws + WS_CTL, 0, CTL_ZERO_BYTES, stream) != hipSuccess) return;
    Args a{};
    for (int i = 0; i < 14; ++i) a.in[i] = (const float*)d_in[i];
    a.out = (float*)d_out; a.ws = (unsigned char*)d_ws;
    hipLaunchKernelGGL(mega_fwd, dim3(grid), dim3(NWAVES * 64), LDS_BYTES, stream, a);
    const hipError_t le = hipPeekAtLastError();
    if (le != hipSuccess) fprintf(stderr, "kernel_launch: launch failed: %s\n", hipGetErrorName(le));
}
```

```cpp
#include <hip/hip_runtime.h>
#include <cstdio>
#include <cstdint>
namespace pg8 {
#define PG8_LAS __attribute__((address_space(3)))
typedef unsigned short bf16_t;
typedef short bf16x8 __attribute__((ext_vector_type(8)));
typedef float f32x4 __attribute__((ext_vector_type(4)));
typedef unsigned u32x4 __attribute__((ext_vector_type(4)));
constexpr int BM = 256, BK = 64, HALF = 128, HTB = HALF * BK * 2  , STAGE_BYTES = 8 * HTB, NXCD = 8, WGM = 8;

__host__ __device__ __forceinline__ int lds_byte(int r, int c) { const int st = (r >> 4) * 2 + (c >> 5), rr = r & 15, cc = c & 31, ob = rr * 64 + cc * 2; return st * 1024 + (ob ^ (((ob >> 9) & 1) << 5)); }
__host__ __device__ __forceinline__ void stage_rc(int b, int& R, int& C) { const int st = b / 1024, sb = b % 1024, swz = sb ^ (((sb >> 9) & 1) << 5); R = (st >> 1) * 16 + swz / 64; C = (st & 1) * 32 + (swz % 64) / 2; }
__host__ __device__ __forceinline__ int perm32(int rho) { const int n = rho >> 4, i = rho & 15; return 8 * (i >> 2) + 4 * n + (i & 3); }

struct Unit { int pm, pn; };
struct Gemm { const bf16_t* A; const bf16_t* Bt; int M, N, K; };

struct StaticOrder {
    int nM, nN, nwg, G, c;
    __host__ __device__ void init(int M, int N, int G_, int c_) { nM = M / BM; nN = N / BM; nwg = nM * nN; G = G_; c = c_; }
    __host__ __device__ bool next(int i, Unit& u) const {
        const long L = (long)i * G + c; if (L >= nwg) return false;
        int wgid = (int)L; { const int q = nwg / NXCD, r = nwg % NXCD, xcd = wgid % NXCD, off = wgid / NXCD; wgid = (xcd < r ? xcd * (q + 1) : r * (q + 1) + (xcd - r) * q) + off; }
        const int nig = WGM * nN, gid = wgid / nig, fm = gid * WGM, gsz = (nM - fm) < WGM ? (nM - fm) : WGM;
        u.pm = fm + ((wgid % nig) % gsz); u.pn = (wgid % nig) / gsz; return true;
    }
    __device__ __forceinline__ void a_ready(const Unit&) const {}
    __device__ __forceinline__ void done(const Unit&) const {}
};

__device__ __forceinline__ unsigned cvt_pk_bf16(float lo, float hi) { unsigned r; asm volatile("v_cvt_pk_bf16_f32 %0, %1, %2" : "=v"(r) : "v"(lo), "v"(hi)); return r; }
typedef float f32x2 __attribute__((ext_vector_type(2)));
struct EpiF32 {
    static constexpr bool PERM = false, AFTER_DRAIN = false;
    float* C; int ldc;
    __device__ __forceinline__ void operator()(const f32x4 (&acc)[2][2][4][2], const Unit& u, int wr, int wc, int fr, int fq) const {
        const int row0 = u.pm * BM + wr * 64 + fr, col0 = u.pn * BM + wc * 32 + 4 * fq;
#pragma unroll
        for (int ai = 0; ai < 2; ++ai)
#pragma unroll
            for (int m = 0; m < 4; ++m) { float* rowp = C + (size_t)(row0 + ai * HALF + m * 16) * ldc + col0;
#pragma unroll
                for (int bj = 0; bj < 2; ++bj)
#pragma unroll
                    for (int n = 0; n < 2; ++n) *(f32x4*)(rowp + bj * HALF + n * 16) = acc[ai][bj][m][n]; }
    }
};
template <int ACT  > struct EpiBf16 {
    static constexpr bool PERM = true, AFTER_DRAIN = false;
    bf16_t* O; int ldc;
    __device__ __forceinline__ void operator()(const f32x4 (&acc)[2][2][4][2], const Unit& u, int wr, int wc, int fr, int fq) const {
        const int row0 = u.pm * BM + wr * 64 + fr; const int col0 = u.pn * BM + wc * 32 + 8 * fq;
#pragma unroll
        for (int ai = 0; ai < 2; ++ai)
#pragma unroll
            for (int m = 0; m < 4; ++m) { bf16_t* rowp = O + (size_t)(row0 + ai * HALF + m * 16) * ldc + col0;
#pragma unroll
                for (int bj = 0; bj < 2; ++bj) { f32x4 v0 = acc[ai][bj][m][0], v1 = acc[ai][bj][m][1];
                    if (ACT == 3) {
#pragma unroll
                        for (int j = 0; j < 4; ++j) { const float a = fmaxf(v0[j], 0.f), b = fmaxf(v1[j], 0.f); v0[j] = a * a; v1[j] = b * b; } }
                    u32x4 w; w.x = cvt_pk_bf16(v0[0], v0[1]); w.y = cvt_pk_bf16(v0[2], v0[3]); w.z = cvt_pk_bf16(v1[0], v1[1]); w.w = cvt_pk_bf16(v1[2], v1[3]);
                    *(u32x4*)(rowp + bj * HALF) = w; } }
    }
};
struct EpiQKV {
    static constexpr bool PERM = true, AFTER_DRAIN = false;
    bf16_t* O; int Mrows;
    __device__ __forceinline__ void operator()(const f32x4 (&acc)[2][2][4][2], const Unit& u, int wr, int wc, int fr, int fq) const {
        const int row0 = u.pm * BM + wr * 64 + fr;
#pragma unroll
        for (int bj = 0; bj < 2; ++bj) { bf16_t* hb = O + (size_t)(u.pn * 2 + bj) * Mrows * 128 + wc * 32 + 8 * fq;
#pragma unroll
            for (int ai = 0; ai < 2; ++ai)
#pragma unroll
                for (int m = 0; m < 4; ++m) { const f32x4 v0 = acc[ai][bj][m][0], v1 = acc[ai][bj][m][1];
                    u32x4 w; w.x = cvt_pk_bf16(v0[0], v0[1]); w.y = cvt_pk_bf16(v0[2], v0[3]); w.z = cvt_pk_bf16(v1[0], v1[1]); w.w = cvt_pk_bf16(v1[2], v1[3]);
                    *(u32x4*)(hb + (size_t)(row0 + ai * HALF + m * 16) * 128) = w; } }
    }
};
template <class Epi, class Sched, bool ALIGN_EPI = false, bool SP2 = false>
__device__ __forceinline__ void gemm_phase(PG8_LAS unsigned char* lds, const Gemm g, const Sched& S, const Epi& E) {
    int tid_ = threadIdx.x; asm volatile("" : "+v"(tid_));
    const int tid = tid_, wid = __builtin_amdgcn_readfirstlane(tid >> 6), lane = tid & 63, wr = wid >> 2, wc = wid & 3, fr = lane & 15, fq = lane >> 4;
    const int K = g.K, nt = K / BK;
    unsigned voffA[2], voffB[2];
#pragma unroll
    for (int i = 0; i < 2; ++i) { int R, C; stage_rc(tid * 16 + i * 8192, R, C); const int Rb = Epi::PERM ? ((R & ~31) + perm32(R & 31)) : R;
        voffA[i] = (unsigned)(R * K + C) * 2u; voffB[i] = (unsigned)(Rb * K + C) * 2u; }
    const size_t kstep = (size_t)(BK * 2);
    const size_t hstep = (size_t)HALF * K * 2;
    const size_t tstep = 2 * hstep;
    const unsigned ldsw = (unsigned)wid * 1024u;
    const int aoff = lds_byte(wr * 64 + fr, fq * 8), boff = lds_byte(wc * 32 + fr, fq * 8);
#define PG8_SA(b, h) (((b) * 2 + (h)) * HTB)
#define PG8_SB(b, h) ((4 + (b) * 2 + (h)) * HTB)
#define PG8_STAGE(bufoff, gbase, voff) do { _Pragma("unroll") for (int _i = 0; _i < 2; ++_i) \
        __builtin_amdgcn_global_load_lds((const unsigned*)((const char*)(gbase) + (voff)[_i]), (PG8_LAS unsigned*)(lds + (bufoff) + ldsw + _i * 8192), 16, 0, 0); } while (0)
#define PG8_LDA(dst, b, h) do { _Pragma("unroll") for (int m = 0; m < 4; ++m) _Pragma("unroll") for (int k = 0; k < 2; ++k) dst[m][k] = *(const PG8_LAS bf16x8*)(lds + PG8_SA(b, h) + aoff + m * 2048 + k * 1024); } while (0)
#define PG8_LDB(dst, b, h) do { _Pragma("unroll") for (int n = 0; n < 2; ++n) _Pragma("unroll") for (int k = 0; k < 2; ++k) dst[n][k] = *(const PG8_LAS bf16x8*)(lds + PG8_SB(b, h) + boff + n * 2048 + k * 1024); } while (0)
#define PG8_MMA(ai, bj, At, Bt) do { __builtin_amdgcn_s_setprio(1); _Pragma("unroll") for (int m = 0; m < 4; ++m) _Pragma("unroll") for (int n = 0; n < 2; ++n) _Pragma("unroll") for (int k = 0; k < 2; ++k) \
        acc[ai][bj][m][n] = __builtin_amdgcn_mfma_f32_16x16x32_bf16(Bt[n][k], At[m][k], acc[ai][bj][m][n], 0, 0, 0); __builtin_amdgcn_s_setprio(0); } while (0)
#define PG8_WAIT_V(n) asm volatile("s_waitcnt vmcnt(" #n ")" ::: "memory")
#define PG8_WAIT_L(n) asm volatile("s_waitcnt lgkmcnt(" #n ")" ::: "memory")
#define PG8_BAR __builtin_amdgcn_s_barrier()
#define PG8_SCHED __builtin_amdgcn_sched_barrier(0)
    Unit cur, nxt; int ui = 0;
    if (!S.next(0, cur)) return;
    f32x4 acc[2][2][4][2];
#pragma unroll
    for (int a = 0; a < 2; ++a)
#pragma unroll
        for (int b = 0; b < 2; ++b)
#pragma unroll
            for (int m = 0; m < 4; ++m)
#pragma unroll
                for (int n = 0; n < 2; ++n) acc[a][b][m][n] = (f32x4){0.f, 0.f, 0.f, 0.f};
    bf16x8 At[4][2], B0[2][2], B1[2][2];
    const char* cA = (const char*)g.A + (size_t)cur.pm * tstep; const char* cB = (const char*)g.Bt + (size_t)cur.pn * tstep;
    S.a_ready(cur);
    if constexpr (SP2) {
        PG8_STAGE(PG8_SB(0, 0), cB, voffB); PG8_STAGE(PG8_SB(0, 1), cB + hstep, voffB); PG8_STAGE(PG8_SA(0, 0), cA, voffA); PG8_STAGE(PG8_SA(0, 1), cA + hstep, voffA);
        if (wr == 1) PG8_BAR;
        PG8_WAIT_V(2); PG8_BAR;
        PG8_STAGE(PG8_SB(1, 0), cB + kstep, voffB); PG8_STAGE(PG8_SA(1, 0), cA + kstep, voffA); PG8_STAGE(PG8_SB(1, 1), cB + hstep + kstep, voffB);
        PG8_WAIT_V(6); PG8_BAR;
    } else {
        PG8_STAGE(PG8_SB(0, 0), cB, voffB); PG8_STAGE(PG8_SA(0, 0), cA, voffA); PG8_STAGE(PG8_SB(0, 1), cB + hstep, voffB); PG8_STAGE(PG8_SA(0, 1), cA + hstep, voffA);
        if (wr == 1) PG8_BAR;
        PG8_WAIT_V(4); PG8_BAR;
        PG8_STAGE(PG8_SB(1, 0), cB + kstep, voffB); PG8_STAGE(PG8_SA(1, 0), cA + kstep, voffA); PG8_STAGE(PG8_SB(1, 1), cB + hstep + kstep, voffB);
        PG8_WAIT_V(6); PG8_BAR;
    }
    for (;;) {
        const bool has_next = S.next(ui + 1, nxt);
        const char* nA = has_next ? (const char*)g.A + (size_t)nxt.pm * tstep : cA; const char* nB = has_next ? (const char*)g.Bt + (size_t)nxt.pn * tstep : cB;
        for (int t = 0; t < nt; t += 2) {
            const bool last = (t == nt - 2);
            const char* a1 = cA + (size_t)(t + 1) * kstep;
            const char* a2 = last ? nA : cA + (size_t)(t + 2) * kstep; const char* b2 = last ? nB : cB + (size_t)(t + 2) * kstep;
            const char* a3 = a2 + kstep; const char* b3 = b2 + kstep;
            if (last && has_next) S.a_ready(nxt);
            if constexpr (SP2) {
            PG8_LDB(B0, 0, 0); PG8_LDB(B1, 0, 1); PG8_SCHED; PG8_LDA(At, 0, 0); PG8_STAGE(PG8_SA(1, 1), a1 + hstep, voffA);
            PG8_WAIT_V(8); PG8_WAIT_L(0); PG8_BAR; PG8_MMA(0, 0, At, B0); PG8_MMA(0, 1, At, B1); PG8_BAR; PG8_SCHED;
            PG8_LDA(At, 0, 1); PG8_STAGE(PG8_SB(0, 0), b2, voffB); PG8_STAGE(PG8_SB(0, 1), b2 + hstep, voffB); PG8_STAGE(PG8_SA(0, 0), a2, voffA);
            PG8_WAIT_V(8); PG8_WAIT_L(0); PG8_BAR; PG8_MMA(1, 0, At, B0); PG8_MMA(1, 1, At, B1); PG8_BAR; PG8_SCHED;
            PG8_LDB(B0, 1, 0); PG8_LDB(B1, 1, 1); PG8_SCHED; PG8_LDA(At, 1, 0); PG8_STAGE(PG8_SA(0, 1), a2 + hstep, voffA);
            PG8_WAIT_V(8); PG8_WAIT_L(0); PG8_BAR; PG8_MMA(0, 0, At, B0); PG8_MMA(0, 1, At, B1); PG8_BAR; PG8_SCHED;
            PG8_LDA(At, 1, 1); PG8_STAGE(PG8_SB(1, 0), b3, voffB); PG8_STAGE(PG8_SB(1, 1), b3 + hstep, voffB); PG8_STAGE(PG8_SA(1, 0), a3, voffA);
            PG8_WAIT_V(8); PG8_WAIT_L(0); PG8_BAR; PG8_MMA(1, 0, At, B0); PG8_MMA(1, 1, At, B1); PG8_BAR; PG8_SCHED;
            } else {
            PG8_LDB(B0, 0, 0); PG8_SCHED; PG8_LDA(At, 0, 0); PG8_STAGE(PG8_SA(1, 1), a1 + hstep, voffA);
            PG8_WAIT_L(8); PG8_BAR; PG8_WAIT_L(0); PG8_MMA(0, 0, At, B0); PG8_BAR; PG8_SCHED;
            PG8_LDB(B1, 0, 1); PG8_STAGE(PG8_SB(0, 0), b2, voffB);
            PG8_BAR; PG8_WAIT_L(0); PG8_MMA(0, 1, At, B1); PG8_BAR;
            PG8_LDA(At, 0, 1); PG8_STAGE(PG8_SA(0, 0), a2, voffA);
            PG8_BAR; PG8_WAIT_L(0); PG8_MMA(1, 0, At, B0); PG8_BAR; PG8_SCHED;
            PG8_STAGE(PG8_SB(0, 1), b2 + hstep, voffB);
            PG8_WAIT_V(6); PG8_BAR; PG8_MMA(1, 1, At, B1); PG8_BAR;
            PG8_LDB(B0, 1, 0); PG8_SCHED; PG8_LDA(At, 1, 0); PG8_STAGE(PG8_SA(0, 1), a2 + hstep, voffA);
            PG8_WAIT_L(8); PG8_BAR; PG8_WAIT_L(0); PG8_MMA(0, 0, At, B0); PG8_BAR; PG8_SCHED;
            PG8_LDB(B1, 1, 1); PG8_STAGE(PG8_SB(1, 0), b3, voffB);
            PG8_BAR; PG8_WAIT_L(0); PG8_MMA(0, 1, At, B1); PG8_BAR;
            PG8_LDA(At, 1, 1); PG8_STAGE(PG8_SA(1, 0), a3, voffA);
            PG8_BAR; PG8_WAIT_L(0); PG8_MMA(1, 0, At, B0); PG8_BAR; PG8_SCHED;
            PG8_STAGE(PG8_SB(1, 1), b3 + hstep, voffB);
            PG8_WAIT_V(6); PG8_BAR; PG8_MMA(1, 1, At, B1); PG8_BAR;
            }
        }
        if constexpr (ALIGN_EPI) { if (wr == 0) PG8_BAR; }
        if constexpr (!Epi::AFTER_DRAIN) { E(acc, cur, wr, wc, fr, fq); S.done(cur); }
        if (!has_next) break;
#pragma unroll
        for (int a = 0; a < 2; ++a)
#pragma unroll
            for (int b = 0; b < 2; ++b)
#pragma unroll
                for (int m = 0; m < 4; ++m)
#pragma unroll
                    for (int n = 0; n < 2; ++n) acc[a][b][m][n] = (f32x4){0.f, 0.f, 0.f, 0.f};
        cur = nxt; cA = nA; cB = nB; ++ui;
        if constexpr (ALIGN_EPI) { if (wr == 1) PG8_BAR; }
    }
    PG8_WAIT_V(0);
    if constexpr (!ALIGN_EPI) { if (wr == 0) PG8_BAR; }
    PG8_BAR;
    if constexpr (Epi::AFTER_DRAIN) { E.fused(acc, cur, wr, wc, fr, fq, lds, wid, lane); S.done(cur); }
#undef PG8_SA
#undef PG8_SB
#undef PG8_STAGE
#undef PG8_LDA
#undef PG8_LDB
#undef PG8_MMA
#undef PG8_WAIT_V
#undef PG8_WAIT_L
#undef PG8_BAR
#undef PG8_SCHED
}
}
namespace att {
typedef unsigned short bf16;
using bf16x8 = __attribute__((ext_vector_type(8))) short;
using s16x4  = __attribute__((ext_vector_type(4))) short;
using f32x16 = __attribute__((ext_vector_type(16))) float;
using u32x4  = __attribute__((ext_vector_type(4))) unsigned;
constexpr int   D = 128, NW = 8, QBLK = 32, KVBLK = 64;
constexpr float SCALE = 0.088388347648318440f;
constexpr float LOG2E = 1.4426950408889634f;
constexpr float C2 = SCALE * LOG2E;
constexpr float THR = 8.f;
constexpr int SHM_V = KVBLK * D * 2, SHM_K = KVBLK * D * 2;
constexpr int LDS_WS = 2 * SHM_V + 2 * SHM_K, LDS_TB = LDS_WS + NW * 64 * 4, LDS_ATT_BYTES = LDS_TB + 4096;
#define KSWZ(row, colB) ((row) * 256 + ((colB) ^ (((row) & 7) << 4)))
#define SBAR() __builtin_amdgcn_sched_barrier(0)
__device__ __forceinline__ int crow(int r, int hi) { return (r & 3) + 8 * (r >> 2) + 4 * hi; }
__device__ __forceinline__ unsigned cvtpk(float lo, float hi) { unsigned r; asm volatile("v_cvt_pk_bf16_f32 %0, %1, %2" : "=v"(r) : "v"(lo), "v"(hi)); return r; }
__device__ __forceinline__ bf16x8 ld8(const bf16* p) { return *reinterpret_cast<const bf16x8*>(p); }

struct MaskCtx { int a, v, d; const float* tbl; };
constexpr int TB_ORG = 256;

__device__ __forceinline__ void partialSM(f32x16& p0, f32x16& p1, float& m_reg, float& mn, float& alpha) {
  float pmax = p0[0];
#pragma unroll
  for (int r = 1; r < 16; ++r) pmax = fmaxf(pmax, p0[r]);
#pragma unroll
  for (int r = 0; r < 16; ++r) pmax = fmaxf(pmax, p1[r]);
  { auto rr = __builtin_amdgcn_permlane32_swap(__float_as_uint(pmax), __float_as_uint(pmax), false, false);
    pmax = fmaxf(__uint_as_float(rr[0]), __uint_as_float(rr[1])); }
  if (__builtin_expect(__all(pmax - m_reg <= THR / SCALE), 1)) { mn = m_reg; alpha = 1.f; }
  else { mn = fmaxf(m_reg, pmax); alpha = __builtin_amdgcn_exp2f((m_reg - mn) * C2); m_reg = mn; }
  float mnC = -mn * C2;
#pragma unroll
  for (int r = 0; r < 16; ++r) p0[r] = fmaf(p0[r], C2, mnC);
#pragma unroll
  for (int r = 0; r < 16; ++r) p1[r] = fmaf(p1[r], C2, mnC);
#pragma unroll
  for (int r = 0; r < 16; ++r) p0[r] = __builtin_amdgcn_exp2f(p0[r]);
}
template <int KIND>
__device__ __forceinline__ void partialSM_m(f32x16& p0, f32x16& p1, float& m_reg, float& mn, float& alpha, int jt, const MaskCtx& mc) {
  const float* tp = (KIND == 1) ? mc.tbl + (jt - mc.a + 7) * 31 : mc.tbl + jt * 64;
  float b0[16], b1[16];
#pragma unroll
  for (int r = 0; r < 16; ++r) { const int kc = (r & 3) + 8 * (r >> 2); b0[r] = tp[kc]; b1[r] = tp[kc + 32]; }
#pragma unroll
  for (int r = 0; r < 16; ++r) asm volatile("" : "+v"(b0[r]), "+v"(b1[r]));
  if (KIND == 1) {
    const bool rowok = (unsigned)(jt - min(max(mc.a - 4, 0), 120)) <= 7u;
#pragma unroll
    for (int r = 0; r < 16; ++r) { const int kc = (r & 3) + 8 * (r >> 2);
      { const bool ok = rowok && (unsigned)(kc - mc.v) <= 15u; const float t = fmaf(p0[r], C2, b0[r]); p0[r] = ok ? t : -1e30f; }
      { const bool ok = rowok && (unsigned)(kc + 32 - mc.v) <= 15u; const float t = fmaf(p1[r], C2, b1[r]); p1[r] = ok ? t : -1e30f; } }
  } else {
    const bool tok = (unsigned)jt < (unsigned)mc.d;
    const int db = jt * 64 + mc.v;
#pragma unroll
    for (int r = 0; r < 16; ++r) { const int kc = (r & 3) + 8 * (r >> 2);
      { const bool ok = tok && (unsigned)(db + kc) <= 128u; const float t = fmaf(p0[r], C2, b0[r]); p0[r] = ok ? t : -1e30f; }
      { const bool ok = tok && (unsigned)(db + kc + 32) <= 128u; const float t = fmaf(p1[r], C2, b1[r]); p1[r] = ok ? t : -1e30f; } }
  }
  float pmax = p0[0];
#pragma unroll
  for (int r = 1; r < 16; ++r) pmax = fmaxf(pmax, p0[r]);
#pragma unroll
  for (int r = 0; r < 16; ++r) pmax = fmaxf(pmax, p1[r]);
  { auto rr = __builtin_amdgcn_permlane32_swap(__float_as_uint(pmax), __float_as_uint(pmax), false, false);
    pmax = fmaxf(__uint_as_float(rr[0]), __uint_as_float(rr[1])); }
  if (__builtin_expect(__all(pmax - m_reg <= THR * LOG2E), 1)) { mn = m_reg; alpha = 1.f; }
  else { mn = fmaxf(m_reg, pmax); alpha = __builtin_amdgcn_exp2f(m_reg - mn); m_reg = mn; }
#pragma unroll
  for (int r = 0; r < 16; ++r) p0[r] -= mn;
#pragma unroll
  for (int r = 0; r < 16; ++r) p1[r] -= mn;
#pragma unroll
  for (int r = 0; r < 16; ++r) p0[r] = __builtin_amdgcn_exp2f(p0[r]);
}
__device__ __forceinline__ void finishSM(f32x16& p0, f32x16& p1, float alpha, float& l_reg, bf16x8& pa0, bf16x8& pa1, bf16x8& pa2, bf16x8& pa3) {
#pragma unroll
  for (int r = 0; r < 16; ++r) p1[r] = __builtin_amdgcn_exp2f(p1[r]);
  float ps = 0;
#pragma unroll
  for (int r = 0; r < 16; ++r) ps += p0[r];
#pragma unroll
  for (int r = 0; r < 16; ++r) ps += p1[r];
  { auto rr = __builtin_amdgcn_permlane32_swap(__float_as_uint(ps), __float_as_uint(ps), false, false);
    ps = __uint_as_float(rr[0]) + __uint_as_float(rr[1]); }
  l_reg = l_reg * alpha + ps;
#define PK4(P, BASE, OUT) do { unsigned a0 = cvtpk(P[BASE + 0], P[BASE + 1]), a1 = cvtpk(P[BASE + 2], P[BASE + 3]);   \
    unsigned b0 = cvtpk(P[BASE + 4], P[BASE + 5]), b1 = cvtpk(P[BASE + 6], P[BASE + 7]);                              \
    auto r0 = __builtin_amdgcn_permlane32_swap(a0, b0, false, false); auto r1 = __builtin_amdgcn_permlane32_swap(a1, b1, false, false); \
    u32x4 w = {r0[0], r1[0], r0[1], r1[1]}; OUT = *reinterpret_cast<bf16x8*>(&w); } while (0)
  PK4(p0, 0, pa0); PK4(p0, 8, pa1); PK4(p1, 0, pa2); PK4(p1, 8, pa3);
#undef PK4
}
__device__ __forceinline__ void qkt(f32x16& p0, f32x16& p1, const bf16* Ks, const bf16x8* qr, int r32, int hi) {
  p0 = f32x16{}; p1 = f32x16{};
#pragma unroll
  for (int d0 = 0; d0 < 8; ++d0) { int cb = (d0 * 16 + hi * 8) * 2;
    bf16x8 b0 = *reinterpret_cast<const bf16x8*>((const char*)Ks + KSWZ(r32, cb));
    bf16x8 b1 = *reinterpret_cast<const bf16x8*>((const char*)Ks + KSWZ(32 + r32, cb));
    p0 = __builtin_amdgcn_mfma_f32_32x32x16_bf16(b0, qr[d0], p0, 0, 0, 0);
    p1 = __builtin_amdgcn_mfma_f32_32x32x16_bf16(b1, qr[d0], p1, 0, 0, 0); }
}
__device__ __forceinline__ int v_st(int k, int c) { const int kk = (k & ~0xC) | ((k & 4) << 1) | ((k & 8) >> 1); return ((kk >> 3) * 4 + (c >> 5)) * 512 + ((kk & 7) * 32 + (c & 31)) * 2; }
__device__ __forceinline__ int v_rd_base(int lane) { return ((lane & 3) << 3) | (((lane >> 2) & 3) << 6) | (((lane >> 4) & 1) << 5) | (((lane >> 5) & 1) << 8); }
constexpr int v_rd_off(int d0, int ks, int half) { return d0 * 512 + ks * 4096 + half * 2048; }
template <int OFF> __device__ __forceinline__ s16x4 tr_read(int vb) {
  s16x4 r; asm volatile("ds_read_b64_tr_b16 %0, %1 offset:%2" : "=&v"(r) : "v"(vb), "i"(OFF) : "memory"); return r;
}
template <int D0> __device__ __forceinline__ void pv_one(f32x16& od, int vb, bf16x8 pa0, bf16x8 pa1, bf16x8 pa2, bf16x8 pa3) {
  const s16x4 l0 = tr_read<v_rd_off(D0, 0, 0)>(vb), h0 = tr_read<v_rd_off(D0, 0, 1)>(vb), l1 = tr_read<v_rd_off(D0, 1, 0)>(vb), h1 = tr_read<v_rd_off(D0, 1, 1)>(vb);
  const s16x4 l2 = tr_read<v_rd_off(D0, 2, 0)>(vb), h2 = tr_read<v_rd_off(D0, 2, 1)>(vb), l3 = tr_read<v_rd_off(D0, 3, 0)>(vb), h3 = tr_read<v_rd_off(D0, 3, 1)>(vb);
  asm volatile("s_waitcnt lgkmcnt(0)" ::: "memory"); SBAR();
#define PK(L, H) (bf16x8){L[0], L[1], L[2], L[3], H[0], H[1], H[2], H[3]}
  od = __builtin_amdgcn_mfma_f32_32x32x16_bf16(pa0, PK(l0, h0), od, 0, 0, 0);
  od = __builtin_amdgcn_mfma_f32_32x32x16_bf16(pa1, PK(l1, h1), od, 0, 0, 0);
  od = __builtin_amdgcn_mfma_f32_32x32x16_bf16(pa2, PK(l2, h2), od, 0, 0, 0);
  od = __builtin_amdgcn_mfma_f32_32x32x16_bf16(pa3, PK(l3, h3), od, 0, 0, 0);
#undef PK
}
__device__ __forceinline__ void pv_d0(f32x16* o, int vb, bf16x8 pa0, bf16x8 pa1, bf16x8 pa2, bf16x8 pa3) {
  pv_one<0>(o[0], vb, pa0, pa1, pa2, pa3); pv_one<1>(o[1], vb, pa0, pa1, pa2, pa3); pv_one<2>(o[2], vb, pa0, pa1, pa2, pa3); pv_one<3>(o[3], vb, pa0, pa1, pa2, pa3);
}

template <int KIND>
__device__ __forceinline__ void attn_unit(const bf16* __restrict__ Qb, long qs, const bf16* __restrict__ Kh, const bf16* __restrict__ Vh, long ks,
                                          int kt0, int NT, int ktmax, bf16* __restrict__ Ob, long os, float* __restrict__ stp, long sts,
                                          int mq0, const float* __restrict__ tbsrc, int tbn, char* lds) {
  int tid_ = threadIdx.x; asm volatile("" : "+v"(tid_));
  const int tid = tid_, wid = __builtin_amdgcn_readfirstlane(tid >> 6), lane = tid & 63, r32 = lane & 31, hi = lane >> 5;
  bf16* V_lds = (bf16*)lds; bf16* K_lds = (bf16*)(lds + 2 * SHM_V);
  float* ws = (float*)(lds + LDS_WS) + wid * 64; float* li_l = ws; float* al_l = ws + 32;
  float* tb = (float*)(lds + LDS_TB);
  MaskCtx mc; mc.a = 0; mc.v = 0; mc.d = 0; mc.tbl = tb;
  if (KIND == 1) { const int r = mq0 + (wid >> 1), c = (wid & 1) * 32 + r32; mc.a = r; mc.v = min(max(c - 8, 0), 48) - 4 * hi; mc.tbl = tb + TB_ORG + 15 - c + 4 * hi; }
  if (KIND == 2) { mc.v = 64 - (mq0 + wid * 32 + r32) + 4 * hi; mc.d = ktmax; mc.tbl = tb + TB_ORG + mc.v; }
  if (KIND != 0) { __syncthreads();
    for (int i = tid; i < tbn; i += 64 * NW) tb[TB_ORG + i] = tbsrc[i] * LOG2E; }
  float m_reg = -1e30f, l_reg = 0; f32x16 o[4] = {}; bf16x8 qr[8];
  const bf16* Qw = Qb + (long)(wid * QBLK + r32) * qs + hi * 8;
#pragma unroll
  for (int d0 = 0; d0 < 8; ++d0) qr[d0] = ld8(Qw + d0 * 16);
  const int sr = tid >> 4, sc = (tid & 15) * 8, vst0 = v_st(sr, sc), vst1 = v_st(32 + sr, sc);
  const int vb0 = (int)(uintptr_t)V_lds + v_rd_base(lane);
  const bf16* Kp = Kh + (long)sr * ks + sc; const bf16* Vp = Vh + (long)sr * ks + sc; const long o32 = 32 * ks, tstep = 64 * ks;
  struct { bf16x8 vs0, vs1, ks0, ks1; } sr_[2];
#define TCL(j) ((long)min(max(kt0 + (j), 0), ktmax - 1))
#define SLOAD(i, j) do { const long off_ = TCL(j) * tstep; sr_[i].vs0 = ld8(Vp + off_); sr_[i].vs1 = ld8(Vp + off_ + o32); sr_[i].ks0 = ld8(Kp + off_); sr_[i].ks1 = ld8(Kp + off_ + o32); } while (0)
#define SWRITE(b, i) do { *(bf16x8*)((char*)V_lds + (b) * SHM_V + vst0) = sr_[i].vs0;          \
    *(bf16x8*)((char*)V_lds + (b) * SHM_V + vst1) = sr_[i].vs1; int kc = sc * 2;               \
    *(bf16x8*)((char*)K_lds + (b) * SHM_K + KSWZ(sr, kc)) = sr_[i].ks0;                       \
    *(bf16x8*)((char*)K_lds + (b) * SHM_K + KSWZ(32 + sr, kc)) = sr_[i].ks1; } while (0)
#define SWAIT() asm volatile("s_waitcnt vmcnt(4)" ::: "memory")
#define RESC(a) do { if (__any((a) < 1.f)) { if (hi == 0) al_l[r32] = (a); asm volatile("s_waitcnt lgkmcnt(0)" ::: "memory"); \
    _Pragma("unroll") for (int d = 0; d < 4; ++d) _Pragma("unroll") for (int r = 0; r < 16; ++r) o[d][r] *= al_l[crow(r, hi)]; } } while (0)
  bf16x8 pa0, pa1, pa2, pa3;
  if constexpr (KIND == 0) {
    f32x16 pA0, pA1, pB0, pB1; float mnA, mnB, alA, alB;
    constexpr int SE = 0, SO = 1;
    SLOAD(SE, 0); asm volatile("s_waitcnt vmcnt(0)" ::: "memory"); SWRITE(0, SE); __syncthreads();
    qkt(pA0, pA1, K_lds, qr, r32, hi); partialSM(pA0, pA1, m_reg, mnA, alA);
    SLOAD(SO, 1); if (2 < NT) SLOAD(SE, 2);
    SWAIT(); SWRITE(1, SO); __syncthreads();
    for (int j = 1; j + 1 < NT; j += 2) {
      SBAR(); qkt(pB0, pB1, (bf16*)((char*)K_lds + SHM_K), qr, r32, hi);
      finishSM(pA0, pA1, alA, l_reg, pa0, pa1, pa2, pa3); SBAR();
      SLOAD(SO, j + 2); SBAR();
      pv_d0(o, vb0, pa0, pa1, pa2, pa3); partialSM(pB0, pB1, m_reg, mnB, alB);
      __syncthreads(); SWAIT(); SWRITE(0, SE);
      RESC(alB); __syncthreads();
      SBAR(); qkt(pA0, pA1, K_lds, qr, r32, hi);
      finishSM(pB0, pB1, alB, l_reg, pa0, pa1, pa2, pa3); SBAR();
      if (j + 3 < NT) SLOAD(SE, j + 3); SBAR();
      pv_d0(o, vb0 + (int)SHM_V, pa0, pa1, pa2, pa3); partialSM(pA0, pA1, m_reg, mnA, alA);
      __syncthreads(); SWAIT(); SWRITE(1, SO);
      RESC(alA); __syncthreads();
    }
    SBAR(); qkt(pB0, pB1, (bf16*)((char*)K_lds + SHM_K), qr, r32, hi);
    finishSM(pA0, pA1, alA, l_reg, pa0, pa1, pa2, pa3); SBAR();
    pv_d0(o, vb0, pa0, pa1, pa2, pa3); partialSM(pB0, pB1, m_reg, mnB, alB);
    __syncthreads(); RESC(alB);
    finishSM(pB0, pB1, alB, l_reg, pa0, pa1, pa2, pa3); SBAR();
    pv_d0(o, vb0 + (int)SHM_V, pa0, pa1, pa2, pa3);
  } else {
    const int nd_lo = (KIND == 1) ? min(max(mq0 + (wid >> 1) - 4, 0), 120) : (mq0 + 32 * wid - 127);
    const int nd_hi = mq0 + 32 * wid + 95;
#define NEED(jt) ((KIND == 1) ? ((unsigned)((jt) - nd_lo) <= 7u) : ((unsigned)(jt) < (unsigned)ktmax && 64 * (jt) >= nd_lo && 64 * (jt) <= nd_hi))
    f32x16 p0, p1; float mn, al;
    SLOAD(0, 0); SLOAD(1, 1);
#define STEP(J, B) do { SWRITE(B, B); if ((J) + 2 < NT) SLOAD(B, (J) + 2); __syncthreads();                                     \
      if (NEED(kt0 + (J))) { qkt(p0, p1, (bf16*)((char*)K_lds + (B) * SHM_K), qr, r32, hi); partialSM_m<KIND>(p0, p1, m_reg, mn, al, kt0 + (J), mc); RESC(al); \
        finishSM(p0, p1, al, l_reg, pa0, pa1, pa2, pa3); SBAR(); pv_d0(o, vb0 + (B) * (int)SHM_V, pa0, pa1, pa2, pa3); } } while (0)
    for (int j = 0; j < NT; j += 2) { STEP(j, 0); STEP(j + 1, 1); }
#undef STEP
#undef NEED
  }
  if (hi == 0) li_l[r32] = l_reg; asm volatile("s_waitcnt lgkmcnt(0)" ::: "memory");
  if (KIND == 2) { if (hi == 0) { float* sp = stp + (long)(wid * QBLK + r32) * sts; sp[0] = m_reg; sp[1] = l_reg; } }
  float rli[16];
#pragma unroll
  for (int r = 0; r < 16; ++r) rli[r] = __builtin_amdgcn_rcpf(li_l[crow(r, hi)]);
  bf16* Ow = Ob + (long)(wid * QBLK) * os;
#pragma unroll
  for (int r = 0; r < 16; ++r) { const int orow = crow(r, hi);
#pragma unroll
    for (int d0 = 0; d0 < 4; ++d0) { const float v = o[d0][r] * rli[r]; Ow[(long)orow * os + d0 * 32 + r32] = (bf16)(cvtpk(v, v) & 0xffffu); } }
#undef TCL
#undef SLOAD
#undef SWRITE
#undef SWAIT
#undef RESC
}
}
#define GAS __attribute__((address_space(1)))
#define LAS __attribute__((address_space(3)))
typedef unsigned short bf16;
typedef unsigned v4u __attribute__((ext_vector_type(4)));
typedef float f32x4 __attribute__((ext_vector_type(4)));
typedef short bf16x8 __attribute__((ext_vector_type(8)));
typedef GAS unsigned gu32;
typedef GAS unsigned long long gu64;
#define RLX_AGENT __ATOMIC_RELAXED, __HIP_MEMORY_SCOPE_AGENT
#define LDS_WAIT() asm volatile("s_waitcnt lgkmcnt(0)" ::: "memory")
#define VM_WAIT() asm volatile("s_waitcnt vmcnt(0)" ::: "memory")
__device__ __forceinline__ unsigned long long rt() { return __builtin_amdgcn_s_memrealtime(); }
__device__ __forceinline__ unsigned f2bf(float f) { unsigned u = __builtin_bit_cast(unsigned, f); return (u + 0x7fffu + ((u >> 16) & 1u)) >> 16; }
__device__ __forceinline__ unsigned pk2(float lo, float hi) { return f2bf(lo) | (f2bf(hi) << 16); }

#define XB_TMO      128
#define XB_XCNT(j)  (256  + 64 * (j))
#define XB_XSUB(j)  (1280 + 64 * (j))
#define XB_XGEN(j)  (2304 + 64 * (j))
#define XB_TOP      3328
#define XB_TOPGEN   3392
#define XCD_BAR_WORDS 3456
#define XB_SPIN_CAP (1u << 18)

__device__ __forceinline__ unsigned xb_ld(unsigned* p)              { return __hip_atomic_load(p, __ATOMIC_RELAXED, __HIP_MEMORY_SCOPE_AGENT); }
__device__ __forceinline__ unsigned xb_add(unsigned* p, unsigned v) { return __hip_atomic_fetch_add(p, v, __ATOMIC_RELAXED, __HIP_MEMORY_SCOPE_AGENT); }
__device__ __forceinline__ unsigned xb_xcc_id() { return (unsigned)__builtin_amdgcn_s_getreg((3 << 11) | 20) & 0xFu; }
#define XB_SPIN(cond, bar) do { unsigned _sp = 0; while (cond) { __builtin_amdgcn_s_sleep(1); \
    if ((++_sp & 255u) == 0u) { if (xb_ld(&(bar)[XB_TMO])) break; if (_sp > XB_SPIN_CAP) { atomicAdd(&(bar)[XB_TMO], 1u); break; } } } } while (0)

struct XcdBarrier {
    unsigned* bar; unsigned x;
    volatile LAS unsigned* st;
};

__device__ __forceinline__ XcdBarrier xcd_barrier_post(unsigned* bar, volatile LAS unsigned* st) {
    XcdBarrier b; b.bar = bar; b.x = xb_xcc_id(); b.st = st;
    if (threadIdx.x == 0) (void)xb_add(&bar[XB_XCNT(b.x)], 1u);
    return b;
}
__device__ __forceinline__ void xcd_barrier_complete(unsigned* bar, unsigned x, unsigned& nloc, unsigned& nx) {
    const unsigned G = gridDim.x * gridDim.y * gridDim.z;
    unsigned sum, cnt, mine, sp = 0u;
    for (;;) {
        sum = 0u; cnt = 0u; mine = 0u;
#pragma unroll
        for (unsigned j = 0; j < 16; ++j) { const unsigned c = xb_ld(&bar[XB_XCNT(j)]); sum += c; cnt += (c > 0u) ? 1u : 0u; mine = (j == x) ? c : mine; }
        if (sum == G) break;
        __builtin_amdgcn_s_sleep(1);
        if ((++sp & 255u) == 0u) { if (xb_ld(&bar[XB_TMO])) break; if (sp > XB_SPIN_CAP) { atomicAdd(&bar[XB_TMO], 1u); break; } }
    }
    nloc = mine > 0u ? mine : 1u; nx = cnt > 0u ? cnt : 1u;
}

__device__ __forceinline__ void xcd_barrier(const XcdBarrier& b) {
    asm volatile("s_waitcnt vmcnt(0)" ::: "memory");
    __syncthreads();
    if (threadIdx.x == 0) {
        unsigned* bar = b.bar;
        __builtin_amdgcn_s_waitcnt(0);
        unsigned nloc = b.st[0], nx = b.st[1];
        if (nloc == 0u) { xcd_barrier_complete(bar, b.x, nloc, nx); b.st[0] = nloc; b.st[1] = nx; }
        const unsigned old = xb_add(&bar[XB_XSUB(b.x)], 1u);
        const unsigned gen = old / nloc;
        if (old + 1u == (gen + 1u) * nloc) {
            __builtin_amdgcn_fence(__ATOMIC_RELEASE, "agent");
            asm volatile("s_waitcnt vmcnt(0)" ::: "memory");
            const unsigned og = xb_add(&bar[XB_TOP], 1u);
            const unsigned tg = og / nx;
            if (og + 1u == (tg + 1u) * nx) xb_add(&bar[XB_TOPGEN], 1u);
            else XB_SPIN(xb_ld(&bar[XB_TOPGEN]) == tg, bar);
            __builtin_amdgcn_fence(__ATOMIC_ACQUIRE, "agent");
            xb_add(&bar[XB_XGEN(b.x)], 1u);
            asm volatile("s_waitcnt vmcnt(0)" ::: "memory");
        } else {
            XB_SPIN(xb_ld(&bar[XB_XGEN(b.x)]) == gen, bar);
            __builtin_amdgcn_fence(__ATOMIC_ACQUIRE, "agent");
            asm volatile("s_waitcnt vmcnt(0)" ::: "memory");
        }
    }
    __syncthreads();
}
constexpr int BATCH = 2, SEQ = 8192, DM = 4096, DEPTH = 4, HDIM = 128, H_NA = 8, H_DIL = 12, H_GQA = 12, KV_GQA = 4;
constexpr int NQKV = 10240, DFF = 16384, M = BATCH * SEQ, NMOD = 6;
constexpr int Q_NA = 0, Q_DIL = 1024, Q_GQA = 2560, K_NA = 4096, K_DIL = 5120, K_GQA = 6656, V_NA = 7168, V_DIL = 8192, V_GQA = 9728;
constexpr int O_NA = 0, O_DIL = 1024, O_GQA = 2560, DILW = H_DIL * HDIM;
constexpr float EPS = 1e-6f;
constexpr size_t MiB = 1u << 20;
constexpr size_t WS_CTL = 0, CTL_ZERO_BYTES = 1 * MiB;
constexpr size_t WS_MODP = 1 * MiB;
constexpr size_t WS_MODV = 4 * MiB;
constexpr size_t WS_ROPE = 5 * MiB;
constexpr size_t WS_DILTB = 5 * MiB + 64 * 1024;
constexpr size_t WS_DILST = 6 * MiB;
constexpr size_t WS_WIN = 16 * MiB, WS_WOUT = 336 * MiB, WS_W1 = 464 * MiB, WS_W2 = 976 * MiB;
constexpr size_t WS_H = 1488 * MiB, WS_QKV = 1616 * MiB, WS_O = 1936 * MiB, WS_Y = 2064 * MiB, WS_U = 2320 * MiB, WS_DILP = 2832 * MiB, WS_XB = 2976 * MiB, WS_END = 3104 * MiB;
static_assert(WS_DILST + (size_t)3 * M * 12 * 2 * 4 <= WS_WIN, "ws map");
constexpr int CW_BAR = 4096, CW_QUEUE = 16384;
constexpr int RING_OFF = 0, RING_BYTES = 131072, LDSCTL_OFF = RING_BYTES, MISC_OFF = LDSCTL_OFF + 320, LDS_BYTES = 147456;
constexpr int NWAVES = 8;

struct Frame {
    LAS unsigned char* lds; volatile LAS unsigned* MISC;
    int G;
};
__device__ __forceinline__ float wave_sum(float v) {
#pragma unroll
    for (int o = 1; o < 64; o <<= 1) v += __shfl_xor(v, o);
    return v;
}
__device__ __forceinline__ float bf2f(unsigned short b) { return __uint_as_float(((unsigned)b) << 16); }
struct XItem { const float* src; bf16* dst; int K, N; };
__device__ __forceinline__ void xitem_load(const XItem& it, f32x4 (&wv)[8], int lane) {
    const int lr = lane >> 3, lc = (lane & 7) * 4;
#pragma unroll
    for (int i = 0; i < 8; ++i) wv[i] = __builtin_nontemporal_load((const f32x4*)(it.src + (size_t)(16 * (i >> 1) + 2 * lr + (i & 1)) * it.N + lc));
}
__device__ __forceinline__ void xitem_finish(const XItem& it, const f32x4 (&wv)[8], LAS float* scr, int lane) {
    LAS unsigned* T = (LAS unsigned*)scr; const int lr = lane >> 3, lc = (lane & 7) * 4;
#pragma unroll
    for (int m = 0; m < 4; ++m) { const f32x4 a = wv[2 * m], b = wv[2 * m + 1]; const int kw = 8 * m + lr;
        T[(lc + 0) * 36 + kw] = pg8::cvt_pk_bf16(a.x, b.x); T[(lc + 1) * 36 + kw] = pg8::cvt_pk_bf16(a.y, b.y); T[(lc + 2) * 36 + kw] = pg8::cvt_pk_bf16(a.z, b.z); T[(lc + 3) * 36 + kw] = pg8::cvt_pk_bf16(a.w, b.w); }
    LDS_WAIT(); asm volatile("" ::: "memory");
    const int kq = lane & 7;
#pragma unroll
    for (int j = 0; j < 4; ++j) { const int n = (lane >> 3) + 8 * j; const v4u o = *(const LAS v4u*)(T + n * 36 + kq * 4);
        __builtin_nontemporal_store(o, (GAS v4u*)(it.dst + (size_t)n * it.K + 8 * kq)); }
    LDS_WAIT(); asm volatile("" ::: "memory");
}
__device__ __forceinline__ int t5_bucket_dev(int rel) {
    const int n = rel < 0 ? -rel : rel; int b;
    if (n < 8) b = n; else b = 8 + (n >= 15) + (n >= 27) + (n >= 50) + (n >= 91) + (n >= 166) + (n >= 305) + (n >= 559);
    return (rel > 0 ? 16 : 0) + b;
}

#ifndef PH_MASK
#define PH_MASK 0xFFF
#endif
#define ON(k) (((PH_MASK) >> (k)) & 1)
#define QKVH(head, row) (QKV + ((size_t)(head) * M + (size_t)(row)) * HDIM)
constexpr int I_IN = (DM / 64) * (NQKV / 32), I_OUT = (DM / 64) * (DM / 32), I_1 = (DM / 64) * (DFF / 32), I_2 = (DFF / 64) * (DM / 32), I_LAYER = I_IN + I_OUT + I_1 + I_2;
#ifndef CONV_IN_QUEUE
#define CONV_IN_QUEUE 1
#endif
constexpr int NCONV = 128, CONV_ITEMS = I_LAYER / NCONV;
static_assert(I_LAYER % NCONV == 0 && CONV_ITEMS % 16 == 0 && (I_LAYER - I_IN) % NCONV == 0 && ((I_LAYER - I_IN) / NCONV) % 16 == 0, "conversion chunking: whole chunks, an even item count per wave");
__device__ __forceinline__ XItem conv_item(int l, int r, const float* w_in, const float* w_out, const float* w_mlp_in, const float* w_mlp_out, bf16* WIN, bf16* WOUT, bf16* W1, bf16* W2) {
    const float* W; bf16* WT; int K, N;
    if (r < I_IN) { W = w_in + (size_t)l * DM * NQKV; WT = WIN + (size_t)l * NQKV * DM; K = DM; N = NQKV; }
    else if (r < I_IN + I_OUT) { r -= I_IN; W = w_out + (size_t)l * DM * DM; WT = WOUT + (size_t)l * DM * DM; K = DM; N = DM; }
    else if (r < I_IN + I_OUT + I_1) { r -= I_IN + I_OUT; W = w_mlp_in + (size_t)l * DM * DFF; WT = W1 + (size_t)l * DFF * DM; K = DM; N = DFF; }
    else { r -= I_IN + I_OUT + I_1; W = w_mlp_out + (size_t)l * DFF * DM; WT = W2 + (size_t)l * DM * DFF; K = DFF; N = DM; }
    const int nblk = N / 32, k0 = 64 * (r / nblk), n0 = 32 * (r % nblk);
    XItem it; it.src = W + (size_t)k0 * N + n0; it.dst = WT + (size_t)n0 * K + k0; it.K = K; it.N = N; return it;
}
__device__ __forceinline__ XItem conv_qitem(int l, int q, const float* w_in, const float* w_out, const float* w_mlp_in, const float* w_mlp_out, bf16* WIN, bf16* WOUT, bf16* W1, bf16* W2) {
    return (q < I_LAYER - I_IN) ? conv_item(l, q + I_IN, w_in, w_out, w_mlp_in, w_mlp_out, WIN, WOUT, W1, W2) : conv_item(l + 1, q - (I_LAYER - I_IN), w_in, w_out, w_mlp_in, w_mlp_out, WIN, WOUT, W1, W2);
}
template <bool QMAP> __device__ __forceinline__ void conv_run_t(int l, int first, int step, int end, const float* w_in, const float* w_out, const float* w_mlp_in, const float* w_mlp_out, bf16* WIN, bf16* WOUT, bf16* W1, bf16* W2, LAS float* scr, int lane) {
#define CI_(r) (QMAP ? conv_qitem(l, (r), w_in, w_out, w_mlp_in, w_mlp_out, WIN, WOUT, W1, W2) : conv_item(l, (r), w_in, w_out, w_mlp_in, w_mlp_out, WIN, WOUT, W1, W2))
    if (first >= end) return;
    f32x4 wa[8], wb[8], wc[8], wd[8];
    if ((((end - first) + step - 1) / step) & 1) { const XItem s = CI_(first); xitem_load(s, wa, lane); xitem_finish(s, wa, scr, lane); first += step; if (first >= end) return; }
    XItem a = CI_(first), b = CI_(first + step);
    xitem_load(a, wa, lane); xitem_load(b, wb, lane);
    for (int r = first; r < end; r += 4 * step) {
        const bool more = r + 2 * step < end;
        XItem c = a, d = b; if (more) { c = CI_(r + 2 * step); d = CI_(r + 3 * step); xitem_load(c, wc, lane); xitem_load(d, wd, lane); }
        xitem_finish(a, wa, scr, lane); xitem_finish(b, wb, scr, lane);
        if (!more) break;
        const bool more2 = r + 4 * step < end;
        if (more2) { a = CI_(r + 4 * step); b = CI_(r + 5 * step); xitem_load(a, wa, lane); xitem_load(b, wb, lane); }
        xitem_finish(c, wc, scr, lane); xitem_finish(d, wd, scr, lane);
        if (!more2) break;
    }
#undef CI_
}
struct Args { const float* in[14]; float* out; unsigned char* ws; };

__device__ __forceinline__ f32x4 ld_row4(const void* base, size_t row, int idx, bool is_bf) {
    if (is_bf) { const unsigned long long w = ((const unsigned long long*)((const bf16*)base + row * DM))[idx]; const unsigned lo = (unsigned)w, hi = (unsigned)(w >> 32);
        return (f32x4){__uint_as_float(lo << 16), __uint_as_float(lo & 0xffff0000u), __uint_as_float(hi << 16), __uint_as_float(hi & 0xffff0000u)}; }
    return ((const f32x4*)((const float*)base + row * DM))[idx];
}
template <bool HAS_Y>
__device__ __forceinline__ void norm_phase(Frame& F, const void* xin, bool xin_bf, const bf16* y, void* xout, bool xout_bf, bf16* h, const float* Gv, const float* Av, const float* Bv, int bstride) {
    int tid_ = threadIdx.x; asm volatile("" : "+v"(tid_)); const int tid = tid_, lane = tid & 63, wave = __builtin_amdgcn_readfirstlane(tid >> 6);
    LAS f32x4* Gs = (LAS f32x4*)(F.lds); LAS f32x4* As = (LAS f32x4*)(F.lds + 16384); LAS f32x4* Bs = (LAS f32x4*)(F.lds + 32768);
    for (int chunk = blockIdx.x; chunk < M / 64; chunk += F.G) {
        const int b = chunk / (SEQ / 64);
        __syncthreads();
        for (int i = tid; i < 1024; i += NWAVES * 64) { if (HAS_Y) Gs[i] = ((const f32x4*)(Gv + (size_t)b * bstride))[i]; if (h) { As[i] = ((const f32x4*)(Av + (size_t)b * bstride))[i]; Bs[i] = ((const f32x4*)(Bv + (size_t)b * bstride))[i]; } }
        __syncthreads();
        for (int rr = wave; rr < 64; rr += NWAVES) {
            const size_t row = (size_t)chunk * 64 + rr;
            f32x4 xv[16];
            if (HAS_Y) {
                f32x4 yv[16]; float ss = 0.f;
#pragma unroll
                for (int j = 0; j < 16; ++j) yv[j] = ld_row4(y, row, lane + 64 * j, true);
#pragma unroll
                for (int j = 0; j < 16; ++j) xv[j] = ld_row4(xin, row, lane + 64 * j, xin_bf);
#pragma unroll
                for (int j = 0; j < 16; ++j) { asm volatile("" : "+v"(xv[j]));
                    ss += (yv[j].x * yv[j].x + yv[j].y * yv[j].y) + (yv[j].z * yv[j].z + yv[j].w * yv[j].w); }
                const float ry = 1.0f / sqrtf(wave_sum(ss) * (1.0f / DM) + EPS);
#pragma unroll
                for (int j = 0; j < 16; ++j) { const f32x4 g = Gs[lane + 64 * j]; xv[j] = xv[j] + g * (yv[j] * ry); }
                if (xout_bf) { unsigned long long* xo = (unsigned long long*)((bf16*)xout + row * DM) + lane;
#pragma unroll
                    for (int j = 0; j < 16; ++j) xo[64 * j] = (unsigned long long)pg8::cvt_pk_bf16(xv[j].x, xv[j].y) | ((unsigned long long)pg8::cvt_pk_bf16(xv[j].z, xv[j].w) << 32);
                } else { f32x4* xo = (f32x4*)((float*)xout + row * DM) + lane;
#pragma unroll
                    for (int j = 0; j < 16; ++j) xo[64 * j] = xv[j]; }
            } else {
#pragma unroll
                for (int j = 0; j < 16; ++j) xv[j] = ld_row4(xin, row, lane + 64 * j, xin_bf);
            }
            if (h) {
                float ss = 0.f;
#pragma unroll
                for (int j = 0; j < 16; ++j) ss += (xv[j].x * xv[j].x + xv[j].y * xv[j].y) + (xv[j].z * xv[j].z + xv[j].w * xv[j].w);
                const float rx = 1.0f / sqrtf(wave_sum(ss) * (1.0f / DM) + EPS);
                unsigned long long* ho = (unsigned long long*)(h + row * DM) + lane;
#pragma unroll
                for (int j = 0; j < 16; ++j) { const f32x4 a = As[lane + 64 * j], bb = Bs[lane + 64 * j]; const f32x4 v = a * (xv[j] * rx) + bb;
                    ho[64 * j] = (unsigned long long)pg8::cvt_pk_bf16(v.x, v.y) | ((unsigned long long)pg8::cvt_pk_bf16(v.z, v.w) << 32); }
            }
        }
    }
}

__device__ __forceinline__ void norm_phase_bf(Frame& F, const bf16* xin, const bf16* y, void* xout, bool xout_bf, bf16* h, const float* Gv, const float* Av, const float* Bv, int bstride) {
    int tid_ = threadIdx.x; asm volatile("" : "+v"(tid_)); const int tid = tid_, lane = tid & 63, wave = __builtin_amdgcn_readfirstlane(tid >> 6);
    LAS f32x4* Gs = (LAS f32x4*)(F.lds); LAS f32x4* As = (LAS f32x4*)(F.lds + 16384); LAS f32x4* Bs = (LAS f32x4*)(F.lds + 32768);
    typedef unsigned long long u64;
#define NB_CVT(W) ((f32x4){__uint_as_float((unsigned)(W) << 16), __uint_as_float((unsigned)(W) & 0xffff0000u), __uint_as_float((unsigned)((W) >> 32) << 16), __uint_as_float((unsigned)((W) >> 32) & 0xffff0000u)})
#define NB_LOAD(YR, XR, ROW) do { _Pragma("unroll") for (int j = 0; j < 16; ++j) { YR[j] = ((const u64*)(y + (ROW) * DM))[lane + 64 * j]; XR[j] = ((const u64*)(xin + (ROW) * DM))[lane + 64 * j]; } } while (0)
#define NB_PIN(YR, XR) do { _Pragma("unroll") for (int j = 0; j < 16; ++j) { asm volatile("" : "+v"(YR[j])); asm volatile("" : "+v"(XR[j])); } } while (0)
#define NB_ROW(YR, XR, ROW) do { int lq = lane; asm volatile("" : "+v"(lq)); float ss = 0.f; f32x4 xv[16]; \
        _Pragma("unroll") for (int j = 0; j < 16; ++j) { const f32x4 yv = NB_CVT(YR[j]); ss += (yv.x * yv.x + yv.y * yv.y) + (yv.z * yv.z + yv.w * yv.w); } \
        const float ry = 1.0f / sqrtf(wave_sum(ss) * (1.0f / DM) + EPS); \
        _Pragma("unroll") for (int j = 0; j < 16; ++j) { const f32x4 g = Gs[lq + 64 * j]; xv[j] = NB_CVT(XR[j]) + g * (NB_CVT(YR[j]) * ry); } \
        if (xout_bf) { u64* xo = (u64*)((bf16*)xout + (ROW) * DM) + lane; \
            _Pragma("unroll") for (int j = 0; j < 16; ++j) xo[64 * j] = (u64)pg8::cvt_pk_bf16(xv[j].x, xv[j].y) | ((u64)pg8::cvt_pk_bf16(xv[j].z, xv[j].w) << 32); \
        } else { f32x4* xo = (f32x4*)((float*)xout + (ROW) * DM) + lane; \
            _Pragma("unroll") for (int j = 0; j < 16; ++j) xo[64 * j] = xv[j]; } \
        if (h) { float s2 = 0.f; \
            _Pragma("unroll") for (int j = 0; j < 16; ++j) s2 += (xv[j].x * xv[j].x + xv[j].y * xv[j].y) + (xv[j].z * xv[j].z + xv[j].w * xv[j].w); \
            const float rx = 1.0f / sqrtf(wave_sum(s2) * (1.0f / DM) + EPS); \
            u64* ho = (u64*)(h + (ROW) * DM) + lane; \
            _Pragma("unroll") for (int j = 0; j < 16; ++j) { const f32x4 a = As[lq + 64 * j], bb = Bs[lq + 64 * j]; const f32x4 v = a * (xv[j] * rx) + bb; \
                ho[64 * j] = (u64)pg8::cvt_pk_bf16(v.x, v.y) | ((u64)pg8::cvt_pk_bf16(v.z, v.w) << 32); } } } while (0)
    for (int chunk = blockIdx.x; chunk < M / 64; chunk += F.G) {
        const int b = chunk / (SEQ / 64);
        const size_t row0 = (size_t)chunk * 64 + wave;
        u64 yA[16], xA[16], yB[16], xB[16];
        NB_LOAD(yA, xA, row0);
        __syncthreads();
        for (int i = tid; i < 1024; i += NWAVES * 64) { Gs[i] = ((const f32x4*)(Gv + (size_t)b * bstride))[i]; if (h) { As[i] = ((const f32x4*)(Av + (size_t)b * bstride))[i]; Bs[i] = ((const f32x4*)(Bv + (size_t)b * bstride))[i]; } }
        __syncthreads();
#pragma unroll 1
        for (int it = 0; it < 4; ++it) {
            const size_t ra = row0 + 16 * it, rb = ra + 8;
            NB_LOAD(yB, xB, rb); NB_PIN(yA, xA);
            NB_ROW(yA, xA, ra);
            if (it < 3) { NB_LOAD(yA, xA, rb + 8); }
            NB_PIN(yB, xB);
            NB_ROW(yB, xB, rb);
        }
    }
#undef NB_CVT
#undef NB_LOAD
#undef NB_PIN
#undef NB_ROW
}

typedef __attribute__((address_space(4))) const unsigned char ckb_t;
__device__ __forceinline__ const void* karg(int i) { ckb_t* kp = (ckb_t*)__builtin_amdgcn_kernarg_segment_ptr(); asm volatile("" : "+s"(kp)); return *(const void* const __attribute__((address_space(4)))*)(kp + 8 * i); }
#define KIN(i) ((const float*)karg(i))
#define KOUT() ((float*)karg(14))
#define KWS() ((unsigned char*)karg(15))
__global__ void __launch_bounds__(NWAVES * 64, 2) mega_fwd(Args args_unused) {
    extern __shared__ __attribute__((aligned(16))) unsigned char lds[];
    Frame F;
    F.lds = (LAS unsigned char*)lds; F.MISC = (volatile LAS unsigned*)(F.lds + MISC_OFF); F.G = gridDim.x;
    for (int u = threadIdx.x; u < (LDS_BYTES - LDSCTL_OFF) / 4; u += NWAVES * 64) ((LAS unsigned*)(F.lds + LDSCTL_OFF))[u] = 0u;
    __syncthreads();
    (void)xcd_barrier_post((unsigned*)((gu32*)(KWS() + WS_CTL) + CW_BAR), F.MISC + 8);
#define GRID_BAR() do { XcdBarrier bar_; bar_.bar = (unsigned*)((gu32*)(KWS() + WS_CTL) + CW_BAR); bar_.x = xb_xcc_id(); bar_.st = (volatile LAS unsigned*)(F.lds + MISC_OFF) + 8; xcd_barrier(bar_); } while (0)
#define FRESH_IDS() int tid_ = threadIdx.x; asm volatile("" : "+v"(tid_)); const int ftid = tid_, flane = ftid & 63, fwave = __builtin_amdgcn_readfirstlane(ftid >> 6); \
    const int gw = blockIdx.x * NWAVES + fwave, NGW = F.G * NWAVES, gtid = blockIdx.x * (NWAVES * 64) + ftid, NGT = F.G * NWAVES * 64; (void)flane; (void)gw; (void)NGW; (void)gtid; (void)NGT
#define WSP(T, off) ((T*)(ws + (off)))
#ifndef DUP_GEMM
#define DUP_GEMM 0
#endif
#ifndef XBF16
#define XBF16 1
#endif
#ifndef DUP_NORM
#define DUP_NORM 0
#endif
#ifndef DUP_P0C
#define DUP_P0C 0
#endif
#ifndef XBAR
#define XBAR 0
#endif
#ifndef DUP_G0
#define DUP_G0 0
#endif
#ifndef DUP_G1
#define DUP_G1 0
#endif
#ifndef DUP_G2
#define DUP_G2 0
#endif
#ifndef DUP_G3
#define DUP_G3 0
#endif
#ifndef DUP_NA
#define DUP_NA 0
#endif
#ifndef DUP_DIL
#define DUP_DIL 0
#endif
#ifndef DUP_GQA
#define DUP_GQA 0
#endif
#ifndef DUP_ATT
#define DUP_ATT 0
#endif
#ifndef DUP_P0A
#define DUP_P0A 0
#endif
#ifndef DUPBAR
#define DUPBAR 0
#endif
#define REPBAR() do { if (DUPBAR && rep_ > 0) GRID_BAR(); } while (0)
#define REPEAT(n) for (int rep_ = 0, nrep_ = __builtin_amdgcn_readfirstlane(1 + (n)); rep_ < nrep_; ++rep_)

    if (ON(0)) REPEAT(DUP_P0A)
    {
        FRESH_IDS(); unsigned char* ws = KWS(); const float* in_c = KIN(1); const float* ada_w = KIN(2); float* MODP = WSP(float, WS_MODP);
        for (int task = gw; task < 96 * 16; task += NGW) {
            const int cg = task % 96, kc = task / 96; const int col = cg * 256 + flane * 4;
            f32x4 a0 = {0.f, 0.f, 0.f, 0.f}, a1 = {0.f, 0.f, 0.f, 0.f};
            const float* wp = ada_w + (size_t)(kc * 256) * (NMOD * DM) + col;
#pragma unroll 8
            for (int k = 0; k < 256; ++k) {
                const f32x4 w = *(const f32x4*)(wp + (size_t)k * (NMOD * DM));
                const float c0 = in_c[kc * 256 + k], c1 = in_c[DM + kc * 256 + k];
                const float s0 = c0 / (1.0f + __expf(-c0)), s1 = c1 / (1.0f + __expf(-c1));
                a0 = a0 + w * s0; a1 = a1 + w * s1;
            }
            *(f32x4*)(MODP + ((size_t)(kc * 2 + 0) * (NMOD * DM)) + col) = a0;
            *(f32x4*)(MODP + ((size_t)(kc * 2 + 1) * (NMOD * DM)) + col) = a1;
        }
        LAS float* scr = (LAS float*)(F.lds + RING_OFF + fwave * 16384);
        const float* w_in = KIN(6); const float* w_out = KIN(7); const float* w_mlp_in = KIN(12); const float* w_mlp_out = KIN(13);
        bf16* WIN = WSP(bf16, WS_WIN); bf16* WOUT = WSP(bf16, WS_WOUT); bf16* W1 = WSP(bf16, WS_W1); bf16* W2 = WSP(bf16, WS_W2);
        if (CONV_IN_QUEUE) conv_run_t<false>(0, gw, NGW, I_IN, w_in, w_out, w_mlp_in, w_mlp_out, WIN, WOUT, W1, W2, scr, flane);
        else for (int cl_ = 0; cl_ < DEPTH; ++cl_) conv_run_t<false>(cl_, gw, NGW, I_LAYER, w_in, w_out, w_mlp_in, w_mlp_out, WIN, WOUT, W1, W2, scr, flane);
    }
    GRID_BAR();
    if (ON(1))
    {
        FRESH_IDS(); unsigned char* ws = KWS(); const float* ada_b = KIN(3); const float* ada_emb = KIN(4); const float* gains = KIN(5); const float* t5_table = KIN(11);
        float* MODP = WSP(float, WS_MODP); float* MODV = WSP(float, WS_MODV); float* ROPE = WSP(float, WS_ROPE); float* DILTB = WSP(float, WS_DILTB);
        for (int i = gtid; i < DEPTH * 2 * NMOD * DM; i += NGT) {
            const int col = i % DM, j = (i / DM) % NMOD, b = (i / (DM * NMOD)) % 2, l = i / (DM * NMOD * 2);
            float m = ada_b[j * DM + col];
#pragma unroll
            for (int kc = 0; kc < 16; ++kc) m += MODP[(size_t)(kc * 2 + b) * (NMOD * DM) + j * DM + col];
            m += ada_emb[((size_t)l * NMOD + j) * DM + col];
            const float* gl = gains + (size_t)l * 4 * DM;
            float v;
            if (j == 0) v = m; else if (j == 1) v = gl[0 * DM + col] * (1.0f + m); else if (j == 2) v = m * gl[1 * DM + col];
            else if (j == 3) v = m; else if (j == 4) v = gl[2 * DM + col] * (1.0f + m); else v = m * gl[3 * DM + col];
            MODV[i] = v;
        }
        if (blockIdx.x == 0 && ftid < 32) {
            const int f = ftid; const double th = (double)__builtin_amdgcn_exp2f(-(float)f * 0.41524101186092029f);
            double c1 = 1.0, s1 = th, tc = 1.0, ts = th; const double x2 = th * th;
            for (int n = 1; n <= 12; ++n) { tc *= -x2 / (double)((2 * n - 1) * (2 * n)); ts *= -x2 / (double)((2 * n) * (2 * n + 1)); c1 += tc; s1 += ts; }
            double c = 1.0, s = 0.0;
            for (int pos = 0; pos < 128; ++pos) { ROPE[pos * 32 + f] = (float)c; ROPE[4096 + pos * 32 + f] = (float)s; const double cn = c * c1 - s * s1; s = s * c1 + c * s1; c = cn; }
        }
        if (blockIdx.x == 1 || F.G == 1) {
            for (int i = ftid; i < 3 * H_DIL * 129; i += NWAVES * 64) { const int p = i / (H_DIL * 129), hh = (i / 129) % H_DIL, jj = i % 129 - 64; const int d = p == 0 ? 1 : (p == 1 ? 4 : 16);
                DILTB[i] = t5_table[t5_bucket_dev(jj * d) * H_DIL + hh]; }
        }
    }
    GRID_BAR();
    if (ON(2))
    REPEAT(DUP_P0C) { unsigned char* ws = KWS(); float* MODV = WSP(float, WS_MODV);
      norm_phase<false>(F, KIN(0), false, nullptr, nullptr, false, WSP(bf16, WS_H), nullptr, MODV + 1 * DM, MODV + 0 * DM, NMOD * DM); }
    GRID_BAR();

    for (int l = 0; l < DEPTH; ++l) {
        for (int xb_ = 0; xb_ < XBAR; ++xb_) GRID_BAR();
    if (ON(3)) REPEAT(DUP_GEMM + DUP_G0)
        {
            REPBAR();
            unsigned char* ws = KWS();
            pg8::Gemm g{WSP(bf16, WS_H), WSP(bf16, WS_WIN) + (size_t)l * NQKV * DM, M, NQKV, DM}; pg8::StaticOrder S; S.init(M, NQKV, F.G, (int)blockIdx.x);
            pg8::EpiQKV E{WSP(bf16, WS_QKV), M};
            pg8::gemm_phase<pg8::EpiQKV, pg8::StaticOrder, true, true>(F.lds + RING_OFF, g, S, E);
        }
        GRID_BAR();
    if (ON(4))
        {
            FRESH_IDS(); const int i16 = ftid & 15; const int g16 = gtid >> 4, NG16 = NGT >> 4;
            unsigned char* ws = KWS(); bf16* QKV = WSP(bf16, WS_QKV); const float* ROPE = WSP(float, WS_ROPE); const float* q_gain = KIN(8); const float* k_gain = KIN(9);
            for (int task = g16; task < 16 * (M / 8); task += NG16) {
                const int hh = task >> 11, row0 = (task & (M / 8 - 1)) * 8;
                const int head = hh < H_GQA ? Q_GQA / HDIM + hh : K_GQA / HDIM + (hh - H_GQA);
                const float* gp = (hh < H_GQA ? q_gain : k_gain) + l * HDIM + 8 * i16;
                bf16* p = QKVH(head, row0) + 8 * i16;
                const int jj = i16 & 7, fb = 8 * (jj & 3);
                v4u raw[8]; f32x4 c0[8], c1[8], s0[8], s1[8];
#pragma unroll
                for (int k = 0; k < 8; ++k) raw[k] = *(const v4u*)(p + (size_t)k * HDIM);
                const f32x4 g0 = *(const f32x4*)gp, g1 = *(const f32x4*)(gp + 4);
#pragma unroll
                for (int k = 0; k < 8; ++k) { const int t = (row0 + k) & (SEQ - 1); const int pos = (i16 < 8) ? (t >> 6) : (t & 63); const float* rp = ROPE + pos * 32 + fb;
                    c0[k] = *(const f32x4*)rp; c1[k] = *(const f32x4*)(rp + 4); s0[k] = *(const f32x4*)(rp + 4096); s1[k] = *(const f32x4*)(rp + 4100); }
#pragma unroll
                for (int k = 0; k < 8; ++k) {
                    float x[8];
                    x[0] = __uint_as_float(raw[k].x << 16); x[1] = __uint_as_float(raw[k].x & 0xffff0000u); x[2] = __uint_as_float(raw[k].y << 16); x[3] = __uint_as_float(raw[k].y & 0xffff0000u);
                    x[4] = __uint_as_float(raw[k].z << 16); x[5] = __uint_as_float(raw[k].z & 0xffff0000u); x[6] = __uint_as_float(raw[k].w << 16); x[7] = __uint_as_float(raw[k].w & 0xffff0000u);
                    float ss = 0.f;
#pragma unroll
                    for (int e = 0; e < 8; ++e) ss += x[e] * x[e];
                    ss += __shfl_xor(ss, 1); ss += __shfl_xor(ss, 2); ss += __shfl_xor(ss, 4); ss += __shfl_xor(ss, 8);
                    const float rstd = 1.0f / sqrtf(ss * (1.0f / HDIM) + EPS);
                    x[0] *= rstd * g0.x; x[1] *= rstd * g0.y; x[2] *= rstd * g0.z; x[3] *= rstd * g0.w; x[4] *= rstd * g1.x; x[5] *= rstd * g1.y; x[6] *= rstd * g1.z; x[7] *= rstd * g1.w;
                    const float cs[8] = {c0[k].x, c0[k].y, c0[k].z, c0[k].w, c1[k].x, c1[k].y, c1[k].z, c1[k].w}; const float sn[8] = {s0[k].x, s0[k].y, s0[k].z, s0[k].w, s1[k].x, s1[k].y, s1[k].z, s1[k].w};
                    float o[8];
#pragma unroll
                    for (int e = 0; e < 8; ++e) { const float pv = __shfl_xor(x[e], 4); o[e] = (jj < 4) ? (x[e] * cs[e] - pv * sn[e]) : (pv * sn[e] + x[e] * cs[e]); }
                    v4u w; w.x = pg8::cvt_pk_bf16(o[0], o[1]); w.y = pg8::cvt_pk_bf16(o[2], o[3]); w.z = pg8::cvt_pk_bf16(o[4], o[5]); w.w = pg8::cvt_pk_bf16(o[6], o[7]);
                    *(v4u*)(p + (size_t)k * HDIM) = w;
                }
            }
        }
    if (ON(5))
        {
            char* alds = (char*)lds + RING_OFF;
            (void)alds;
        }
        GRID_BAR();
    if (ON(5)) REPEAT(DUP_ATT)
        {
            char* alds = (char*)lds + RING_OFF;
            { unsigned char* ws = KWS(); bf16* QKV = WSP(bf16, WS_QKV); bf16* O = WSP(bf16, WS_O); const float* na_rpb = KIN(10);
              bf16* DILP = WSP(bf16, WS_DILP); float* DILST = WSP(float, WS_DILST); const float* DILTB = WSP(float, WS_DILTB);
              gu32* qhead = (gu32*)(ws + WS_CTL) + CW_QUEUE + 64 * l; volatile LAS unsigned* qslot = (volatile LAS unsigned*)(F.lds + MISC_OFF) + 16;
              const int nconv = CONV_IN_QUEUE ? NCONV : 0;
              unsigned nx_ = 0u; if (threadIdx.x == 0) nx_ = __hip_atomic_fetch_add(qhead, 1u, RLX_AGENT);
              for (int guard_ = 0; guard_ < 4096; ++guard_) {
                __syncthreads();
                if (threadIdx.x == 0) qslot[0] = nx_;
                __syncthreads();
                const int uq = (int)__builtin_amdgcn_readfirstlane(qslot[0]);
                if (uq >= 768 + nconv + 2816) break;
                if (threadIdx.x == 0) nx_ = __hip_atomic_fetch_add(qhead, 1u, RLX_AGENT);
                int u;
                if (uq < 768 + nconv) {
                    if (nconv && uq % 7 == 6) {
                        int tid_ = threadIdx.x; asm volatile("" : "+v"(tid_)); const int cl = tid_ & 63, cw = __builtin_amdgcn_readfirstlane(tid_ >> 6);
                        LAS float* scr = (LAS float*)(F.lds + RING_OFF + cw * 16384); const int citems = (l + 1 < DEPTH) ? CONV_ITEMS : (I_LAYER - I_IN) / NCONV, c0 = (uq / 7) * citems;
                        const float* w_in = KIN(6); const float* w_out = KIN(7); const float* w_mlp_in = KIN(12); const float* w_mlp_out = KIN(13);
                        conv_run_t<true>(l, c0 + cw, NWAVES, c0 + citems, w_in, w_out, w_mlp_in, w_mlp_out, WSP(bf16, WS_WIN), WSP(bf16, WS_WOUT), WSP(bf16, WS_W1), WSP(bf16, WS_W2), scr, cl);
                        continue;
                    }
                    u = nconv ? uq - uq / 7 : uq;
                } else u = uq - nconv;
                if (u < 768) {
                    const int grp = u / 96, within = u % 96; const int b = grp >> 2, kvh = grp & 3, hq = kvh * 3 + within / 32, qb = within % 32;
                    const size_t r0 = (size_t)b * SEQ + (size_t)qb * 256;
                    att::attn_unit<0>(QKVH(Q_GQA / HDIM + hq, r0), HDIM, QKVH(K_GQA / HDIM + kvh, (size_t)b * SEQ), QKVH(V_GQA / HDIM + kvh, (size_t)b * SEQ), HDIM,
                                      0, SEQ / 64, SEQ / 64, O + r0 * DM + O_GQA + hq * HDIM, DM, nullptr, 0, 0, nullptr, 0, alds);
                    continue;
                }
                if (u < 768 + 512) {
                    const int un = u - 768; const int b = un >> 8, hh = (un >> 5) & 7, qb = un & 31; const size_t r0 = (size_t)b * SEQ + (size_t)qb * 256;
                    att::attn_unit<1>(QKVH(Q_NA / HDIM + hh, r0), HDIM, QKVH(K_NA / HDIM + hh, (size_t)b * SEQ), QKVH(V_NA / HDIM + hh, (size_t)b * SEQ), HDIM,
                                      qb * 4 - 4, 12, SEQ / 64, O + r0 * DM + O_NA + hh * HDIM, DM, nullptr, 0, qb * 4, na_rpb + ((size_t)l * H_NA + hh) * 465, 465, alds);
                } else {
                    const int v = u - 768 - 512, p = v / 768, w = v % 768, pair = w >> 5, b = pair / H_DIL, hh = pair % H_DIL, blk = w & 31;
                    const int d = p == 0 ? 1 : (p == 1 ? 4 : 16), nub = 32 / d, res = blk / nub, ub = blk % nub, u0 = ub * 256, L = SEQ / d;
                    const size_t rq = (size_t)b * SEQ + (size_t)u0 * d + res, rk = (size_t)b * SEQ + res;
                    att::attn_unit<2>(QKVH(Q_DIL / HDIM + hh, rq), (long)d * HDIM, QKVH(K_DIL / HDIM + hh, rk), QKVH(V_DIL / HDIM + hh, rk), (long)d * HDIM,
                                      u0 / 64 - 1, 6, L / 64, DILP + (size_t)p * M * DILW + rq * DILW + hh * HDIM, (long)d * DILW,
                                      DILST + (((size_t)p * M + rq) * H_DIL + hh) * 2, (long)d * H_DIL * 2, u0, DILTB + (p * H_DIL + hh) * 129, 129, alds);
                }
              } }
        }
        GRID_BAR();
    if (ON(6))
        {
            FRESH_IDS(); const int i16 = ftid & 15; const int g16 = gtid >> 4, NG16 = NGT >> 4;
            unsigned char* ws = KWS(); bf16* O = WSP(bf16, WS_O); const bf16* DILP = WSP(bf16, WS_DILP); const float* DILST = WSP(float, WS_DILST);
            typedef float f32x2v __attribute__((ext_vector_type(2)));
            for (int task0 = g16; task0 < M * H_DIL; task0 += 8 * NG16) {
                f32x2v st[8][3]; v4u raw[8][3];
#pragma unroll
                for (int k = 0; k < 8; ++k) { const int task = task0 + k * NG16; const bool on = task < M * H_DIL; const int tt = on ? task : task0; const int row = tt / H_DIL, hh = tt % H_DIL;
#pragma unroll
                    for (int p = 0; p < 3; ++p) { st[k][p] = *(const f32x2v*)(DILST + (((size_t)p * M + row) * H_DIL + hh) * 2); raw[k][p] = *(const v4u*)(DILP + (size_t)p * M * DILW + (size_t)row * DILW + hh * HDIM + 8 * i16); } }
#pragma unroll
                for (int k = 0; k < 8; ++k) { const int task = task0 + k * NG16; if (task < M * H_DIL) { const int row = task / H_DIL, hh = task % H_DIL;
                    const float mx = fmaxf(st[k][0].x, fmaxf(st[k][1].x, st[k][2].x));
                    float wv[3]; float wsum = 0.f;
#pragma unroll
                    for (int p = 0; p < 3; ++p) { wv[p] = st[k][p].y * __builtin_amdgcn_exp2f(st[k][p].x - mx); wsum += wv[p]; }
                    const float inv = 1.0f / wsum;
                    float acc[8] = {0.f, 0.f, 0.f, 0.f, 0.f, 0.f, 0.f, 0.f};
#pragma unroll
                    for (int p = 0; p < 3; ++p) { const v4u r = raw[k][p]; const float wp = wv[p] * inv;
                        acc[0] += wp * __uint_as_float(r.x << 16); acc[1] += wp * __uint_as_float(r.x & 0xffff0000u); acc[2] += wp * __uint_as_float(r.y << 16); acc[3] += wp * __uint_as_float(r.y & 0xffff0000u);
                        acc[4] += wp * __uint_as_float(r.z << 16); acc[5] += wp * __uint_as_float(r.z & 0xffff0000u); acc[6] += wp * __uint_as_float(r.w << 16); acc[7] += wp * __uint_as_float(r.w & 0xffff0000u); }
                    v4u w; w.x = pg8::cvt_pk_bf16(acc[0], acc[1]); w.y = pg8::cvt_pk_bf16(acc[2], acc[3]); w.z = pg8::cvt_pk_bf16(acc[4], acc[5]); w.w = pg8::cvt_pk_bf16(acc[6], acc[7]);
                    *(v4u*)(O + (size_t)row * DM + O_DIL + hh * HDIM + 8 * i16) = w; } }
            }
        }
        GRID_BAR();
    if (ON(7)) REPEAT(DUP_GEMM + DUP_G1)
        {
            REPBAR();
            unsigned char* ws = KWS();
            pg8::Gemm g{WSP(bf16, WS_O), WSP(bf16, WS_WOUT) + (size_t)l * DM * DM, M, DM, DM}; pg8::StaticOrder S; S.init(M, DM, F.G, (int)blockIdx.x);
            pg8::EpiBf16<0> E{WSP(bf16, WS_Y), DM};
            pg8::gemm_phase<pg8::EpiBf16<0>, pg8::StaticOrder, true, true>(F.lds + RING_OFF, g, S, E);
        }
        GRID_BAR();
    if (ON(8))
        { unsigned char* ws = KWS(); const float* mv = WSP(float, WS_MODV) + (size_t)l * 2 * NMOD * DM;
#if DUP_NORM
          norm_phase<true>(F, l == 0 ? (const void*)KIN(0) : (const void*)KOUT(), false, WSP(bf16, WS_Y), WSP(float, WS_U), false, WSP(bf16, WS_U + 256 * MiB), mv + 2 * DM, mv + 4 * DM, mv + 3 * DM, NMOD * DM);
#endif
#if XBF16
          if (l == 0) norm_phase<true>(F, (const void*)KIN(0), false, WSP(bf16, WS_Y), WSP(bf16, WS_XB), true, WSP(bf16, WS_H), mv + 2 * DM, mv + 4 * DM, mv + 3 * DM, NMOD * DM);
          else norm_phase_bf(F, WSP(bf16, WS_XB), WSP(bf16, WS_Y), WSP(bf16, WS_XB), true, WSP(bf16, WS_H), mv + 2 * DM, mv + 4 * DM, mv + 3 * DM, NMOD * DM); }
#else
          norm_phase<true>(F, l == 0 ? (const void*)KIN(0) : (const void*)KOUT(), false, WSP(bf16, WS_Y), KOUT(), false, WSP(bf16, WS_H), mv + 2 * DM, mv + 4 * DM, mv + 3 * DM, NMOD * DM); }
#endif
        GRID_BAR();
    if (ON(9)) REPEAT(DUP_GEMM + DUP_G2)
        {
            REPBAR();
            unsigned char* ws = KWS();
            pg8::Gemm g{WSP(bf16, WS_H), WSP(bf16, WS_W1) + (size_t)l * DFF * DM, M, DFF, DM}; pg8::StaticOrder S; S.init(M, DFF, F.G, (int)blockIdx.x);
            pg8::EpiBf16<3> E{WSP(bf16, WS_U), DFF};
            pg8::gemm_phase<pg8::EpiBf16<3>, pg8::StaticOrder, true, true>(F.lds + RING_OFF, g, S, E);
        }
        GRID_BAR();
    if (ON(10)) REPEAT(DUP_GEMM + DUP_G3)
        {
            REPBAR();
            unsigned char* ws = KWS();
            pg8::Gemm g{WSP(bf16, WS_U), WSP(bf16, WS_W2) + (size_t)l * DM * DFF, M, DM, DFF}; pg8::StaticOrder S; S.init(M, DM, F.G, (int)blockIdx.x);
            pg8::EpiBf16<0> E{WSP(bf16, WS_Y), DM};
            pg8::gemm_phase<pg8::EpiBf16<0>, pg8::StaticOrder, true, true>(F.lds + RING_OFF, g, S, E);
        }
        GRID_BAR();
    if (ON(11))
        {
            unsigned char* ws = KWS(); const float* mv = WSP(float, WS_MODV) + (size_t)l * 2 * NMOD * DM; float* out = KOUT();
            const float* mvn = WSP(float, WS_MODV) + (size_t)(l + 1 < DEPTH ? l + 1 : l) * 2 * NMOD * DM;
#if XBF16
            norm_phase_bf(F, WSP(bf16, WS_XB), WSP(bf16, WS_Y), (l + 1 < DEPTH) ? (void*)WSP(bf16, WS_XB) : (void*)out, l + 1 < DEPTH, (l + 1 < DEPTH) ? WSP(bf16, WS_H) : (bf16*)nullptr, mv + 5 * DM, mvn + 1 * DM, mvn + 0 * DM, NMOD * DM);
#else
            norm_phase<true>(F, out, false, WSP(bf16, WS_Y), out, false, (l + 1 < DEPTH) ? WSP(bf16, WS_H) : (bf16*)nullptr, mv + 5 * DM, mvn + 1 * DM, mvn + 0 * DM, NMOD * DM);
#endif
        }
        if (l + 1 < DEPTH) GRID_BAR();
    }
    __syncthreads();
    if (__hip_atomic_load((gu32*)(KWS() + WS_CTL) + CW_BAR + XB_TMO, RLX_AGENT) != 0u) {
        const float q = __builtin_nanf(""); float* out = KOUT();
        for (int chunk = blockIdx.x; chunk < M / 64; chunk += F.G) for (int i = threadIdx.x; i < 64 * DM / 4; i += NWAVES * 64) ((f32x4*)(out + (size_t)chunk * 64 * DM))[i] = (f32x4){q, q, q, q};
    }
}

extern "C" void kernel_launch(void* const* d_in, const int* in_sizes, int n_in, void* d_out, int out_size, void* d_ws, size_t ws_size, hipStream_t stream) {
    static int grid = 0;
    if (grid == 0) {
        if (n_in != 14 || in_sizes[0] != M * DM || out_size != M * DM || ws_size < WS_END) { fprintf(stderr, "kernel_launch: shape/workspace mismatch (n_in %d, in0 %d, out %d, ws %zu, need %zu)\n", n_in, n_in > 0 ? in_sizes[0] : -1, out_size, ws_size, (size_t)WS_END); grid = -1; return; }
        int dev = 0, cus = 0, per_cu = 0;
        if (hipGetDevice(&dev) != hipSuccess || hipDeviceGetAttribute(&cus, hipDeviceAttributeMultiprocessorCount, dev) != hipSuccess) { grid = -1; return; }
        if (hipFuncSetAttribute((const void*)mega_fwd, hipFuncAttributeMaxDynamicSharedMemorySize, LDS_BYTES) != hipSuccess) { fprintf(stderr, "kernel_launch: hipFuncSetAttribute failed\n"); grid = -1; return; }
        if (hipOccupancyMaxActiveBlocksPerMultiprocessor(&per_cu, (const void*)mega_fwd, NWAVES * 64, LDS_BYTES) != hipSuccess || per_cu < 1) { fprintf(stderr, "kernel_launch: occupancy query reports %d blocks per CU\n", per_cu); }
        (void)hipGetLastError();
        grid = cus;
    }
    if (grid < 0) return;
    if (hipMemsetAsync((char*)d_ws + WS_CTL, 0, CTL_ZERO_BYTES, stream) != hipSuccess) return;
    Args a{};
    for (int i = 0; i < 14; ++i) a.in[i] = (const float*)d_in[i];
    a.out = (float*)d_out; a.ws = (unsigned char*)d_ws;
    hipLaunchKernelGGL(mega_fwd, dim3(grid), dim3(NWAVES * 64), LDS_BYTES, stream, a);
    const hipError_t le = hipPeekAtLastError();
    if (le != hipSuccess) fprintf(stderr, "kernel_launch: launch failed: %s\n", hipGetErrorName(le));
}
```

```cpp
#include <hip/hip_runtime.h>
#include <cstdio>
#include <cstdint>
namespace pg8 {
#define PG8_LAS __attribute__((address_space(3)))
typedef unsigned short bf16_t;
typedef short bf16x8 __attribute__((ext_vector_type(8)));
typedef float f32x4 __attribute__((ext_vector_type(4)));
typedef unsigned u32x4 __attribute__((ext_vector_type(4)));
constexpr int BM = 256, BK = 64, HALF = 128, HTB = HALF * BK * 2  , STAGE_BYTES = 8 * HTB, NXCD = 8, WGM = 8;

__host__ __device__ __forceinline__ int lds_byte(int r, int c) { const int st = (r >> 4) * 2 + (c >> 5), rr = r & 15, cc = c & 31, ob = rr * 64 + cc * 2; return st * 1024 + (ob ^ (((ob >> 9) & 1) << 5)); }
__host__ __device__ __forceinline__ void stage_rc(int b, int& R, int& C) { const int st = b / 1024, sb = b % 1024, swz = sb ^ (((sb >> 9) & 1) << 5); R = (st >> 1) * 16 + swz / 64; C = (st & 1) * 32 + (swz % 64) / 2; }
__host__ __device__ __forceinline__ int perm32(int rho) { const int n = rho >> 4, i = rho & 15; return 8 * (i >> 2) + 4 * n + (i & 3); }

struct Unit { int pm, pn; };
struct Gemm { const bf16_t* A; const bf16_t* Bt; int M, N, K; };

struct StaticOrder {
    int nM, nN, nwg, G, c;
    __host__ __device__ void init(int M, int N, int G_, int c_) { nM = M / BM; nN = N / BM; nwg = nM * nN; G = G_; c = c_; }
    __host__ __device__ bool next(int i, Unit& u) const {
        const long L = (long)i * G + c; if (L >= nwg) return false;
        int wgid = (int)L; { const int q = nwg / NXCD, r = nwg % NXCD, xcd = wgid % NXCD, off = wgid / NXCD; wgid = (xcd < r ? xcd * (q + 1) : r * (q + 1) + (xcd - r) * q) + off; }
        const int nig = WGM * nN, gid = wgid / nig, fm = gid * WGM, gsz = (nM - fm) < WGM ? (nM - fm) : WGM;
        u.pm = fm + ((wgid % nig) % gsz); u.pn = (wgid % nig) / gsz; return true;
    }
    __device__ __forceinline__ void a_ready(const Unit&) const {}
    __device__ __forceinline__ void done(const Unit&) const {}
};

__device__ __forceinline__ unsigned cvt_pk_bf16(float lo, float hi) { unsigned r; asm volatile("v_cvt_pk_bf16_f32 %0, %1, %2" : "=v"(r) : "v"(lo), "v"(hi)); return r; }
typedef float f32x2 __attribute__((ext_vector_type(2)));
struct EpiF32 {
    static constexpr bool PERM = false, AFTER_DRAIN = false;
    float* C; int ldc;
    __device__ __forceinline__ void operator()(const f32x4 (&acc)[2][2][4][2], const Unit& u, int wr, int wc, int fr, int fq) const {
        const int row0 = u.pm * BM + wr * 64 + fr, col0 = u.pn * BM + wc * 32 + 4 * fq;
#pragma unroll
        for (int ai = 0; ai < 2; ++ai)
#pragma unroll
            for (int m = 0; m < 4; ++m) { float* rowp = C + (size_t)(row0 + ai * HALF + m * 16) * ldc + col0;
#pragma unroll
                for (int bj = 0; bj < 2; ++bj)
#pragma unroll
                    for (int n = 0; n < 2; ++n) *(f32x4*)(rowp + bj * HALF + n * 16) = acc[ai][bj][m][n]; }
    }
};
template <int ACT  > struct EpiBf16 {
    static constexpr bool PERM = true, AFTER_DRAIN = false;
    bf16_t* O; int ldc;
    __device__ __forceinline__ void operator()(const f32x4 (&acc)[2][2][4][2], const Unit& u, int wr, int wc, int fr, int fq) const {
        const int row0 = u.pm * BM + wr * 64 + fr; const int col0 = u.pn * BM + wc * 32 + 8 * fq;
#pragma unroll
        for (int ai = 0; ai < 2; ++ai)
#pragma unroll
            for (int m = 0; m < 4; ++m) { bf16_t* rowp = O + (size_t)(row0 + ai * HALF + m * 16) * ldc + col0;
#pragma unroll
                for (int bj = 0; bj < 2; ++bj) { f32x4 v0 = acc[ai][bj][m][0], v1 = acc[ai][bj][m][1];
                    if (ACT == 3) {
#pragma unroll
                        for (int j = 0; j < 4; ++j) { const float a = fmaxf(v0[j], 0.f), b = fmaxf(v1[j], 0.f); v0[j] = a * a; v1[j] = b * b; } }
                    u32x4 w; w.x = cvt_pk_bf16(v0[0], v0[1]); w.y = cvt_pk_bf16(v0[2], v0[3]); w.z = cvt_pk_bf16(v1[0], v1[1]); w.w = cvt_pk_bf16(v1[2], v1[3]);
                    *(u32x4*)(rowp + bj * HALF) = w; } }
    }
};
struct EpiQKV {
    static constexpr bool PERM = true, AFTER_DRAIN = false;
    bf16_t* O; int Mrows;
    __device__ __forceinline__ void operator()(const f32x4 (&acc)[2][2][4][2], const Unit& u, int wr, int wc, int fr, int fq) const {
        const int row0 = u.pm * BM + wr * 64 + fr;
#pragma unroll
        for (int bj = 0; bj < 2; ++bj) { bf16_t* hb = O + (size_t)(u.pn * 2 + bj) * Mrows * 128 + wc * 32 + 8 * fq;
#pragma unroll
            for (int ai = 0; ai < 2; ++ai)
#pragma unroll
                for (int m = 0; m < 4; ++m) { const f32x4 v0 = acc[ai][bj][m][0], v1 = acc[ai][bj][m][1];
                    u32x4 w; w.x = cvt_pk_bf16(v0[0], v0[1]); w.y = cvt_pk_bf16(v0[2], v0[3]); w.z = cvt_pk_bf16(v1[0], v1[1]); w.w = cvt_pk_bf16(v1[2], v1[3]);
                    *(u32x4*)(hb + (size_t)(row0 + ai * HALF + m * 16) * 128) = w; } }
    }
};
template <class Epi, class Sched, bool ALIGN_EPI = false, bool SP2 = false>
__device__ __forceinline__ void gemm_phase(PG8_LAS unsigned char* lds, const Gemm g, const Sched& S, const Epi& E) {
    int tid_ = threadIdx.x; asm volatile("" : "+v"(tid_));
    const int tid = tid_, wid = __builtin_amdgcn_readfirstlane(tid >> 6), lane = tid & 63, wr = wid >> 2, wc = wid & 3, fr = lane & 15, fq = lane >> 4;
    const int K = g.K, nt = K / BK;
    unsigned voffA[2], voffB[2];
#pragma unroll
    for (int i = 0; i < 2; ++i) { int R, C; stage_rc(tid * 16 + i * 8192, R, C); const int Rb = Epi::PERM ? ((R & ~31) + perm32(R & 31)) : R;
        voffA[i] = (unsigned)(R * K + C) * 2u; voffB[i] = (unsigned)(Rb * K + C) * 2u; }
    const size_t kstep = (size_t)(BK * 2);
    const size_t hstep = (size_t)HALF * K * 2;
    const size_t tstep = 2 * hstep;
    const unsigned ldsw = (unsigned)wid * 1024u;
    const int aoff = lds_byte(wr * 64 + fr, fq * 8), boff = lds_byte(wc * 32 + fr, fq * 8);
#define PG8_SA(b, h) (((b) * 2 + (h)) * HTB)
#define PG8_SB(b, h) ((4 + (b) * 2 + (h)) * HTB)
#define PG8_STAGE(bufoff, gbase, voff) do { _Pragma("unroll") for (int _i = 0; _i < 2; ++_i) \
        __builtin_amdgcn_global_load_lds((const unsigned*)((const char*)(gbase) + (voff)[_i]), (PG8_LAS unsigned*)(lds + (bufoff) + ldsw + _i * 8192), 16, 0, 0); } while (0)
#define PG8_LDA(dst, b, h) do { _Pragma("unroll") for (int m = 0; m < 4; ++m) _Pragma("unroll") for (int k = 0; k < 2; ++k) dst[m][k] = *(const PG8_LAS bf16x8*)(lds + PG8_SA(b, h) + aoff + m * 2048 + k * 1024); } while (0)
#define PG8_LDB(dst, b, h) do { _Pragma("unroll") for (int n = 0; n < 2; ++n) _Pragma("unroll") for (int k = 0; k < 2; ++k) dst[n][k] = *(const PG8_LAS bf16x8*)(lds + PG8_SB(b, h) + boff + n * 2048 + k * 1024); } while (0)
#define PG8_MMA(ai, bj, At, Bt) do { __builtin_amdgcn_s_setprio(1); _Pragma("unroll") for (int m = 0; m < 4; ++m) _Pragma("unroll") for (int n = 0; n < 2; ++n) _Pragma("unroll") for (int k = 0; k < 2; ++k) \
        acc[ai][bj][m][n] = __builtin_amdgcn_mfma_f32_16x16x32_bf16(Bt[n][k], At[m][k], acc[ai][bj][m][n], 0, 0, 0); __builtin_amdgcn_s_setprio(0); } while (0)
#define PG8_WAIT_V(n) asm volatile("s_waitcnt vmcnt(" #n ")" ::: "memory")
#define PG8_WAIT_L(n) asm volatile("s_waitcnt lgkmcnt(" #n ")" ::: "memory")
#define PG8_BAR __builtin_amdgcn_s_barrier()
#define PG8_SCHED __builtin_amdgcn_sched_barrier(0)
    Unit cur, nxt; int ui = 0;
    if (!S.next(0, cur)) return;
    f32x4 acc[2][2][4][2];
#pragma unroll
    for (int a = 0; a < 2; ++a)
#pragma unroll
        for (int b = 0; b < 2; ++b)
#pragma unroll
            for (int m = 0; m < 4; ++m)
#pragma unroll
                for (int n = 0; n < 2; ++n) acc[a][b][m][n] = (f32x4){0.f, 0.f, 0.f, 0.f};
    bf16x8 At[4][2], B0[2][2], B1[2][2];
    const char* cA = (const char*)g.A + (size_t)cur.pm * tstep; const char* cB = (const char*)g.Bt + (size_t)cur.pn * tstep;
    S.a_ready(cur);
    if constexpr (SP2) {
        PG8_STAGE(PG8_SB(0, 0), cB, voffB); PG8_STAGE(PG8_SB(0, 1), cB + hstep, voffB); PG8_STAGE(PG8_SA(0, 0), cA, voffA); PG8_STAGE(PG8_SA(0, 1), cA + hstep, voffA);
        if (wr == 1) PG8_BAR;
        PG8_WAIT_V(2); PG8_BAR;
        PG8_STAGE(PG8_SB(1, 0), cB + kstep, voffB); PG8_STAGE(PG8_SA(1, 0), cA + kstep, voffA); PG8_STAGE(PG8_SB(1, 1), cB + hstep + kstep, voffB);
        PG8_WAIT_V(6); PG8_BAR;
    } else {
        PG8_STAGE(PG8_SB(0, 0), cB, voffB); PG8_STAGE(PG8_SA(0, 0), cA, voffA); PG8_STAGE(PG8_SB(0, 1), cB + hstep, voffB); PG8_STAGE(PG8_SA(0, 1), cA + hstep, voffA);
        if (wr == 1) PG8_BAR;
        PG8_WAIT_V(4); PG8_BAR;
        PG8_STAGE(PG8_SB(1, 0), cB + kstep, voffB); PG8_STAGE(PG8_SA(1, 0), cA + kstep, voffA); PG8_STAGE(PG8_SB(1, 1), cB + hstep + kstep, voffB);
        PG8_WAIT_V(6); PG8_BAR;
    }
    for (;;) {
        const bool has_next = S.next(ui + 1, nxt);
        const char* nA = has_next ? (const char*)g.A + (size_t)nxt.pm * tstep : cA; const char* nB = has_next ? (const char*)g.Bt + (size_t)nxt.pn * tstep : cB;
        for (int t = 0; t < nt; t += 2) {
            const bool last = (t == nt - 2);
            const char* a1 = cA + (size_t)(t + 1) * kstep;
            const char* a2 = last ? nA : cA + (size_t)(t + 2) * kstep; const char* b2 = last ? nB : cB + (size_t)(t + 2) * kstep;
            const char* a3 = a2 + kstep; const char* b3 = b2 + kstep;
            if (last && has_next) S.a_ready(nxt);
            if constexpr (SP2) {
            PG8_LDB(B0, 0, 0); PG8_LDB(B1, 0, 1); PG8_SCHED; PG8_LDA(At, 0, 0); PG8_STAGE(PG8_SA(1, 1), a1 + hstep, voffA);
            PG8_WAIT_V(8); PG8_WAIT_L(0); PG8_BAR; PG8_MMA(0, 0, At, B0); PG8_MMA(0, 1, At, B1); PG8_BAR; PG8_SCHED;
            PG8_LDA(At, 0, 1); PG8_STAGE(PG8_SB(0, 0), b2, voffB); PG8_STAGE(PG8_SB(0, 1), b2 + hstep, voffB); PG8_STAGE(PG8_SA(0, 0), a2, voffA);
            PG8_WAIT_V(8); PG8_WAIT_L(0); PG8_BAR; PG8_MMA(1, 0, At, B0); PG8_MMA(1, 1, At, B1); PG8_BAR; PG8_SCHED;
            PG8_LDB(B0, 1, 0); PG8_LDB(B1, 1, 1); PG8_SCHED; PG8_LDA(At, 1, 0); PG8_STAGE(PG8_SA(0, 1), a2 + hstep, voffA);
            PG8_WAIT_V(8); PG8_WAIT_L(0); PG8_BAR; PG8_MMA(0, 0, At, B0); PG8_MMA(0, 1, At, B1); PG8_BAR; PG8_SCHED;
            PG8_LDA(At, 1, 1); PG8_STAGE(PG8_SB(1, 0), b3, voffB); PG8_STAGE(PG8_SB(1, 1), b3 + hstep, voffB); PG8_STAGE(PG8_SA(1, 0), a3, voffA);
            PG8_WAIT_V(8); PG8_WAIT_L(0); PG8_BAR; PG8_MMA(1, 0, At, B0); PG8_MMA(1, 1, At, B1); PG8_BAR; PG8_SCHED;
            } else {
            PG8_LDB(B0, 0, 0); PG8_SCHED; PG8_LDA(At, 0, 0); PG8_STAGE(PG8_SA(1, 1), a1 + hstep, voffA);
            PG8_WAIT_L(8); PG8_BAR; PG8_WAIT_L(0); PG8_MMA(0, 0, At, B0); PG8_BAR; PG8_SCHED;
            PG8_LDB(B1, 0, 1); PG8_STAGE(PG8_SB(0, 0), b2, voffB);
            PG8_BAR; PG8_WAIT_L(0); PG8_MMA(0, 1, At, B1); PG8_BAR;
            PG8_LDA(At, 0, 1); PG8_STAGE(PG8_SA(0, 0), a2, voffA);
            PG8_BAR; PG8_WAIT_L(0); PG8_MMA(1, 0, At, B0); PG8_BAR; PG8_SCHED;
            PG8_STAGE(PG8_SB(0, 1), b2 + hstep, voffB);
            PG8_WAIT_V(6); PG8_BAR; PG8_MMA(1, 1, At, B1); PG8_BAR;
            PG8_LDB(B0, 1, 0); PG8_SCHED; PG8_LDA(At, 1, 0); PG8_STAGE(PG8_SA(0, 1), a2 + hstep, voffA);
            PG8_WAIT_L(8); PG8_BAR; PG8_WAIT_L(0); PG8_MMA(0, 0, At, B0); PG8_BAR; PG8_SCHED;
            PG8_LDB(B1, 1, 1); PG8_STAGE(PG8_SB(1, 0), b3, voffB);
            PG8_BAR; PG8_WAIT_L(0); PG8_MMA(0, 1, At, B1); PG8_BAR;
            PG8_LDA(At, 1, 1); PG8_STAGE(PG8_SA(1, 0), a3, voffA);
            PG8_BAR; PG8_WAIT_L(0); PG8_MMA(1, 0, At, B0); PG8_BAR; PG8_SCHED;
            PG8_STAGE(PG8_SB(1, 1), b3 + hstep, voffB);
            PG8_WAIT_V(6); PG8_BAR; PG8_MMA(1, 1, At, B1); PG8_BAR;
            }
        }
        if constexpr (ALIGN_EPI) { if (wr == 0) PG8_BAR; }
        if constexpr (!Epi::AFTER_DRAIN) { E(acc, cur, wr, wc, fr, fq); S.done(cur); }
        if (!has_next) break;
#pragma unroll
        for (int a = 0; a < 2; ++a)
#pragma unroll
            for (int b = 0; b < 2; ++b)
#pragma unroll
                for (int m = 0; m < 4; ++m)
#pragma unroll
                    for (int n = 0; n < 2; ++n) acc[a][b][m][n] = (f32x4){0.f, 0.f, 0.f, 0.f};
        cur = nxt; cA = nA; cB = nB; ++ui;
        if constexpr (ALIGN_EPI) { if (wr == 1) PG8_BAR; }
    }
    PG8_WAIT_V(0);
    if constexpr (!ALIGN_EPI) { if (wr == 0) PG8_BAR; }
    PG8_BAR;
    if constexpr (Epi::AFTER_DRAIN) { E.fused(acc, cur, wr, wc, fr, fq, lds, wid, lane); S.done(cur); }
#undef PG8_SA
#undef PG8_SB
#undef PG8_STAGE
#undef PG8_LDA
#undef PG8_LDB
#undef PG8_MMA
#undef PG8_WAIT_V
#undef PG8_WAIT_L
#undef PG8_BAR
#undef PG8_SCHED
}
}
namespace att {
typedef unsigned short bf16;
using bf16x8 = __attribute__((ext_vector_type(8))) short;
using s16x4  = __attribute__((ext_vector_type(4))) short;
using f32x16 = __attribute__((ext_vector_type(16))) float;
using u32x4  = __attribute__((ext_vector_type(4))) unsigned;
constexpr int   D = 128, NW = 8, QBLK = 32, KVBLK = 64;
constexpr float SCALE = 0.088388347648318440f;
constexpr float LOG2E = 1.4426950408889634f;
constexpr float C2 = SCALE * LOG2E;
constexpr float THR = 8.f;
constexpr int SHM_V = KVBLK * D * 2, SHM_K = KVBLK * D * 2;
constexpr int LDS_WS = 2 * SHM_V + 2 * SHM_K, LDS_TB = LDS_WS + NW * 64 * 4, LDS_ATT_BYTES = LDS_TB + 4096;
#define KSWZ(row, colB) ((row) * 256 + ((colB) ^ (((row) & 7) << 4)))
#define SBAR() __builtin_amdgcn_sched_barrier(0)
__device__ __forceinline__ int crow(int r, int hi) { return (r & 3) + 8 * (r >> 2) + 4 * hi; }
__device__ __forceinline__ unsigned cvtpk(float lo, float hi) { unsigned r; asm volatile("v_cvt_pk_bf16_f32 %0, %1, %2" : "=v"(r) : "v"(lo), "v"(hi)); return r; }
__device__ __forceinline__ bf16x8 ld8(const bf16* p) { return *reinterpret_cast<const bf16x8*>(p); }

struct MaskCtx { int a, v, d; const float* tbl; };
constexpr int TB_ORG = 256;

__device__ __forceinline__ void partialSM(f32x16& p0, f32x16& p1, float& m_reg, float& mn, float& alpha) {
  float pmax = p0[0];
#pragma unroll
  for (int r = 1; r < 16; ++r) pmax = fmaxf(pmax, p0[r]);
#pragma unroll
  for (int r = 0; r < 16; ++r) pmax = fmaxf(pmax, p1[r]);
  { auto rr = __builtin_amdgcn_permlane32_swap(__float_as_uint(pmax), __float_as_uint(pmax), false, false);
    pmax = fmaxf(__uint_as_float(rr[0]), __uint_as_float(rr[1])); }
  if (__builtin_expect(__all(pmax - m_reg <= THR / SCALE), 1)) { mn = m_reg; alpha = 1.f; }
  else { mn = fmaxf(m_reg, pmax); alpha = __builtin_amdgcn_exp2f((m_reg - mn) * C2); m_reg = mn; }
  float mnC = -mn * C2;
#pragma unroll
  for (int r = 0; r < 16; ++r) p0[r] = fmaf(p0[r], C2, mnC);
#pragma unroll
  for (int r = 0; r < 16; ++r) p1[r] = fmaf(p1[r], C2, mnC);
#pragma unroll
  for (int r = 0; r < 16; ++r) p0[r] = __builtin_amdgcn_exp2f(p0[r]);
}
template <int KIND>
__device__ __forceinline__ void partialSM_m(f32x16& p0, f32x16& p1, float& m_reg, float& mn, float& alpha, int jt, const MaskCtx& mc) {
  const float* tp = (KIND == 1) ? mc.tbl + (jt - mc.a + 7) * 31 : mc.tbl + jt * 64;
  float b0[16], b1[16];
#pragma unroll
  for (int r = 0; r < 16; ++r) { const int kc = (r & 3) + 8 * (r >> 2); b0[r] = tp[kc]; b1[r] = tp[kc + 32]; }
#pragma unroll
  for (int r = 0; r < 16; ++r) asm volatile("" : "+v"(b0[r]), "+v"(b1[r]));
  if (KIND == 1) {
    const bool rowok = (unsigned)(jt - min(max(mc.a - 4, 0), 120)) <= 7u;
#pragma unroll
    for (int r = 0; r < 16; ++r) { const int kc = (r & 3) + 8 * (r >> 2);
      { const bool ok = rowok && (unsigned)(kc - mc.v) <= 15u; const float t = fmaf(p0[r], C2, b0[r]); p0[r] = ok ? t : -1e30f; }
      { const bool ok = rowok && (unsigned)(kc + 32 - mc.v) <= 15u; const float t = fmaf(p1[r], C2, b1[r]); p1[r] = ok ? t : -1e30f; } }
  } else {
    const bool tok = (unsigned)jt < (unsigned)mc.d;
    const int db = jt * 64 + mc.v;
#pragma unroll
    for (int r = 0; r < 16; ++r) { const int kc = (r & 3) + 8 * (r >> 2);
      { const bool ok = tok && (unsigned)(db + kc) <= 128u; const float t = fmaf(p0[r], C2, b0[r]); p0[r] = ok ? t : -1e30f; }
      { const bool ok = tok && (unsigned)(db + kc + 32) <= 128u; const float t = fmaf(p1[r], C2, b1[r]); p1[r] = ok ? t : -1e30f; } }
  }
  float pmax = p0[0];
#pragma unroll
  for (int r = 1; r < 16; ++r) pmax = fmaxf(pmax, p0[r]);
#pragma unroll
  for (int r = 0; r < 16; ++r) pmax = fmaxf(pmax, p1[r]);
  { auto rr = __builtin_amdgcn_permlane32_swap(__float_as_uint(pmax), __float_as_uint(pmax), false, false);
    pmax = fmaxf(__uint_as_float(rr[0]), __uint_as_float(rr[1])); }
  if (__builtin_expect(__all(pmax - m_reg <= THR * LOG2E), 1)) { mn = m_reg; alpha = 1.f; }
  else { mn = fmaxf(m_reg, pmax); alpha = __builtin_amdgcn_exp2f(m_reg - mn); m_reg = mn; }
#pragma unroll
  for (int r = 0; r < 16; ++r) p0[r] -= mn;
#pragma unroll
  for (int r = 0; r < 16; ++r) p1[r] -= mn;
#pragma unroll
  for (int r = 0; r < 16; ++r) p0[r] = __builtin_amdgcn_exp2f(p0[r]);
}
__device__ __forceinline__ void finishSM(f32x16& p0, f32x16& p1, float alpha, float& l_reg, bf16x8& pa0, bf16x8& pa1, bf16x8& pa2, bf16x8& pa3) {
#pragma unroll
  for (int r = 0; r < 16; ++r) p1[r] = __builtin_amdgcn_exp2f(p1[r]);
  float ps = 0;
#pragma unroll
  for (int r = 0; r < 16; ++r) ps += p0[r];
#pragma unroll
  for (int r = 0; r < 16; ++r) ps += p1[r];
  { auto rr = __builtin_amdgcn_permlane32_swap(__float_as_uint(ps), __float_as_uint(ps), false, false);
    ps = __uint_as_float(rr[0]) + __uint_as_float(rr[1]); }
  l_reg = l_reg * alpha + ps;
#define PK4(P, BASE, OUT) do { unsigned a0 = cvtpk(P[BASE + 0], P[BASE + 1]), a1 = cvtpk(P[BASE + 2], P[BASE + 3]);   \
    unsigned b0 = cvtpk(P[BASE + 4], P[BASE + 5]), b1 = cvtpk(P[BASE + 6], P[BASE + 7]);                              \
    auto r0 = __builtin_amdgcn_permlane32_swap(a0, b0, false, false); auto r1 = __builtin_amdgcn_permlane32_swap(a1, b1, false, false); \
    u32x4 w = {r0[0], r1[0], r0[1], r1[1]}; OUT = *reinterpret_cast<bf16x8*>(&w); } while (0)
  PK4(p0, 0, pa0); PK4(p0, 8, pa1); PK4(p1, 0, pa2); PK4(p1, 8, pa3);
#undef PK4
}
__device__ __forceinline__ void qkt(f32x16& p0, f32x16& p1, const bf16* Ks, const bf16x8* qr, int r32, int hi) {
  p0 = f32x16{}; p1 = f32x16{};
#pragma unroll
  for (int d0 = 0; d0 < 8; ++d0) { int cb = (d0 * 16 + hi * 8) * 2;
    bf16x8 b0 = *reinterpret_cast<const bf16x8*>((const char*)Ks + KSWZ(r32, cb));
    bf16x8 b1 = *reinterpret_cast<const bf16x8*>((const char*)Ks + KSWZ(32 + r32, cb));
    p0 = __builtin_amdgcn_mfma_f32_32x32x16_bf16(b0, qr[d0], p0, 0, 0, 0);
    p1 = __builtin_amdgcn_mfma_f32_32x32x16_bf16(b1, qr[d0], p1, 0, 0, 0); }
}
__device__ __forceinline__ int v_st(int k, int c) { const int kk = (k & ~0xC) | ((k & 4) << 1) | ((k & 8) >> 1); return ((kk >> 3) * 4 + (c >> 5)) * 512 + ((kk & 7) * 32 + (c & 31)) * 2; }
__device__ __forceinline__ int v_rd_base(int lane) { return ((lane & 3) << 3) | (((lane >> 2) & 3) << 6) | (((lane >> 4) & 1) << 5) | (((lane >> 5) & 1) << 8); }
constexpr int v_rd_off(int d0, int ks, int half) { return d0 * 512 + ks * 4096 + half * 2048; }
template <int OFF> __device__ __forceinline__ s16x4 tr_read(int vb) {
  s16x4 r; asm volatile("ds_read_b64_tr_b16 %0, %1 offset:%2" : "=&v"(r) : "v"(vb), "i"(OFF) : "memory"); return r;
}
template <int D0> __device__ __forceinline__ void pv_one(f32x16& od, int vb, bf16x8 pa0, bf16x8 pa1, bf16x8 pa2, bf16x8 pa3) {
  const s16x4 l0 = tr_read<v_rd_off(D0, 0, 0)>(vb), h0 = tr_read<v_rd_off(D0, 0, 1)>(vb), l1 = tr_read<v_rd_off(D0, 1, 0)>(vb), h1 = tr_read<v_rd_off(D0, 1, 1)>(vb);
  const s16x4 l2 = tr_read<v_rd_off(D0, 2, 0)>(vb), h2 = tr_read<v_rd_off(D0, 2, 1)>(vb), l3 = tr_read<v_rd_off(D0, 3, 0)>(vb), h3 = tr_read<v_rd_off(D0, 3, 1)>(vb);
  asm volatile("s_waitcnt lgkmcnt(0)" ::: "memory"); SBAR();
#define PK(L, H) (bf16x8){L[0], L[1], L[2], L[3], H[0], H[1], H[2], H[3]}
  od = __builtin_amdgcn_mfma_f32_32x32x16_bf16(pa0, PK(l0, h0), od, 0, 0, 0);
  od = __builtin_amdgcn_mfma_f32_32x32x16_bf16(pa1, PK(l1, h1), od, 0, 0, 0);
  od = __builtin_amdgcn_mfma_f32_32x32x16_bf16(pa2, PK(l2, h2), od, 0, 0, 0);
  od = __builtin_amdgcn_mfma_f32_32x32x16_bf16(pa3, PK(l3, h3), od, 0, 0, 0);
#undef PK
}
__device__ __forceinline__ void pv_d0(f32x16* o, int vb, bf16x8 pa0, bf16x8 pa1, bf16x8 pa2, bf16x8 pa3) {
  pv_one<0>(o[0], vb, pa0, pa1, pa2, pa3); pv_one<1>(o[1], vb, pa0, pa1, pa2, pa3); pv_one<2>(o[2], vb, pa0, pa1, pa2, pa3); pv_one<3>(o[3], vb, pa0, pa1, pa2, pa3);
}

template <int KIND>
__device__ __forceinline__ void attn_unit(const bf16* __restrict__ Qb, long qs, const bf16* __restrict__ Kh, const bf16* __restrict__ Vh, long ks,
                                          int kt0, int NT, int ktmax, bf16* __restrict__ Ob, long os, float* __restrict__ stp, long sts,
                                          int mq0, const float* __restrict__ tbsrc, int tbn, char* lds,
                                          const float* __restrict__ qg = nullptr, const float* __restrict__ rope = nullptr, int t0 = 0) {
  int tid_ = threadIdx.x; asm volatile("" : "+v"(tid_));
  const int tid = tid_, wid = __builtin_amdgcn_readfirstlane(tid >> 6), lane = tid & 63, r32 = lane & 31, hi = lane >> 5;
  bf16* V_lds = (bf16*)lds; bf16* K_lds = (bf16*)(lds + 2 * SHM_V);
  float* ws = (float*)(lds + LDS_WS) + wid * 64; float* li_l = ws; float* al_l = ws + 32;
  float* tb = (float*)(lds + LDS_TB);
  MaskCtx mc; mc.a = 0; mc.v = 0; mc.d = 0; mc.tbl = tb;
  if (KIND == 1) { const int r = mq0 + (wid >> 1), c = (wid & 1) * 32 + r32; mc.a = r; mc.v = min(max(c - 8, 0), 48) - 4 * hi; mc.tbl = tb + TB_ORG + 15 - c + 4 * hi; }
  if (KIND == 2) { mc.v = 64 - (mq0 + wid * 32 + r32) + 4 * hi; mc.d = ktmax; mc.tbl = tb + TB_ORG + mc.v; }
  if (KIND != 0) { __syncthreads();
    for (int i = tid; i < tbn; i += 64 * NW) tb[TB_ORG + i] = tbsrc[i] * LOG2E; }
  float m_reg = -1e30f, l_reg = 0; f32x16 o[4] = {}; bf16x8 qr[8];
  const bf16* Qw = Qb + (long)(wid * QBLK + r32) * qs + hi * 8;
#pragma unroll
  for (int d0 = 0; d0 < 8; ++d0) qr[d0] = ld8(Qw + d0 * 16);
  if (KIND == 0 && qg != nullptr) {
    float x[8][8];
#pragma unroll
    for (int d0 = 0; d0 < 8; ++d0) { const u32x4 w = *reinterpret_cast<const u32x4*>(&qr[d0]);
      x[d0][0] = __uint_as_float(w[0] << 16); x[d0][1] = __uint_as_float(w[0] & 0xffff0000u); x[d0][2] = __uint_as_float(w[1] << 16); x[d0][3] = __uint_as_float(w[1] & 0xffff0000u);
      x[d0][4] = __uint_as_float(w[2] << 16); x[d0][5] = __uint_as_float(w[2] & 0xffff0000u); x[d0][6] = __uint_as_float(w[3] << 16); x[d0][7] = __uint_as_float(w[3] & 0xffff0000u); }
    float ss = 0.f;
#pragma unroll
    for (int d0 = 0; d0 < 8; ++d0)
#pragma unroll
      for (int i = 0; i < 8; ++i) ss += x[d0][i] * x[d0][i];
    ss += __shfl_xor(ss, 32);
    const float rstd = 1.0f / sqrtf(ss * (1.0f / 128.0f) + 1e-6f);
#pragma unroll
    for (int d0 = 0; d0 < 8; ++d0) { const float* gp = qg + d0 * 16 + hi * 8; const float4 g0 = *reinterpret_cast<const float4*>(gp), g1 = *reinterpret_cast<const float4*>(gp + 4);
      x[d0][0] *= rstd * g0.x; x[d0][1] *= rstd * g0.y; x[d0][2] *= rstd * g0.z; x[d0][3] *= rstd * g0.w; x[d0][4] *= rstd * g1.x; x[d0][5] *= rstd * g1.y; x[d0][6] *= rstd * g1.z; x[d0][7] *= rstd * g1.w; }
    const int t = t0 + wid * QBLK + r32;
#pragma unroll
    for (int half = 0; half < 2; ++half) { const int pos = half ? (t & 63) : (t >> 6);
#pragma unroll
      for (int dd = 0; dd < 2; ++dd) { const int d1 = half * 4 + dd, d2 = d1 + 2; const float* rp = rope + pos * 32 + dd * 16 + hi * 8;
        const float4 c0 = *reinterpret_cast<const float4*>(rp), c1 = *reinterpret_cast<const float4*>(rp + 4), s0 = *reinterpret_cast<const float4*>(rp + 4096), s1 = *reinterpret_cast<const float4*>(rp + 4100);
        const float cs[8] = {c0.x, c0.y, c0.z, c0.w, c1.x, c1.y, c1.z, c1.w}, sn[8] = {s0.x, s0.y, s0.z, s0.w, s1.x, s1.y, s1.z, s1.w};
#pragma unroll
        for (int i = 0; i < 8; ++i) { const float a1 = x[d1][i], a2 = x[d2][i]; x[d1][i] = a1 * cs[i] - a2 * sn[i]; x[d2][i] = a1 * sn[i] + a2 * cs[i]; } } }
#pragma unroll
    for (int d0 = 0; d0 < 8; ++d0) { u32x4 w = {cvtpk(x[d0][0], x[d0][1]), cvtpk(x[d0][2], x[d0][3]), cvtpk(x[d0][4], x[d0][5]), cvtpk(x[d0][6], x[d0][7])}; qr[d0] = *reinterpret_cast<bf16x8*>(&w); }
  }
  const int sr = tid >> 4, sc = (tid & 15) * 8, vst0 = v_st(sr, sc), vst1 = v_st(32 + sr, sc);
  const int vb0 = (int)(uintptr_t)V_lds + v_rd_base(lane);
  const bf16* Kp = Kh + (long)sr * ks + sc; const bf16* Vp = Vh + (long)sr * ks + sc; const long o32 = 32 * ks, tstep = 64 * ks;
  struct { bf16x8 vs0, vs1, ks0, ks1; } sr_[2];
#define TCL(j) ((long)min(max(kt0 + (j), 0), ktmax - 1))
#define SLOAD(i, j) do { const long off_ = TCL(j) * tstep; sr_[i].vs0 = ld8(Vp + off_); sr_[i].vs1 = ld8(Vp + off_ + o32); sr_[i].ks0 = ld8(Kp + off_); sr_[i].ks1 = ld8(Kp + off_ + o32); } while (0)
#define SWRITE(b, i) do { *(bf16x8*)((char*)V_lds + (b) * SHM_V + vst0) = sr_[i].vs0;          \
    *(bf16x8*)((char*)V_lds + (b) * SHM_V + vst1) = sr_[i].vs1; int kc = sc * 2;               \
    *(bf16x8*)((char*)K_lds + (b) * SHM_K + KSWZ(sr, kc)) = sr_[i].ks0;                       \
    *(bf16x8*)((char*)K_lds + (b) * SHM_K + KSWZ(32 + sr, kc)) = sr_[i].ks1; } while (0)
#define SWAIT() asm volatile("s_waitcnt vmcnt(4)" ::: "memory")
#define RESC(a) do { if (__any((a) < 1.f)) { if (hi == 0) al_l[r32] = (a); asm volatile("s_waitcnt lgkmcnt(0)" ::: "memory"); \
    _Pragma("unroll") for (int d = 0; d < 4; ++d) _Pragma("unroll") for (int r = 0; r < 16; ++r) o[d][r] *= al_l[crow(r, hi)]; } } while (0)
  bf16x8 pa0, pa1, pa2, pa3;
  if constexpr (KIND == 0) {
    f32x16 pA0, pA1, pB0, pB1; float mnA, mnB, alA, alB;
    constexpr int SE = 0, SO = 1;
    SLOAD(SE, 0); asm volatile("s_waitcnt vmcnt(0)" ::: "memory"); SWRITE(0, SE); __syncthreads();
    qkt(pA0, pA1, K_lds, qr, r32, hi); partialSM(pA0, pA1, m_reg, mnA, alA);
    SLOAD(SO, 1); if (2 < NT) SLOAD(SE, 2);
    SWAIT(); SWRITE(1, SO); __syncthreads();
    for (int j = 1; j + 1 < NT; j += 2) {
      SBAR(); qkt(pB0, pB1, (bf16*)((char*)K_lds + SHM_K), qr, r32, hi);
      finishSM(pA0, pA1, alA, l_reg, pa0, pa1, pa2, pa3); SBAR();
      SLOAD(SO, j + 2); SBAR();
      pv_d0(o, vb0, pa0, pa1, pa2, pa3); partialSM(pB0, pB1, m_reg, mnB, alB);
      __syncthreads(); SWAIT(); SWRITE(0, SE);
      RESC(alB); __syncthreads();
      SBAR(); qkt(pA0, pA1, K_lds, qr, r32, hi);
      finishSM(pB0, pB1, alB, l_reg, pa0, pa1, pa2, pa3); SBAR();
      if (j + 3 < NT) SLOAD(SE, j + 3); SBAR();
      pv_d0(o, vb0 + (int)SHM_V, pa0, pa1, pa2, pa3); partialSM(pA0, pA1, m_reg, mnA, alA);
      __syncthreads(); SWAIT(); SWRITE(1, SO);
      RESC(alA); __syncthreads();
    }
    SBAR(); qkt(pB0, pB1, (bf16*)((char*)K_lds + SHM_K), qr, r32, hi);
    finishSM(pA0, pA1, alA, l_reg, pa0, pa1, pa2, pa3); SBAR();
    pv_d0(o, vb0, pa0, pa1, pa2, pa3); partialSM(pB0, pB1, m_reg, mnB, alB);
    __syncthreads(); RESC(alB);
    finishSM(pB0, pB1, alB, l_reg, pa0, pa1, pa2, pa3); SBAR();
    pv_d0(o, vb0 + (int)SHM_V, pa0, pa1, pa2, pa3);
  } else {
    const int nd_lo = (KIND == 1) ? min(max(mq0 + (wid >> 1) - 4, 0), 120) : (mq0 + 32 * wid - 127);
    const int nd_hi = mq0 + 32 * wid + 95;
#define NEED(jt) ((KIND == 1) ? ((unsigned)((jt) - nd_lo) <= 7u) : ((unsigned)(jt) < (unsigned)ktmax && 64 * (jt) >= nd_lo && 64 * (jt) <= nd_hi))
    f32x16 p0, p1; float mn, al;
    SLOAD(0, 0); SLOAD(1, 1);
#define STEP(J, B) do { SWRITE(B, B); if ((J) + 2 < NT) SLOAD(B, (J) + 2); __syncthreads();                                     \
      if (NEED(kt0 + (J))) { qkt(p0, p1, (bf16*)((char*)K_lds + (B) * SHM_K), qr, r32, hi); partialSM_m<KIND>(p0, p1, m_reg, mn, al, kt0 + (J), mc); RESC(al); \
        finishSM(p0, p1, al, l_reg, pa0, pa1, pa2, pa3); SBAR(); pv_d0(o, vb0 + (B) * (int)SHM_V, pa0, pa1, pa2, pa3); } } while (0)
    for (int j = 0; j < NT; j += 2) { STEP(j, 0); STEP(j + 1, 1); }
#undef STEP
#undef NEED
  }
  if (hi == 0) li_l[r32] = l_reg; asm volatile("s_waitcnt lgkmcnt(0)" ::: "memory");
  if (KIND == 2) { if (hi == 0) { float* sp = stp + (long)(wid * QBLK + r32) * sts; sp[0] = m_reg; sp[1] = l_reg; } }
  float rli[16];
#pragma unroll
  for (int r = 0; r < 16; ++r) rli[r] = __builtin_amdgcn_rcpf(li_l[crow(r, hi)]);
  bf16* Ow = Ob + (long)(wid * QBLK) * os;
#pragma unroll
  for (int r = 0; r < 16; ++r) { const int orow = crow(r, hi);
#pragma unroll
    for (int d0 = 0; d0 < 4; ++d0) { const float v = o[d0][r] * rli[r]; Ow[(long)orow * os + d0 * 32 + r32] = (bf16)(cvtpk(v, v) & 0xffffu); } }
#undef TCL
#undef SLOAD
#undef SWRITE
#undef SWAIT
#undef RESC
}
}
#define GAS __attribute__((address_space(1)))
#define LAS __attribute__((address_space(3)))
typedef unsigned short bf16;
typedef unsigned v4u __attribute__((ext_vector_type(4)));
typedef float f32x4 __attribute__((ext_vector_type(4)));
typedef short bf16x8 __attribute__((ext_vector_type(8)));
typedef GAS unsigned gu32;
typedef GAS unsigned long long gu64;
#define RLX_AGENT __ATOMIC_RELAXED, __HIP_MEMORY_SCOPE_AGENT
#define LDS_WAIT() asm volatile("s_waitcnt lgkmcnt(0)" ::: "memory")
#define VM_WAIT() asm volatile("s_waitcnt vmcnt(0)" ::: "memory")
__device__ __forceinline__ unsigned long long rt() { return __builtin_amdgcn_s_memrealtime(); }
__device__ __forceinline__ unsigned f2bf(float f) { unsigned u = __builtin_bit_cast(unsigned, f); return (u + 0x7fffu + ((u >> 16) & 1u)) >> 16; }
__device__ __forceinline__ unsigned pk2(float lo, float hi) { return f2bf(lo) | (f2bf(hi) << 16); }

#define XB_TMO      128
#define XB_XCNT(j)  (256  + 64 * (j))
#define XB_XSUB(j)  (1280 + 64 * (j))
#define XB_XGEN(j)  (2304 + 64 * (j))
#define XB_TOP      3328
#define XB_TOPGEN   3392
#define XCD_BAR_WORDS 3456
#define XB_SPIN_CAP (1u << 18)

__device__ __forceinline__ unsigned xb_ld(unsigned* p)              { return __hip_atomic_load(p, __ATOMIC_RELAXED, __HIP_MEMORY_SCOPE_AGENT); }
__device__ __forceinline__ unsigned xb_add(unsigned* p, unsigned v) { return __hip_atomic_fetch_add(p, v, __ATOMIC_RELAXED, __HIP_MEMORY_SCOPE_AGENT); }
__device__ __forceinline__ unsigned xb_xcc_id() { return (unsigned)__builtin_amdgcn_s_getreg((3 << 11) | 20) & 0xFu; }
#define XB_SPIN(cond, bar) do { unsigned _sp = 0; while (cond) { __builtin_amdgcn_s_sleep(1); \
    if ((++_sp & 255u) == 0u) { if (xb_ld(&(bar)[XB_TMO])) break; if (_sp > XB_SPIN_CAP) { atomicAdd(&(bar)[XB_TMO], 1u); break; } } } } while (0)

struct XcdBarrier {
    unsigned* bar; unsigned x;
    volatile LAS unsigned* st;
};

__device__ __forceinline__ XcdBarrier xcd_barrier_post(unsigned* bar, volatile LAS unsigned* st) {
    XcdBarrier b; b.bar = bar; b.x = xb_xcc_id(); b.st = st;
    if (threadIdx.x == 0) (void)xb_add(&bar[XB_XCNT(b.x)], 1u);
    return b;
}
__device__ __forceinline__ void xcd_barrier_complete(unsigned* bar, unsigned x, unsigned& nloc, unsigned& nx) {
    const unsigned G = gridDim.x * gridDim.y * gridDim.z;
    unsigned sum, cnt, mine, sp = 0u;
    for (;;) {
        sum = 0u; cnt = 0u; mine = 0u;
#pragma unroll
        for (unsigned j = 0; j < 16; ++j) { const unsigned c = xb_ld(&bar[XB_XCNT(j)]); sum += c; cnt += (c > 0u) ? 1u : 0u; mine = (j == x) ? c : mine; }
        if (sum == G) break;
        __builtin_amdgcn_s_sleep(1);
        if ((++sp & 255u) == 0u) { if (xb_ld(&bar[XB_TMO])) break; if (sp > XB_SPIN_CAP) { atomicAdd(&bar[XB_TMO], 1u); break; } }
    }
    nloc = mine > 0u ? mine : 1u; nx = cnt > 0u ? cnt : 1u;
}

__device__ __forceinline__ void xcd_barrier(const XcdBarrier& b) {
    asm volatile("s_waitcnt vmcnt(0)" ::: "memory");
    __syncthreads();
    if (threadIdx.x == 0) {
        unsigned* bar = b.bar;
        __builtin_amdgcn_s_waitcnt(0);
        unsigned nloc = b.st[0], nx = b.st[1];
        if (nloc == 0u) { xcd_barrier_complete(bar, b.x, nloc, nx); b.st[0] = nloc; b.st[1] = nx; }
        const unsigned old = xb_add(&bar[XB_XSUB(b.x)], 1u);
        const unsigned gen = old / nloc;
        if (old + 1u == (gen + 1u) * nloc) {
            __builtin_amdgcn_fence(__ATOMIC_RELEASE, "agent");
            asm volatile("s_waitcnt vmcnt(0)" ::: "memory");
            const unsigned og = xb_add(&bar[XB_TOP], 1u);
            const unsigned tg = og / nx;
            if (og + 1u == (tg + 1u) * nx) xb_add(&bar[XB_TOPGEN], 1u);
            else XB_SPIN(xb_ld(&bar[XB_TOPGEN]) == tg, bar);
            __builtin_amdgcn_fence(__ATOMIC_ACQUIRE, "agent");
            xb_add(&bar[XB_XGEN(b.x)], 1u);
            asm volatile("s_waitcnt vmcnt(0)" ::: "memory");
        } else {
            XB_SPIN(xb_ld(&bar[XB_XGEN(b.x)]) == gen, bar);
            __builtin_amdgcn_fence(__ATOMIC_ACQUIRE, "agent");
            asm volatile("s_waitcnt vmcnt(0)" ::: "memory");
        }
    }
    __syncthreads();
}
constexpr int BATCH = 2, SEQ = 8192, DM = 4096, DEPTH = 4, HDIM = 128, H_NA = 8, H_DIL = 12, H_GQA = 12, KV_GQA = 4;
constexpr int NQKV = 10240, DFF = 16384, M = BATCH * SEQ, NMOD = 6;
constexpr int Q_NA = 0, Q_DIL = 1024, Q_GQA = 2560, K_NA = 4096, K_DIL = 5120, K_GQA = 6656, V_NA = 7168, V_DIL = 8192, V_GQA = 9728;
constexpr int O_NA = 0, O_DIL = 1024, O_GQA = 2560, DILW = H_DIL * HDIM;
constexpr float EPS = 1e-6f;
constexpr size_t MiB = 1u << 20;
constexpr size_t WS_CTL = 0, CTL_ZERO_BYTES = 1 * MiB;
constexpr size_t WS_MODP = 1 * MiB;
constexpr size_t WS_MODV = 4 * MiB;
constexpr size_t WS_ROPE = 5 * MiB;
constexpr size_t WS_DILTB = 5 * MiB + 64 * 1024;
constexpr size_t WS_DILST = 6 * MiB;
constexpr size_t WS_WIN = 16 * MiB, WS_WOUT = 336 * MiB, WS_W1 = 464 * MiB, WS_W2 = 976 * MiB;
constexpr size_t WS_H = 1488 * MiB, WS_QKV = 1616 * MiB, WS_O = 1936 * MiB, WS_Y = 2064 * MiB, WS_U = 2320 * MiB, WS_DILP = 2832 * MiB, WS_XB = 2976 * MiB, WS_END = 3104 * MiB;
static_assert(WS_DILST + (size_t)3 * M * 12 * 2 * 4 <= WS_WIN, "ws map");
constexpr int CW_BAR = 4096, CW_QUEUE = 16384;
constexpr int RING_OFF = 0, RING_BYTES = 131072, LDSCTL_OFF = RING_BYTES, MISC_OFF = LDSCTL_OFF + 320, LDS_BYTES = 147456;
constexpr int NWAVES = 8;

struct Frame {
    LAS unsigned char* lds; volatile LAS unsigned* MISC;
    int G;
};
__device__ __forceinline__ float wave_sum(float v) {
#pragma unroll
    for (int o = 1; o < 64; o <<= 1) v += __shfl_xor(v, o);
    return v;
}
__device__ __forceinline__ float bf2f(unsigned short b) { return __uint_as_float(((unsigned)b) << 16); }
struct XItem { const float* src; bf16* dst; int K, N; };
__device__ __forceinline__ void xitem_load(const XItem& it, f32x4 (&wv)[8], int lane) {
    const int lr = lane >> 3, lc = (lane & 7) * 4;
#pragma unroll
    for (int i = 0; i < 8; ++i) wv[i] = __builtin_nontemporal_load((const f32x4*)(it.src + (size_t)(16 * (i >> 1) + 2 * lr + (i & 1)) * it.N + lc));
}
__device__ __forceinline__ void xitem_finish(const XItem& it, const f32x4 (&wv)[8], LAS float* scr, int lane) {
    LAS unsigned* T = (LAS unsigned*)scr; const int lr = lane >> 3, lc = (lane & 7) * 4;
#pragma unroll
    for (int m = 0; m < 4; ++m) { const f32x4 a = wv[2 * m], b = wv[2 * m + 1]; const int kw = 8 * m + lr;
        T[(lc + 0) * 36 + kw] = pg8::cvt_pk_bf16(a.x, b.x); T[(lc + 1) * 36 + kw] = pg8::cvt_pk_bf16(a.y, b.y); T[(lc + 2) * 36 + kw] = pg8::cvt_pk_bf16(a.z, b.z); T[(lc + 3) * 36 + kw] = pg8::cvt_pk_bf16(a.w, b.w); }
    LDS_WAIT(); asm volatile("" ::: "memory");
    const int kq = lane & 7;
#pragma unroll
    for (int j = 0; j < 4; ++j) { const int n = (lane >> 3) + 8 * j; const v4u o = *(const LAS v4u*)(T + n * 36 + kq * 4);
        __builtin_nontemporal_store(o, (GAS v4u*)(it.dst + (size_t)n * it.K + 8 * kq)); }
    LDS_WAIT(); asm volatile("" ::: "memory");
}
__device__ __forceinline__ int t5_bucket_dev(int rel) {
    const int n = rel < 0 ? -rel : rel; int b;
    if (n < 8) b = n; else b = 8 + (n >= 15) + (n >= 27) + (n >= 50) + (n >= 91) + (n >= 166) + (n >= 305) + (n >= 559);
    return (rel > 0 ? 16 : 0) + b;
}

#ifndef PH_MASK
#define PH_MASK 0xFFF
#endif
#define ON(k) (((PH_MASK) >> (k)) & 1)
#define QKVH(head, row) (QKV + ((size_t)(head) * M + (size_t)(row)) * HDIM)
constexpr int I_IN = (DM / 64) * (NQKV / 32), I_OUT = (DM / 64) * (DM / 32), I_1 = (DM / 64) * (DFF / 32), I_2 = (DFF / 64) * (DM / 32), I_LAYER = I_IN + I_OUT + I_1 + I_2;
#ifndef CONV_IN_QUEUE
#define CONV_IN_QUEUE 1
#endif
constexpr int NCONV = 128, CONV_ITEMS = I_LAYER / NCONV;
static_assert(I_LAYER % NCONV == 0 && CONV_ITEMS % 16 == 0 && (I_LAYER - I_IN) % NCONV == 0 && ((I_LAYER - I_IN) / NCONV) % 16 == 0, "conversion chunking: whole chunks, an even item count per wave");
__device__ __forceinline__ XItem conv_item(int l, int r, const float* w_in, const float* w_out, const float* w_mlp_in, const float* w_mlp_out, bf16* WIN, bf16* WOUT, bf16* W1, bf16* W2) {
    const float* W; bf16* WT; int K, N;
    if (r < I_IN) { W = w_in + (size_t)l * DM * NQKV; WT = WIN + (size_t)l * NQKV * DM; K = DM; N = NQKV; }
    else if (r < I_IN + I_OUT) { r -= I_IN; W = w_out + (size_t)l * DM * DM; WT = WOUT + (size_t)l * DM * DM; K = DM; N = DM; }
    else if (r < I_IN + I_OUT + I_1) { r -= I_IN + I_OUT; W = w_mlp_in + (size_t)l * DM * DFF; WT = W1 + (size_t)l * DFF * DM; K = DM; N = DFF; }
    else { r -= I_IN + I_OUT + I_1; W = w_mlp_out + (size_t)l * DFF * DM; WT = W2 + (size_t)l * DM * DFF; K = DFF; N = DM; }
    const int nblk = N / 32, k0 = 64 * (r / nblk), n0 = 32 * (r % nblk);
    XItem it; it.src = W + (size_t)k0 * N + n0; it.dst = WT + (size_t)n0 * K + k0; it.K = K; it.N = N; return it;
}
__device__ __forceinline__ XItem conv_qitem(int l, int q, const float* w_in, const float* w_out, const float* w_mlp_in, const float* w_mlp_out, bf16* WIN, bf16* WOUT, bf16* W1, bf16* W2) {
    return (q < I_LAYER - I_IN) ? conv_item(l, q + I_IN, w_in, w_out, w_mlp_in, w_mlp_out, WIN, WOUT, W1, W2) : conv_item(l + 1, q - (I_LAYER - I_IN), w_in, w_out, w_mlp_in, w_mlp_out, WIN, WOUT, W1, W2);
}
template <bool QMAP> __device__ __forceinline__ void conv_run_t(int l, int first, int step, int end, const float* w_in, const float* w_out, const float* w_mlp_in, const float* w_mlp_out, bf16* WIN, bf16* WOUT, bf16* W1, bf16* W2, LAS float* scr, int lane) {
#define CI_(r) (QMAP ? conv_qitem(l, (r), w_in, w_out, w_mlp_in, w_mlp_out, WIN, WOUT, W1, W2) : conv_item(l, (r), w_in, w_out, w_mlp_in, w_mlp_out, WIN, WOUT, W1, W2))
    if (first >= end) return;
    f32x4 wa[8], wb[8], wc[8], wd[8];
    if ((((end - first) + step - 1) / step) & 1) { const XItem s = CI_(first); xitem_load(s, wa, lane); xitem_finish(s, wa, scr, lane); first += step; if (first >= end) return; }
    XItem a = CI_(first), b = CI_(first + step);
    xitem_load(a, wa, lane); xitem_load(b, wb, lane);
    for (int r = first; r < end; r += 4 * step) {
        const bool more = r + 2 * step < end;
        XItem c = a, d = b; if (more) { c = CI_(r + 2 * step); d = CI_(r + 3 * step); xitem_load(c, wc, lane); xitem_load(d, wd, lane); }
        xitem_finish(a, wa, scr, lane); xitem_finish(b, wb, scr, lane);
        if (!more) break;
        const bool more2 = r + 4 * step < end;
        if (more2) { a = CI_(r + 4 * step); b = CI_(r + 5 * step); xitem_load(a, wa, lane); xitem_load(b, wb, lane); }
        xitem_finish(c, wc, scr, lane); xitem_finish(d, wd, scr, lane);
        if (!more2) break;
    }
#undef CI_
}
struct Args { const float* in[14]; float* out; unsigned char* ws; };

__device__ __forceinline__ f32x4 ld_row4(const void* base, size_t row, int idx, bool is_bf) {
    if (is_bf) { const unsigned long long w = ((const unsigned long long*)((const bf16*)base + row * DM))[idx]; const unsigned lo = (unsigned)w, hi = (unsigned)(w >> 32);
        return (f32x4){__uint_as_float(lo << 16), __uint_as_float(lo & 0xffff0000u), __uint_as_float(hi << 16), __uint_as_float(hi & 0xffff0000u)}; }
    return ((const f32x4*)((const float*)base + row * DM))[idx];
}
template <bool HAS_Y>
__device__ __forceinline__ void norm_phase(Frame& F, const void* xin, bool xin_bf, const bf16* y, void* xout, bool xout_bf, bf16* h, const float* Gv, const float* Av, const float* Bv, int bstride) {
    int tid_ = threadIdx.x; asm volatile("" : "+v"(tid_)); const int tid = tid_, lane = tid & 63, wave = __builtin_amdgcn_readfirstlane(tid >> 6);
    LAS f32x4* Gs = (LAS f32x4*)(F.lds); LAS f32x4* As = (LAS f32x4*)(F.lds + 16384); LAS f32x4* Bs = (LAS f32x4*)(F.lds + 32768);
    for (int chunk = blockIdx.x; chunk < M / 64; chunk += F.G) {
        const int b = chunk / (SEQ / 64);
        __syncthreads();
        for (int i = tid; i < 1024; i += NWAVES * 64) { if (HAS_Y) Gs[i] = ((const f32x4*)(Gv + (size_t)b * bstride))[i]; if (h) { As[i] = ((const f32x4*)(Av + (size_t)b * bstride))[i]; Bs[i] = ((const f32x4*)(Bv + (size_t)b * bstride))[i]; } }
        __syncthreads();
        for (int rr = wave; rr < 64; rr += NWAVES) {
            const size_t row = (size_t)chunk * 64 + rr;
            f32x4 xv[16];
            if (HAS_Y) {
                f32x4 yv[16]; float ss = 0.f;
#pragma unroll
                for (int j = 0; j < 16; ++j) yv[j] = ld_row4(y, row, lane + 64 * j, true);
#pragma unroll
                for (int j = 0; j < 16; ++j) xv[j] = ld_row4(xin, row, lane + 64 * j, xin_bf);
#pragma unroll
                for (int j = 0; j < 16; ++j) { asm volatile("" : "+v"(xv[j]));
                    ss += (yv[j].x * yv[j].x + yv[j].y * yv[j].y) + (yv[j].z * yv[j].z + yv[j].w * yv[j].w); }
                const float ry = 1.0f / sqrtf(wave_sum(ss) * (1.0f / DM) + EPS);
#pragma unroll
                for (int j = 0; j < 16; ++j) { const f32x4 g = Gs[lane + 64 * j]; xv[j] = xv[j] + g * (yv[j] * ry); }
                if (xout_bf) { unsigned long long* xo = (unsigned long long*)((bf16*)xout + row * DM) + lane;
#pragma unroll
                    for (int j = 0; j < 16; ++j) xo[64 * j] = (unsigned long long)pg8::cvt_pk_bf16(xv[j].x, xv[j].y) | ((unsigned long long)pg8::cvt_pk_bf16(xv[j].z, xv[j].w) << 32);
                } else { f32x4* xo = (f32x4*)((float*)xout + row * DM) + lane;
#pragma unroll
                    for (int j = 0; j < 16; ++j) xo[64 * j] = xv[j]; }
            } else {
#pragma unroll
                for (int j = 0; j < 16; ++j) xv[j] = ld_row4(xin, row, lane + 64 * j, xin_bf);
            }
            if (h) {
                float ss = 0.f;
#pragma unroll
                for (int j = 0; j < 16; ++j) ss += (xv[j].x * xv[j].x + xv[j].y * xv[j].y) + (xv[j].z * xv[j].z + xv[j].w * xv[j].w);
                const float rx = 1.0f / sqrtf(wave_sum(ss) * (1.0f / DM) + EPS);
                unsigned long long* ho = (unsigned long long*)(h + row * DM) + lane;
#pragma unroll
                for (int j = 0; j < 16; ++j) { const f32x4 a = As[lane + 64 * j], bb = Bs[lane + 64 * j]; const f32x4 v = a * (xv[j] * rx) + bb;
                    ho[64 * j] = (unsigned long long)pg8::cvt_pk_bf16(v.x, v.y) | ((unsigned long long)pg8::cvt_pk_bf16(v.z, v.w) << 32); }
            }
        }
    }
}

__device__ __forceinline__ void norm_phase_bf(Frame& F, const bf16* xin, const bf16* y, void* xout, bool xout_bf, bf16* h, const float* Gv, const float* Av, const float* Bv, int bstride) {
    int tid_ = threadIdx.x; asm volatile("" : "+v"(tid_)); const int tid = tid_, lane = tid & 63, wave = __builtin_amdgcn_readfirstlane(tid >> 6);
    LAS f32x4* Gs = (LAS f32x4*)(F.lds); LAS f32x4* As = (LAS f32x4*)(F.lds + 16384); LAS f32x4* Bs = (LAS f32x4*)(F.lds + 32768);
    typedef unsigned long long u64;
#define NB_CVT(W) ((f32x4){__uint_as_float((unsigned)(W) << 16), __uint_as_float((unsigned)(W) & 0xffff0000u), __uint_as_float((unsigned)((W) >> 32) << 16), __uint_as_float((unsigned)((W) >> 32) & 0xffff0000u)})
#define NB_LOAD(YR, XR, ROW) do { _Pragma("unroll") for (int j = 0; j < 16; ++j) { YR[j] = ((const u64*)(y + (ROW) * DM))[lane + 64 * j]; XR[j] = ((const u64*)(xin + (ROW) * DM))[lane + 64 * j]; } } while (0)
#define NB_PIN(YR, XR) do { _Pragma("unroll") for (int j = 0; j < 16; ++j) { asm volatile("" : "+v"(YR[j])); asm volatile("" : "+v"(XR[j])); } } while (0)
#define NB_ROW(YR, XR, ROW) do { int lq = lane; asm volatile("" : "+v"(lq)); float ss = 0.f; f32x4 xv[16]; \
        _Pragma("unroll") for (int j = 0; j < 16; ++j) { const f32x4 yv = NB_CVT(YR[j]); ss += (yv.x * yv.x + yv.y * yv.y) + (yv.z * yv.z + yv.w * yv.w); } \
        const float ry = 1.0f / sqrtf(wave_sum(ss) * (1.0f / DM) + EPS); \
        _Pragma("unroll") for (int j = 0; j < 16; ++j) { const f32x4 g = Gs[lq + 64 * j]; xv[j] = NB_CVT(XR[j]) + g * (NB_CVT(YR[j]) * ry); } \
        if (xout_bf) { u64* xo = (u64*)((bf16*)xout + (ROW) * DM) + lane; \
            _Pragma("unroll") for (int j = 0; j < 16; ++j) xo[64 * j] = (u64)pg8::cvt_pk_bf16(xv[j].x, xv[j].y) | ((u64)pg8::cvt_pk_bf16(xv[j].z, xv[j].w) << 32); \
        } else { f32x4* xo = (f32x4*)((float*)xout + (ROW) * DM) + lane; \
            _Pragma("unroll") for (int j = 0; j < 16; ++j) xo[64 * j] = xv[j]; } \
        if (h) { float s2 = 0.f; \
            _Pragma("unroll") for (int j = 0; j < 16; ++j) s2 += (xv[j].x * xv[j].x + xv[j].y * xv[j].y) + (xv[j].z * xv[j].z + xv[j].w * xv[j].w); \
            const float rx = 1.0f / sqrtf(wave_sum(s2) * (1.0f / DM) + EPS); \
            u64* ho = (u64*)(h + (ROW) * DM) + lane; \
            _Pragma("unroll") for (int j = 0; j < 16; ++j) { const f32x4 a = As[lq + 64 * j], bb = Bs[lq + 64 * j]; const f32x4 v = a * (xv[j] * rx) + bb; \
                ho[64 * j] = (u64)pg8::cvt_pk_bf16(v.x, v.y) | ((u64)pg8::cvt_pk_bf16(v.z, v.w) << 32); } } } while (0)
    for (int chunk = blockIdx.x; chunk < M / 64; chunk += F.G) {
        const int b = chunk / (SEQ / 64);
        const size_t row0 = (size_t)chunk * 64 + wave;
        u64 yA[16], xA[16], yB[16], xB[16];
        NB_LOAD(yA, xA, row0);
        __syncthreads();
        for (int i = tid; i < 1024; i += NWAVES * 64) { Gs[i] = ((const f32x4*)(Gv + (size_t)b * bstride))[i]; if (h) { As[i] = ((const f32x4*)(Av + (size_t)b * bstride))[i]; Bs[i] = ((const f32x4*)(Bv + (size_t)b * bstride))[i]; } }
        __syncthreads();
#pragma unroll 1
        for (int it = 0; it < 4; ++it) {
            const size_t ra = row0 + 16 * it, rb = ra + 8;
            NB_LOAD(yB, xB, rb); NB_PIN(yA, xA);
            NB_ROW(yA, xA, ra);
            if (it < 3) { NB_LOAD(yA, xA, rb + 8); }
            NB_PIN(yB, xB);
            NB_ROW(yB, xB, rb);
        }
    }
#undef NB_CVT
#undef NB_LOAD
#undef NB_PIN
#undef NB_ROW
}

typedef __attribute__((address_space(4))) const unsigned char ckb_t;
__device__ __forceinline__ const void* karg(int i) { ckb_t* kp = (ckb_t*)__builtin_amdgcn_kernarg_segment_ptr(); asm volatile("" : "+s"(kp)); return *(const void* const __attribute__((address_space(4)))*)(kp + 8 * i); }
#define KIN(i) ((const float*)karg(i))
#define KOUT() ((float*)karg(14))
#define KWS() ((unsigned char*)karg(15))
__global__ void __launch_bounds__(NWAVES * 64, 2) mega_fwd(Args args_unused) {
    extern __shared__ __attribute__((aligned(16))) unsigned char lds[];
    Frame F;
    F.lds = (LAS unsigned char*)lds; F.MISC = (volatile LAS unsigned*)(F.lds + MISC_OFF); F.G = gridDim.x;
    for (int u = threadIdx.x; u < (LDS_BYTES - LDSCTL_OFF) / 4; u += NWAVES * 64) ((LAS unsigned*)(F.lds + LDSCTL_OFF))[u] = 0u;
    __syncthreads();
    (void)xcd_barrier_post((unsigned*)((gu32*)(KWS() + WS_CTL) + CW_BAR), F.MISC + 8);
#define GRID_BAR() do { XcdBarrier bar_; bar_.bar = (unsigned*)((gu32*)(KWS() + WS_CTL) + CW_BAR); bar_.x = xb_xcc_id(); bar_.st = (volatile LAS unsigned*)(F.lds + MISC_OFF) + 8; xcd_barrier(bar_); } while (0)
#define FRESH_IDS() int tid_ = threadIdx.x; asm volatile("" : "+v"(tid_)); const int ftid = tid_, flane = ftid & 63, fwave = __builtin_amdgcn_readfirstlane(ftid >> 6); \
    const int gw = blockIdx.x * NWAVES + fwave, NGW = F.G * NWAVES, gtid = blockIdx.x * (NWAVES * 64) + ftid, NGT = F.G * NWAVES * 64; (void)flane; (void)gw; (void)NGW; (void)gtid; (void)NGT
#define WSP(T, off) ((T*)(ws + (off)))
#ifndef DUP_GEMM
#define DUP_GEMM 0
#endif
#ifndef XBF16
#define XBF16 1
#endif
#ifndef DUP_NORM
#define DUP_NORM 0
#endif
#ifndef DUP_P0C
#define DUP_P0C 0
#endif
#ifndef XBAR
#define XBAR 0
#endif
#ifndef DUP_G0
#define DUP_G0 0
#endif
#ifndef DUP_G1
#define DUP_G1 0
#endif
#ifndef DUP_G2
#define DUP_G2 0
#endif
#ifndef DUP_G3
#define DUP_G3 0
#endif
#ifndef DUP_NA
#define DUP_NA 0
#endif
#ifndef DUP_DIL
#define DUP_DIL 0
#endif
#ifndef DUP_GQA
#define DUP_GQA 0
#endif
#ifndef DUP_ATT
#define DUP_ATT 0
#endif
#ifndef DUP_P0A
#define DUP_P0A 0
#endif
#ifndef DUPBAR
#define DUPBAR 0
#endif
#define REPBAR() do { if (DUPBAR && rep_ > 0) GRID_BAR(); } while (0)
#define REPEAT(n) for (int rep_ = 0, nrep_ = __builtin_amdgcn_readfirstlane(1 + (n)); rep_ < nrep_; ++rep_)

    if (ON(0)) REPEAT(DUP_P0A)
    {
        FRESH_IDS(); unsigned char* ws = KWS(); const float* in_c = KIN(1); const float* ada_w = KIN(2); float* MODP = WSP(float, WS_MODP);
        for (int task = gw; task < 96 * 16; task += NGW) {
            const int cg = task % 96, kc = task / 96; const int col = cg * 256 + flane * 4;
            f32x4 a0 = {0.f, 0.f, 0.f, 0.f}, a1 = {0.f, 0.f, 0.f, 0.f};
            const float* wp = ada_w + (size_t)(kc * 256) * (NMOD * DM) + col;
#pragma unroll 8
            for (int k = 0; k < 256; ++k) {
                const f32x4 w = *(const f32x4*)(wp + (size_t)k * (NMOD * DM));
                const float c0 = in_c[kc * 256 + k], c1 = in_c[DM + kc * 256 + k];
                const float s0 = c0 / (1.0f + __expf(-c0)), s1 = c1 / (1.0f + __expf(-c1));
                a0 = a0 + w * s0; a1 = a1 + w * s1;
            }
            *(f32x4*)(MODP + ((size_t)(kc * 2 + 0) * (NMOD * DM)) + col) = a0;
            *(f32x4*)(MODP + ((size_t)(kc * 2 + 1) * (NMOD * DM)) + col) = a1;
        }
        LAS float* scr = (LAS float*)(F.lds + RING_OFF + fwave * 16384);
        const float* w_in = KIN(6); const float* w_out = KIN(7); const float* w_mlp_in = KIN(12); const float* w_mlp_out = KIN(13);
        bf16* WIN = WSP(bf16, WS_WIN); bf16* WOUT = WSP(bf16, WS_WOUT); bf16* W1 = WSP(bf16, WS_W1); bf16* W2 = WSP(bf16, WS_W2);
        if (CONV_IN_QUEUE) conv_run_t<false>(0, gw, NGW, I_IN, w_in, w_out, w_mlp_in, w_mlp_out, WIN, WOUT, W1, W2, scr, flane);
        else for (int cl_ = 0; cl_ < DEPTH; ++cl_) conv_run_t<false>(cl_, gw, NGW, I_LAYER, w_in, w_out, w_mlp_in, w_mlp_out, WIN, WOUT, W1, W2, scr, flane);
    }
    GRID_BAR();
    if (ON(1))
    {
        FRESH_IDS(); unsigned char* ws = KWS(); const float* ada_b = KIN(3); const float* ada_emb = KIN(4); const float* gains = KIN(5); const float* t5_table = KIN(11);
        float* MODP = WSP(float, WS_MODP); float* MODV = WSP(float, WS_MODV); float* ROPE = WSP(float, WS_ROPE); float* DILTB = WSP(float, WS_DILTB);
        for (int i = gtid; i < DEPTH * 2 * NMOD * DM; i += NGT) {
            const int col = i % DM, j = (i / DM) % NMOD, b = (i / (DM * NMOD)) % 2, l = i / (DM * NMOD * 2);
            float m = ada_b[j * DM + col];
#pragma unroll
            for (int kc = 0; kc < 16; ++kc) m += MODP[(size_t)(kc * 2 + b) * (NMOD * DM) + j * DM + col];
            m += ada_emb[((size_t)l * NMOD + j) * DM + col];
            const float* gl = gains + (size_t)l * 4 * DM;
            float v;
            if (j == 0) v = m; else if (j == 1) v = gl[0 * DM + col] * (1.0f + m); else if (j == 2) v = m * gl[1 * DM + col];
            else if (j == 3) v = m; else if (j == 4) v = gl[2 * DM + col] * (1.0f + m); else v = m * gl[3 * DM + col];
            MODV[i] = v;
        }
        if (blockIdx.x == 0 && ftid < 32) {
            const int f = ftid; const double th = (double)__builtin_amdgcn_exp2f(-(float)f * 0.41524101186092029f);
            double c1 = 1.0, s1 = th, tc = 1.0, ts = th; const double x2 = th * th;
            for (int n = 1; n <= 12; ++n) { tc *= -x2 / (double)((2 * n - 1) * (2 * n)); ts *= -x2 / (double)((2 * n) * (2 * n + 1)); c1 += tc; s1 += ts; }
            double c = 1.0, s = 0.0;
            for (int pos = 0; pos < 128; ++pos) { ROPE[pos * 32 + f] = (float)c; ROPE[4096 + pos * 32 + f] = (float)s; const double cn = c * c1 - s * s1; s = s * c1 + c * s1; c = cn; }
        }
        if (blockIdx.x == 1 || F.G == 1) {
            for (int i = ftid; i < 3 * H_DIL * 129; i += NWAVES * 64) { const int p = i / (H_DIL * 129), hh = (i / 129) % H_DIL, jj = i % 129 - 64; const int d = p == 0 ? 1 : (p == 1 ? 4 : 16);
                DILTB[i] = t5_table[t5_bucket_dev(jj * d) * H_DIL + hh]; }
        }
    }
    GRID_BAR();
    if (ON(2))
    REPEAT(DUP_P0C) { unsigned char* ws = KWS(); float* MODV = WSP(float, WS_MODV);
      norm_phase<false>(F, KIN(0), false, nullptr, nullptr, false, WSP(bf16, WS_H), nullptr, MODV + 1 * DM, MODV + 0 * DM, NMOD * DM); }
    GRID_BAR();

    for (int l = 0; l < DEPTH; ++l) {
        for (int xb_ = 0; xb_ < XBAR; ++xb_) GRID_BAR();
    if (ON(3)) REPEAT(DUP_GEMM + DUP_G0)
        {
            REPBAR();
            unsigned char* ws = KWS();
            pg8::Gemm g{WSP(bf16, WS_H), WSP(bf16, WS_WIN) + (size_t)l * NQKV * DM, M, NQKV, DM}; pg8::StaticOrder S; S.init(M, NQKV, F.G, (int)blockIdx.x);
            pg8::EpiQKV E{WSP(bf16, WS_QKV), M};
            pg8::gemm_phase<pg8::EpiQKV, pg8::StaticOrder, true, true>(F.lds + RING_OFF, g, S, E);
        }
        GRID_BAR();
    if (ON(4))
        {
            FRESH_IDS(); const int i16 = ftid & 15; const int g16 = gtid >> 4, NG16 = NGT >> 4;
            unsigned char* ws = KWS(); bf16* QKV = WSP(bf16, WS_QKV); const float* ROPE = WSP(float, WS_ROPE); const float* q_gain = KIN(8); const float* k_gain = KIN(9);
            for (int task = g16; task < KV_GQA * (M / 8); task += NG16) {
                const int hh = task >> 11, row0 = (task & (M / 8 - 1)) * 8;
                const int head = K_GQA / HDIM + hh;
                const float* gp = k_gain + l * HDIM + 8 * i16;
                bf16* p = QKVH(head, row0) + 8 * i16;
                const int jj = i16 & 7, fb = 8 * (jj & 3);
                v4u raw[8]; f32x4 c0[8], c1[8], s0[8], s1[8];
#pragma unroll
                for (int k = 0; k < 8; ++k) raw[k] = *(const v4u*)(p + (size_t)k * HDIM);
                const f32x4 g0 = *(const f32x4*)gp, g1 = *(const f32x4*)(gp + 4);
#pragma unroll
                for (int k = 0; k < 8; ++k) { const int t = (row0 + k) & (SEQ - 1); const int pos = (i16 < 8) ? (t >> 6) : (t & 63); const float* rp = ROPE + pos * 32 + fb;
                    c0[k] = *(const f32x4*)rp; c1[k] = *(const f32x4*)(rp + 4); s0[k] = *(const f32x4*)(rp + 4096); s1[k] = *(const f32x4*)(rp + 4100); }
#pragma unroll
                for (int k = 0; k < 8; ++k) {
                    float x[8];
                    x[0] = __uint_as_float(raw[k].x << 16); x[1] = __uint_as_float(raw[k].x & 0xffff0000u); x[2] = __uint_as_float(raw[k].y << 16); x[3] = __uint_as_float(raw[k].y & 0xffff0000u);
                    x[4] = __uint_as_float(raw[k].z << 16); x[5] = __uint_as_float(raw[k].z & 0xffff0000u); x[6] = __uint_as_float(raw[k].w << 16); x[7] = __uint_as_float(raw[k].w & 0xffff0000u);
                    float ss = 0.f;
#pragma unroll
                    for (int e = 0; e < 8; ++e) ss += x[e] * x[e];
                    ss += __shfl_xor(ss, 1); ss += __shfl_xor(ss, 2); ss += __shfl_xor(ss, 4); ss += __shfl_xor(ss, 8);
                    const float rstd = 1.0f / sqrtf(ss * (1.0f / HDIM) + EPS);
                    x[0] *= rstd * g0.x; x[1] *= rstd * g0.y; x[2] *= rstd * g0.z; x[3] *= rstd * g0.w; x[4] *= rstd * g1.x; x[5] *= rstd * g1.y; x[6] *= rstd * g1.z; x[7] *= rstd * g1.w;
                    const float cs[8] = {c0[k].x, c0[k].y, c0[k].z, c0[k].w, c1[k].x, c1[k].y, c1[k].z, c1[k].w}; const float sn[8] = {s0[k].x, s0[k].y, s0[k].z, s0[k].w, s1[k].x, s1[k].y, s1[k].z, s1[k].w};
                    float o[8];
#pragma unroll
                    for (int e = 0; e < 8; ++e) { const float pv = __shfl_xor(x[e], 4); o[e] = (jj < 4) ? (x[e] * cs[e] - pv * sn[e]) : (pv * sn[e] + x[e] * cs[e]); }
                    v4u w; w.x = pg8::cvt_pk_bf16(o[0], o[1]); w.y = pg8::cvt_pk_bf16(o[2], o[3]); w.z = pg8::cvt_pk_bf16(o[4], o[5]); w.w = pg8::cvt_pk_bf16(o[6], o[7]);
                    *(v4u*)(p + (size_t)k * HDIM) = w;
                }
            }
        }
    if (ON(5))
        {
            char* alds = (char*)lds + RING_OFF;
            (void)alds;
        }
        GRID_BAR();
    if (ON(5)) REPEAT(DUP_ATT)
        {
            char* alds = (char*)lds + RING_OFF;
            { unsigned char* ws = KWS(); bf16* QKV = WSP(bf16, WS_QKV); bf16* O = WSP(bf16, WS_O); const float* na_rpb = KIN(10);
              bf16* DILP = WSP(bf16, WS_DILP); float* DILST = WSP(float, WS_DILST); const float* DILTB = WSP(float, WS_DILTB);
              gu32* qhead = (gu32*)(ws + WS_CTL) + CW_QUEUE + 64 * l; volatile LAS unsigned* qslot = (volatile LAS unsigned*)(F.lds + MISC_OFF) + 16;
              const int nconv = CONV_IN_QUEUE ? NCONV : 0;
              unsigned nx_ = 0u; if (threadIdx.x == 0) nx_ = __hip_atomic_fetch_add(qhead, 1u, RLX_AGENT);
              for (int guard_ = 0; guard_ < 4096; ++guard_) {
                __syncthreads();
                if (threadIdx.x == 0) qslot[0] = nx_;
                __syncthreads();
                const int uq = (int)__builtin_amdgcn_readfirstlane(qslot[0]);
                if (uq >= 768 + nconv + 2816) break;
                if (threadIdx.x == 0) nx_ = __hip_atomic_fetch_add(qhead, 1u, RLX_AGENT);
                int u;
                if (uq < 768 + nconv) {
                    if (nconv && uq % 7 == 6) {
                        int tid_ = threadIdx.x; asm volatile("" : "+v"(tid_)); const int cl = tid_ & 63, cw = __builtin_amdgcn_readfirstlane(tid_ >> 6);
                        LAS float* scr = (LAS float*)(F.lds + RING_OFF + cw * 16384); const int citems = (l + 1 < DEPTH) ? CONV_ITEMS : (I_LAYER - I_IN) / NCONV, c0 = (uq / 7) * citems;
                        const float* w_in = KIN(6); const float* w_out = KIN(7); const float* w_mlp_in = KIN(12); const float* w_mlp_out = KIN(13);
                        conv_run_t<true>(l, c0 + cw, NWAVES, c0 + citems, w_in, w_out, w_mlp_in, w_mlp_out, WSP(bf16, WS_WIN), WSP(bf16, WS_WOUT), WSP(bf16, WS_W1), WSP(bf16, WS_W2), scr, cl);
                        continue;
                    }
                    u = nconv ? uq - uq / 7 : uq;
                } else u = uq - nconv;
                if (u < 768) {
                    const int grp = u / 96, within = u % 96; const int b = grp >> 2, kvh = grp & 3, hq = kvh * 3 + within / 32, qb = within % 32;
                    const size_t r0 = (size_t)b * SEQ + (size_t)qb * 256;
                    att::attn_unit<0>(QKVH(Q_GQA / HDIM + hq, r0), HDIM, QKVH(K_GQA / HDIM + kvh, (size_t)b * SEQ), QKVH(V_GQA / HDIM + kvh, (size_t)b * SEQ), HDIM,
                                      0, SEQ / 64, SEQ / 64, O + r0 * DM + O_GQA + hq * HDIM, DM, nullptr, 0, 0, nullptr, 0, alds, KIN(8) + l * HDIM, WSP(float, WS_ROPE), qb * 256);
                    continue;
                }
                if (u < 768 + 512) {
                    const int un = u - 768; const int b = un >> 8, hh = (un >> 5) & 7, qb = un & 31; const size_t r0 = (size_t)b * SEQ + (size_t)qb * 256;
                    att::attn_unit<1>(QKVH(Q_NA / HDIM + hh, r0), HDIM, QKVH(K_NA / HDIM + hh, (size_t)b * SEQ), QKVH(V_NA / HDIM + hh, (size_t)b * SEQ), HDIM,
                                      qb * 4 - 4, 12, SEQ / 64, O + r0 * DM + O_NA + hh * HDIM, DM, nullptr, 0, qb * 4, na_rpb + ((size_t)l * H_NA + hh) * 465, 465, alds);
                } else {
                    const int v = u - 768 - 512, p = v / 768, w = v % 768, pair = w >> 5, b = pair / H_DIL, hh = pair % H_DIL, blk = w & 31;
                    const int d = p == 0 ? 1 : (p == 1 ? 4 : 16), nub = 32 / d, res = blk / nub, ub = blk % nub, u0 = ub * 256, L = SEQ / d;
                    const size_t rq = (size_t)b * SEQ + (size_t)u0 * d + res, rk = (size_t)b * SEQ + res;
                    att::attn_unit<2>(QKVH(Q_DIL / HDIM + hh, rq), (long)d * HDIM, QKVH(K_DIL / HDIM + hh, rk), QKVH(V_DIL / HDIM + hh, rk), (long)d * HDIM,
                                      u0 / 64 - 1, 6, L / 64, DILP + (size_t)p * M * DILW + rq * DILW + hh * HDIM, (long)d * DILW,
                                      DILST + (((size_t)p * M + rq) * H_DIL + hh) * 2, (long)d * H_DIL * 2, u0, DILTB + (p * H_DIL + hh) * 129, 129, alds);
                }
              } }
        }
        GRID_BAR();
    if (ON(6))
        {
            FRESH_IDS(); const int i16 = ftid & 15; const int g16 = gtid >> 4, NG16 = NGT >> 4;
            unsigned char* ws = KWS(); bf16* O = WSP(bf16, WS_O); const bf16* DILP = WSP(bf16, WS_DILP); const float* DILST = WSP(float, WS_DILST);
            typedef float f32x2v __attribute__((ext_vector_type(2)));
            for (int task0 = g16; task0 < M * H_DIL; task0 += 8 * NG16) {
                f32x2v st[8][3]; v4u raw[8][3];
#pragma unroll
                for (int k = 0; k < 8; ++k) { const int task = task0 + k * NG16; const bool on = task < M * H_DIL; const int tt = on ? task : task0; const int row = tt / H_DIL, hh = tt % H_DIL;
#pragma unroll
                    for (int p = 0; p < 3; ++p) { st[k][p] = *(const f32x2v*)(DILST + (((size_t)p * M + row) * H_DIL + hh) * 2); raw[k][p] = *(const v4u*)(DILP + (size_t)p * M * DILW + (size_t)row * DILW + hh * HDIM + 8 * i16); } }
#pragma unroll
                for (int k = 0; k < 8; ++k) { const int task = task0 + k * NG16; if (task < M * H_DIL) { const int row = task / H_DIL, hh = task % H_DIL;
                    const float mx = fmaxf(st[k][0].x, fmaxf(st[k][1].x, st[k][2].x));
                    float wv[3]; float wsum = 0.f;
#pragma unroll
                    for (int p = 0; p < 3; ++p) { wv[p] = st[k][p].y * __builtin_amdgcn_exp2f(st[k][p].x - mx); wsum += wv[p]; }
                    const float inv = 1.0f / wsum;
                    float acc[8] = {0.f, 0.f, 0.f, 0.f, 0.f, 0.f, 0.f, 0.f};
#pragma unroll
                    for (int p = 0; p < 3; ++p) { const v4u r = raw[k][p]; const float wp = wv[p] * inv;
                        acc[0] += wp * __uint_as_float(r.x << 16); acc[1] += wp * __uint_as_float(r.x & 0xffff0000u); acc[2] += wp * __uint_as_float(r.y << 16); acc[3] += wp * __uint_as_float(r.y & 0xffff0000u);
                        acc[4] += wp * __uint_as_float(r.z << 16); acc[5] += wp * __uint_as_float(r.z & 0xffff0000u); acc[6] += wp * __uint_as_float(r.w << 16); acc[7] += wp * __uint_as_float(r.w & 0xffff0000u); }
                    v4u w; w.x = pg8::cvt_pk_bf16(acc[0], acc[1]); w.y = pg8::cvt_pk_bf16(acc[2], acc[3]); w.z = pg8::cvt_pk_bf16(acc[4], acc[5]); w.w = pg8::cvt_pk_bf16(acc[6], acc[7]);
                    *(v4u*)(O + (size_t)row * DM + O_DIL + hh * HDIM + 8 * i16) = w; } }
            }
        }
        GRID_BAR();
    if (ON(7)) REPEAT(DUP_GEMM + DUP_G1)
        {
            REPBAR();
            unsigned char* ws = KWS();
            pg8::Gemm g{WSP(bf16, WS_O), WSP(bf16, WS_WOUT) + (size_t)l * DM * DM, M, DM, DM}; pg8::StaticOrder S; S.init(M, DM, F.G, (int)blockIdx.x);
            pg8::EpiBf16<0> E{WSP(bf16, WS_Y), DM};
            pg8::gemm_phase<pg8::EpiBf16<0>, pg8::StaticOrder, true, true>(F.lds + RING_OFF, g, S, E);
        }
        GRID_BAR();
    if (ON(8))
        { unsigned char* ws = KWS(); const float* mv = WSP(float, WS_MODV) + (size_t)l * 2 * NMOD * DM;
#if DUP_NORM
          norm_phase<true>(F, l == 0 ? (const void*)KIN(0) : (const void*)KOUT(), false, WSP(bf16, WS_Y), WSP(float, WS_U), false, WSP(bf16, WS_U + 256 * MiB), mv + 2 * DM, mv + 4 * DM, mv + 3 * DM, NMOD * DM);
#endif
#if XBF16
          if (l == 0) norm_phase<true>(F, (const void*)KIN(0), false, WSP(bf16, WS_Y), WSP(bf16, WS_XB), true, WSP(bf16, WS_H), mv + 2 * DM, mv + 4 * DM, mv + 3 * DM, NMOD * DM);
          else norm_phase_bf(F, WSP(bf16, WS_XB), WSP(bf16, WS_Y), WSP(bf16, WS_XB), true, WSP(bf16, WS_H), mv + 2 * DM, mv + 4 * DM, mv + 3 * DM, NMOD * DM); }
#else
          norm_phase<true>(F, l == 0 ? (const void*)KIN(0) : (const void*)KOUT(), false, WSP(bf16, WS_Y), KOUT(), false, WSP(bf16, WS_H), mv + 2 * DM, mv + 4 * DM, mv + 3 * DM, NMOD * DM); }
#endif
        GRID_BAR();
    if (ON(9)) REPEAT(DUP_GEMM + DUP_G2)
        {
            REPBAR();
            unsigned char* ws = KWS();
            pg8::Gemm g{WSP(bf16, WS_H), WSP(bf16, WS_W1) + (size_t)l * DFF * DM, M, DFF, DM}; pg8::StaticOrder S; S.init(M, DFF, F.G, (int)blockIdx.x);
            pg8::EpiBf16<3> E{WSP(bf16, WS_U), DFF};
            pg8::gemm_phase<pg8::EpiBf16<3>, pg8::StaticOrder, true, true>(F.lds + RING_OFF, g, S, E);
        }
        GRID_BAR();
    if (ON(10)) REPEAT(DUP_GEMM + DUP_G3)
        {
            REPBAR();
            unsigned char* ws = KWS();
            pg8::Gemm g{WSP(bf16, WS_U), WSP(bf16, WS_W2) + (size_t)l * DM * DFF, M, DM, DFF}; pg8::StaticOrder S; S.init(M, DM, F.G, (int)blockIdx.x);
            pg8::EpiBf16<0> E{WSP(bf16, WS_Y), DM};
            pg8::gemm_phase<pg8::EpiBf16<0>, pg8::StaticOrder, true, true>(F.lds + RING_OFF, g, S, E);
        }
        GRID_BAR();
    if (ON(11))
        {
            unsigned char* ws = KWS(); const float* mv = WSP(float, WS_MODV) + (size_t)l * 2 * NMOD * DM; float* out = KOUT();
            const float* mvn = WSP(float, WS_MODV) + (size_t)(l + 1 < DEPTH ? l + 1 : l) * 2 * NMOD * DM;
#if XBF16
            norm_phase_bf(F, WSP(bf16, WS_XB), WSP(bf16, WS_Y), (l + 1 < DEPTH) ? (void*)WSP(bf16, WS_XB) : (void*)out, l + 1 < DEPTH, (l + 1 < DEPTH) ? WSP(bf16, WS_H) : (bf16*)nullptr, mv + 5 * DM, mvn + 1 * DM, mvn + 0 * DM, NMOD * DM);
#else
            norm_phase<true>(F, out, false, WSP(bf16, WS_Y), out, false, (l + 1 < DEPTH) ? WSP(bf16, WS_H) : (bf16*)nullptr, mv + 5 * DM, mvn + 1 * DM, mvn + 0 * DM, NMOD * DM);
#endif
        }
        if (l + 1 < DEPTH) GRID_BAR();
    }
    __syncthreads();
    if (__hip_atomic_load((gu32*)(KWS() + WS_CTL) + CW_BAR + XB_TMO, RLX_AGENT) != 0u) {
        const float q = __builtin_nanf(""); float* out = KOUT();
        for (int chunk = blockIdx.x; chunk < M / 64; chunk += F.G) for (int i = threadIdx.x; i < 64 * DM / 4; i += NWAVES * 64) ((f32x4*)(out + (size_t)chunk * 64 * DM))[i] = (f32x4){q, q, q, q};
    }
}

extern "C" void kernel_launch(void* const* d_in, const int* in_sizes, int n_in, void* d_out, int out_size, void* d_ws, size_t ws_size, hipStream_t stream) {
    static int grid = 0;
    if (grid == 0) {
        if (n_in != 14 || in_sizes[0] != M * DM || out_size != M * DM || ws_size < WS_END) { fprintf(stderr, "kernel_launch: shape/workspace mismatch (n_in %d, in0 %d, out %d, ws %zu, need %zu)\n", n_in, n_in > 0 ? in_sizes[0] : -1, out_size, ws_size, (size_t)WS_END); grid = -1; return; }
        int dev = 0, cus = 0, per_cu = 0;
        if (hipGetDevice(&dev) != hipSuccess || hipDeviceGetAttribute(&cus, hipDeviceAttributeMultiprocessorCount, dev) != hipSuccess) { grid = -1; return; }
        if (hipFuncSetAttribute((const void*)mega_fwd, hipFuncAttributeMaxDynamicSharedMemorySize, LDS_BYTES) != hipSuccess) { fprintf(stderr, "kernel_launch: hipFuncSetAttribute failed\n"); grid = -1; return; }
        if (hipOccupancyMaxActiveBlocksPerMultiprocessor(&per_cu, (const void*)mega_fwd, NWAVES * 64, LDS_BYTES) != hipSuccess || per_cu < 1) { fprintf(stderr, "kernel_launch: occupancy query reports %d blocks per CU\n", per_cu); }
        (void)hipGetLastError();
        grid = cus;
    }
    if (grid < 0) return;
    if (hipMemsetAsync((char*)d_ws + WS_CTL, 0, CTL_ZERO_BYTES, stream) != hipSuccess) return;
    Args a{};
    for (int i = 0; i < 14; ++i) a.in[i] = (const float*)d_in[i];
    a.out = (float*)d_out; a.ws = (unsigned char*)d_ws;
    hipLaunchKernelGGL(mega_fwd, dim3(grid), dim3(NWAVES * 64), LDS_BYTES, stream, a);
    const hipError_t le = hipPeekAtLastError();
    if (le != hipSuccess) fprintf(stderr, "kernel_launch: launch failed: %s\n", hipGetErrorName(le));
}
```

```cpp
#include <hip/hip_runtime.h>
#include <cstdio>
#include <cstdint>
namespace pg8 {
#define PG8_LAS __attribute__((address_space(3)))
typedef unsigned short bf16_t;
typedef short bf16x8 __attribute__((ext_vector_type(8)));
typedef float f32x4 __attribute__((ext_vector_type(4)));
typedef unsigned u32x4 __attribute__((ext_vector_type(4)));
constexpr int BM = 256, BK = 64, HALF = 128, HTB = HALF * BK * 2  , STAGE_BYTES = 8 * HTB, NXCD = 8, WGM = 8;

__host__ __device__ __forceinline__ int lds_byte(int r, int c) { const int st = (r >> 4) * 2 + (c >> 5), rr = r & 15, cc = c & 31, ob = rr * 64 + cc * 2; return st * 1024 + (ob ^ (((ob >> 9) & 1) << 5)); }
__host__ __device__ __forceinline__ void stage_rc(int b, int& R, int& C) { const int st = b / 1024, sb = b % 1024, swz = sb ^ (((sb >> 9) & 1) << 5); R = (st >> 1) * 16 + swz / 64; C = (st & 1) * 32 + (swz % 64) / 2; }
__host__ __device__ __forceinline__ int perm32(int rho) { const int n = rho >> 4, i = rho & 15; return 8 * (i >> 2) + 4 * n + (i & 3); }

struct Unit { int pm, pn; };
struct Gemm { const bf16_t* A; const bf16_t* Bt; int M, N, K; };

struct StaticOrder {
    int nM, nN, nwg, G, c;
    __host__ __device__ void init(int M, int N, int G_, int c_) { nM = M / BM; nN = N / BM; nwg = nM * nN; G = G_; c = c_; }
    __host__ __device__ bool next(int i, Unit& u) const {
        const long L = (long)i * G + c; if (L >= nwg) return false;
        int wgid = (int)L; { const int q = nwg / NXCD, r = nwg % NXCD, xcd = wgid % NXCD, off = wgid / NXCD; wgid = (xcd < r ? xcd * (q + 1) : r * (q + 1) + (xcd - r) * q) + off; }
        const int nig = WGM * nN, gid = wgid / nig, fm = gid * WGM, gsz = (nM - fm) < WGM ? (nM - fm) : WGM;
        u.pm = fm + ((wgid % nig) % gsz); u.pn = (wgid % nig) / gsz; return true;
    }
    __device__ __forceinline__ void a_ready(const Unit&) const {}
    __device__ __forceinline__ void done(const Unit&) const {}
};

__device__ __forceinline__ unsigned cvt_pk_bf16(float lo, float hi) { unsigned r; asm volatile("v_cvt_pk_bf16_f32 %0, %1, %2" : "=v"(r) : "v"(lo), "v"(hi)); return r; }
typedef float f32x2 __attribute__((ext_vector_type(2)));
struct EpiF32 {
    static constexpr bool PERM = false, AFTER_DRAIN = false;
    float* C; int ldc;
    __device__ __forceinline__ void operator()(const f32x4 (&acc)[2][2][4][2], const Unit& u, int wr, int wc, int fr, int fq) const {
        const int row0 = u.pm * BM + wr * 64 + fr, col0 = u.pn * BM + wc * 32 + 4 * fq;
#pragma unroll
        for (int ai = 0; ai < 2; ++ai)
#pragma unroll
            for (int m = 0; m < 4; ++m) { float* rowp = C + (size_t)(row0 + ai * HALF + m * 16) * ldc + col0;
#pragma unroll
                for (int bj = 0; bj < 2; ++bj)
#pragma unroll
                    for (int n = 0; n < 2; ++n) *(f32x4*)(rowp + bj * HALF + n * 16) = acc[ai][bj][m][n]; }
    }
};
template <int ACT  > struct EpiBf16 {
    static constexpr bool PERM = true, AFTER_DRAIN = false;
    bf16_t* O; int ldc;
    __device__ __forceinline__ void operator()(const f32x4 (&acc)[2][2][4][2], const Unit& u, int wr, int wc, int fr, int fq) const {
        const int row0 = u.pm * BM + wr * 64 + fr; const int col0 = u.pn * BM + wc * 32 + 8 * fq;
#pragma unroll
        for (int ai = 0; ai < 2; ++ai)
#pragma unroll
            for (int m = 0; m < 4; ++m) { bf16_t* rowp = O + (size_t)(row0 + ai * HALF + m * 16) * ldc + col0;
#pragma unroll
                for (int bj = 0; bj < 2; ++bj) { f32x4 v0 = acc[ai][bj][m][0], v1 = acc[ai][bj][m][1];
                    if (ACT == 3) {
#pragma unroll
                        for (int j = 0; j < 4; ++j) { const float a = fmaxf(v0[j], 0.f), b = fmaxf(v1[j], 0.f); v0[j] = a * a; v1[j] = b * b; } }
                    u32x4 w; w.x = cvt_pk_bf16(v0[0], v0[1]); w.y = cvt_pk_bf16(v0[2], v0[3]); w.z = cvt_pk_bf16(v1[0], v1[1]); w.w = cvt_pk_bf16(v1[2], v1[3]);
                    *(u32x4*)(rowp + bj * HALF) = w; } }
    }
};
struct EpiQKV {
    static constexpr bool PERM = true, AFTER_DRAIN = false;
    bf16_t* O; int Mrows;
    __device__ __forceinline__ void operator()(const f32x4 (&acc)[2][2][4][2], const Unit& u, int wr, int wc, int fr, int fq) const {
        const int row0 = u.pm * BM + wr * 64 + fr;
#pragma unroll
        for (int bj = 0; bj < 2; ++bj) { bf16_t* hb = O + (size_t)(u.pn * 2 + bj) * Mrows * 128 + wc * 32 + 8 * fq;
#pragma unroll
            for (int ai = 0; ai < 2; ++ai)
#pragma unroll
                for (int m = 0; m < 4; ++m) { const f32x4 v0 = acc[ai][bj][m][0], v1 = acc[ai][bj][m][1];
                    u32x4 w; w.x = cvt_pk_bf16(v0[0], v0[1]); w.y = cvt_pk_bf16(v0[2], v0[3]); w.z = cvt_pk_bf16(v1[0], v1[1]); w.w = cvt_pk_bf16(v1[2], v1[3]);
                    *(u32x4*)(hb + (size_t)(row0 + ai * HALF + m * 16) * 128) = w; } }
    }
};
template <class Epi, class Sched, bool ALIGN_EPI = false, bool SP2 = false>
__device__ __forceinline__ void gemm_phase(PG8_LAS unsigned char* lds, const Gemm g, const Sched& S, const Epi& E) {
    int tid_ = threadIdx.x; asm volatile("" : "+v"(tid_));
    const int tid = tid_, wid = __builtin_amdgcn_readfirstlane(tid >> 6), lane = tid & 63, wr = wid >> 2, wc = wid & 3, fr = lane & 15, fq = lane >> 4;
    const int K = g.K, nt = K / BK;
    unsigned voffA[2], voffB[2];
#pragma unroll
    for (int i = 0; i < 2; ++i) { int R, C; stage_rc(tid * 16 + i * 8192, R, C); const int Rb = Epi::PERM ? ((R & ~31) + perm32(R & 31)) : R;
        voffA[i] = (unsigned)(R * K + C) * 2u; voffB[i] = (unsigned)(Rb * K + C) * 2u; }
    const size_t kstep = (size_t)(BK * 2);
    const size_t hstep = (size_t)HALF * K * 2;
    const size_t tstep = 2 * hstep;
    const unsigned ldsw = (unsigned)wid * 1024u;
    const int aoff = lds_byte(wr * 64 + fr, fq * 8), boff = lds_byte(wc * 32 + fr, fq * 8);
#define PG8_SA(b, h) (((b) * 2 + (h)) * HTB)
#define PG8_SB(b, h) ((4 + (b) * 2 + (h)) * HTB)
#define PG8_STAGE(bufoff, gbase, voff) do { _Pragma("unroll") for (int _i = 0; _i < 2; ++_i) \
        __builtin_amdgcn_global_load_lds((const unsigned*)((const char*)(gbase) + (voff)[_i]), (PG8_LAS unsigned*)(lds + (bufoff) + ldsw + _i * 8192), 16, 0, 0); } while (0)
#define PG8_LDA(dst, b, h) do { _Pragma("unroll") for (int m = 0; m < 4; ++m) _Pragma("unroll") for (int k = 0; k < 2; ++k) dst[m][k] = *(const PG8_LAS bf16x8*)(lds + PG8_SA(b, h) + aoff + m * 2048 + k * 1024); } while (0)
#define PG8_LDB(dst, b, h) do { _Pragma("unroll") for (int n = 0; n < 2; ++n) _Pragma("unroll") for (int k = 0; k < 2; ++k) dst[n][k] = *(const PG8_LAS bf16x8*)(lds + PG8_SB(b, h) + boff + n * 2048 + k * 1024); } while (0)
#define PG8_MMA(ai, bj, At, Bt) do { __builtin_amdgcn_s_setprio(1); _Pragma("unroll") for (int m = 0; m < 4; ++m) _Pragma("unroll") for (int n = 0; n < 2; ++n) _Pragma("unroll") for (int k = 0; k < 2; ++k) \
        acc[ai][bj][m][n] = __builtin_amdgcn_mfma_f32_16x16x32_bf16(Bt[n][k], At[m][k], acc[ai][bj][m][n], 0, 0, 0); __builtin_amdgcn_s_setprio(0); } while (0)
#define PG8_WAIT_V(n) asm volatile("s_waitcnt vmcnt(" #n ")" ::: "memory")
#define PG8_WAIT_L(n) asm volatile("s_waitcnt lgkmcnt(" #n ")" ::: "memory")
#define PG8_BAR __builtin_amdgcn_s_barrier()
#define PG8_SCHED __builtin_amdgcn_sched_barrier(0)
    Unit cur, nxt; int ui = 0;
    if (!S.next(0, cur)) return;
    f32x4 acc[2][2][4][2];
#pragma unroll
    for (int a = 0; a < 2; ++a)
#pragma unroll
        for (int b = 0; b < 2; ++b)
#pragma unroll
            for (int m = 0; m < 4; ++m)
#pragma unroll
                for (int n = 0; n < 2; ++n) acc[a][b][m][n] = (f32x4){0.f, 0.f, 0.f, 0.f};
    bf16x8 At[4][2], B0[2][2], B1[2][2];
    const char* cA = (const char*)g.A + (size_t)cur.pm * tstep; const char* cB = (const char*)g.Bt + (size_t)cur.pn * tstep;
    S.a_ready(cur);
    if constexpr (SP2) {
        PG8_STAGE(PG8_SB(0, 0), cB, voffB); PG8_STAGE(PG8_SB(0, 1), cB + hstep, voffB); PG8_STAGE(PG8_SA(0, 0), cA, voffA); PG8_STAGE(PG8_SA(0, 1), cA + hstep, voffA);
        if (wr == 1) PG8_BAR;
        PG8_WAIT_V(2); PG8_BAR;
        PG8_STAGE(PG8_SB(1, 0), cB + kstep, voffB); PG8_STAGE(PG8_SA(1, 0), cA + kstep, voffA); PG8_STAGE(PG8_SB(1, 1), cB + hstep + kstep, voffB);
        PG8_WAIT_V(6); PG8_BAR;
    } else {
        PG8_STAGE(PG8_SB(0, 0), cB, voffB); PG8_STAGE(PG8_SA(0, 0), cA, voffA); PG8_STAGE(PG8_SB(0, 1), cB + hstep, voffB); PG8_STAGE(PG8_SA(0, 1), cA + hstep, voffA);
        if (wr == 1) PG8_BAR;
        PG8_WAIT_V(4); PG8_BAR;
        PG8_STAGE(PG8_SB(1, 0), cB + kstep, voffB); PG8_STAGE(PG8_SA(1, 0), cA + kstep, voffA); PG8_STAGE(PG8_SB(1, 1), cB + hstep + kstep, voffB);
        PG8_WAIT_V(6); PG8_BAR;
    }
    for (;;) {
        const bool has_next = S.next(ui + 1, nxt);
        const char* nA = has_next ? (const char*)g.A + (size_t)nxt.pm * tstep : cA; const char* nB = has_next ? (const char*)g.Bt + (size_t)nxt.pn * tstep : cB;
        for (int t = 0; t < nt; t += 2) {
            const bool last = (t == nt - 2);
            const char* a1 = cA + (size_t)(t + 1) * kstep;
            const char* a2 = last ? nA : cA + (size_t)(t + 2) * kstep; const char* b2 = last ? nB : cB + (size_t)(t + 2) * kstep;
            const char* a3 = a2 + kstep; const char* b3 = b2 + kstep;
            if (last && has_next) S.a_ready(nxt);
            if constexpr (SP2) {
            PG8_LDB(B0, 0, 0); PG8_LDB(B1, 0, 1); PG8_SCHED; PG8_LDA(At, 0, 0); PG8_STAGE(PG8_SA(1, 1), a1 + hstep, voffA);
            PG8_WAIT_V(8); PG8_WAIT_L(0); PG8_BAR; PG8_MMA(0, 0, At, B0); PG8_MMA(0, 1, At, B1); PG8_BAR; PG8_SCHED;
            PG8_LDA(At, 0, 1); PG8_STAGE(PG8_SB(0, 0), b2, voffB); PG8_STAGE(PG8_SB(0, 1), b2 + hstep, voffB); PG8_STAGE(PG8_SA(0, 0), a2, voffA);
            PG8_WAIT_V(8); PG8_WAIT_L(0); PG8_BAR; PG8_MMA(1, 0, At, B0); PG8_MMA(1, 1, At, B1); PG8_BAR; PG8_SCHED;
            PG8_LDB(B0, 1, 0); PG8_LDB(B1, 1, 1); PG8_SCHED; PG8_LDA(At, 1, 0); PG8_STAGE(PG8_SA(0, 1), a2 + hstep, voffA);
            PG8_WAIT_V(8); PG8_WAIT_L(0); PG8_BAR; PG8_MMA(0, 0, At, B0); PG8_MMA(0, 1, At, B1); PG8_BAR; PG8_SCHED;
            PG8_LDA(At, 1, 1); PG8_STAGE(PG8_SB(1, 0), b3, voffB); PG8_STAGE(PG8_SB(1, 1), b3 + hstep, voffB); PG8_STAGE(PG8_SA(1, 0), a3, voffA);
            PG8_WAIT_V(8); PG8_WAIT_L(0); PG8_BAR; PG8_MMA(1, 0, At, B0); PG8_MMA(1, 1, At, B1); PG8_BAR; PG8_SCHED;
            } else {
            PG8_LDB(B0, 0, 0); PG8_SCHED; PG8_LDA(At, 0, 0); PG8_STAGE(PG8_SA(1, 1), a1 + hstep, voffA);
            PG8_WAIT_L(8); PG8_BAR; PG8_WAIT_L(0); PG8_MMA(0, 0, At, B0); PG8_BAR; PG8_SCHED;
            PG8_LDB(B1, 0, 1); PG8_STAGE(PG8_SB(0, 0), b2, voffB);
            PG8_BAR; PG8_WAIT_L(0); PG8_MMA(0, 1, At, B1); PG8_BAR;
            PG8_LDA(At, 0, 1); PG8_STAGE(PG8_SA(0, 0), a2, voffA);
            PG8_BAR; PG8_WAIT_L(0); PG8_MMA(1, 0, At, B0); PG8_BAR; PG8_SCHED;
            PG8_STAGE(PG8_SB(0, 1), b2 + hstep, voffB);
            PG8_WAIT_V(6); PG8_BAR; PG8_MMA(1, 1, At, B1); PG8_BAR;
            PG8_LDB(B0, 1, 0); PG8_SCHED; PG8_LDA(At, 1, 0); PG8_STAGE(PG8_SA(0, 1), a2 + hstep, voffA);
            PG8_WAIT_L(8); PG8_BAR; PG8_WAIT_L(0); PG8_MMA(0, 0, At, B0); PG8_BAR; PG8_SCHED;
            PG8_LDB(B1, 1, 1); PG8_STAGE(PG8_SB(1, 0), b3, voffB);
            PG8_BAR; PG8_WAIT_L(0); PG8_MMA(0, 1, At, B1); PG8_BAR;
            PG8_LDA(At, 1, 1); PG8_STAGE(PG8_SA(1, 0), a3, voffA);
            PG8_BAR; PG8_WAIT_L(0); PG8_MMA(1, 0, At, B0); PG8_BAR; PG8_SCHED;
            PG8_STAGE(PG8_SB(1, 1), b3 + hstep, voffB);
            PG8_WAIT_V(6); PG8_BAR; PG8_MMA(1, 1, At, B1); PG8_BAR;
            }
        }
        if constexpr (ALIGN_EPI) { if (wr == 0) PG8_BAR; }
        if constexpr (!Epi::AFTER_DRAIN) { E(acc, cur, wr, wc, fr, fq); S.done(cur); }
        if (!has_next) break;
#pragma unroll
        for (int a = 0; a < 2; ++a)
#pragma unroll
            for (int b = 0; b < 2; ++b)
#pragma unroll
                for (int m = 0; m < 4; ++m)
#pragma unroll
                    for (int n = 0; n < 2; ++n) acc[a][b][m][n] = (f32x4){0.f, 0.f, 0.f, 0.f};
        cur = nxt; cA = nA; cB = nB; ++ui;
        if constexpr (ALIGN_EPI) { if (wr == 1) PG8_BAR; }
    }
    PG8_WAIT_V(0);
    if constexpr (!ALIGN_EPI) { if (wr == 0) PG8_BAR; }
    PG8_BAR;
    if constexpr (Epi::AFTER_DRAIN) { E.fused(acc, cur, wr, wc, fr, fq, lds, wid, lane); S.done(cur); }
#undef PG8_SA
#undef PG8_SB
#undef PG8_STAGE
#undef PG8_LDA
#undef PG8_LDB
#undef PG8_MMA
#undef PG8_WAIT_V
#undef PG8_WAIT_L
#undef PG8_BAR
#undef PG8_SCHED
}
}
namespace att {
typedef unsigned short bf16;
using bf16x8 = __attribute__((ext_vector_type(8))) short;
using s16x4  = __attribute__((ext_vector_type(4))) short;
using f32x16 = __attribute__((ext_vector_type(16))) float;
using u32x4  = __attribute__((ext_vector_type(4))) unsigned;
constexpr int   D = 128, NW = 8, QBLK = 32, KVBLK = 64;
constexpr float SCALE = 0.088388347648318440f;
constexpr float LOG2E = 1.4426950408889634f;
constexpr float C2 = SCALE * LOG2E;
constexpr float THR = 8.f;
constexpr int SHM_V = KVBLK * D * 2, SHM_K = KVBLK * D * 2;
constexpr int LDS_WS = 2 * SHM_V + 2 * SHM_K, LDS_TB = LDS_WS + NW * 64 * 4, LDS_ATT_BYTES = LDS_TB + 4096;
#define KSWZ(row, colB) ((row) * 256 + ((colB) ^ (((row) & 7) << 4)))
#define SBAR() __builtin_amdgcn_sched_barrier(0)
__device__ __forceinline__ int crow(int r, int hi) { return (r & 3) + 8 * (r >> 2) + 4 * hi; }
typedef float f32x2_ __attribute__((ext_vector_type(2)));
typedef __bf16 bf16x2_ __attribute__((ext_vector_type(2)));
__device__ __forceinline__ unsigned cvtpk(float lo, float hi) { const f32x2_ v = {lo, hi}; const bf16x2_ r = __builtin_convertvector(v, bf16x2_); return *reinterpret_cast<const unsigned*>(&r); }
#define SGB(mask, n) __builtin_amdgcn_sched_group_barrier(mask, n, 0)
#define SG_QK() do { SGB(0x100, 2); _Pragma("unroll") for (int i_ = 0; i_ < 16; ++i_) { SGB(0x008, 1); if (i_ < 14) SGB(0x100, 1); SGB(0x400, 1); SGB(0x002, 4); } } while (0)
__device__ __forceinline__ bf16x8 ld8(const bf16* p) { return *reinterpret_cast<const bf16x8*>(p); }

struct MaskCtx { int a, v, d; const float* tbl; };
constexpr int TB_ORG = 256;

__device__ __forceinline__ void partialSM(f32x16& p0, f32x16& p1, float& m_reg, float& mn, float& alpha) {
  float pmax = p0[0];
#pragma unroll
  for (int r = 1; r < 16; ++r) pmax = fmaxf(pmax, p0[r]);
#pragma unroll
  for (int r = 0; r < 16; ++r) pmax = fmaxf(pmax, p1[r]);
  { auto rr = __builtin_amdgcn_permlane32_swap(__float_as_uint(pmax), __float_as_uint(pmax), false, false);
    pmax = fmaxf(__uint_as_float(rr[0]), __uint_as_float(rr[1])); }
  if (__builtin_expect(__all(pmax - m_reg <= THR / SCALE), 1)) { mn = m_reg; alpha = 1.f; }
  else { mn = fmaxf(m_reg, pmax); alpha = __builtin_amdgcn_exp2f((m_reg - mn) * C2); m_reg = mn; }
  float mnC = -mn * C2;
#pragma unroll
  for (int r = 0; r < 16; ++r) p0[r] = fmaf(p0[r], C2, mnC);
#pragma unroll
  for (int r = 0; r < 16; ++r) p1[r] = fmaf(p1[r], C2, mnC);
#pragma unroll
  for (int r = 0; r < 16; ++r) p0[r] = __builtin_amdgcn_exp2f(p0[r]);
}
template <int KIND>
__device__ __forceinline__ void partialSM_m(f32x16& p0, f32x16& p1, float& m_reg, float& mn, float& alpha, int jt, const MaskCtx& mc) {
  const float* tp = (KIND == 1) ? mc.tbl + (jt - mc.a + 7) * 31 : mc.tbl + jt * 64;
  float b0[16], b1[16];
#pragma unroll
  for (int r = 0; r < 16; ++r) { const int kc = (r & 3) + 8 * (r >> 2); b0[r] = tp[kc]; b1[r] = tp[kc + 32]; }
#pragma unroll
  for (int r = 0; r < 16; ++r) asm volatile("" : "+v"(b0[r]), "+v"(b1[r]));
  if (KIND == 1) {
    const bool rowok = (unsigned)(jt - min(max(mc.a - 4, 0), 120)) <= 7u;
#pragma unroll
    for (int r = 0; r < 16; ++r) { const int kc = (r & 3) + 8 * (r >> 2);
      { const bool ok = rowok && (unsigned)(kc - mc.v) <= 15u; const float t = fmaf(p0[r], C2, b0[r]); p0[r] = ok ? t : -1e30f; }
      { const bool ok = rowok && (unsigned)(kc + 32 - mc.v) <= 15u; const float t = fmaf(p1[r], C2, b1[r]); p1[r] = ok ? t : -1e30f; } }
  } else {
    const bool tok = (unsigned)jt < (unsigned)mc.d;
    const int db = jt * 64 + mc.v;
#pragma unroll
    for (int r = 0; r < 16; ++r) { const int kc = (r & 3) + 8 * (r >> 2);
      { const bool ok = tok && (unsigned)(db + kc) <= 128u; const float t = fmaf(p0[r], C2, b0[r]); p0[r] = ok ? t : -1e30f; }
      { const bool ok = tok && (unsigned)(db + kc + 32) <= 128u; const float t = fmaf(p1[r], C2, b1[r]); p1[r] = ok ? t : -1e30f; } }
  }
  float pmax = p0[0];
#pragma unroll
  for (int r = 1; r < 16; ++r) pmax = fmaxf(pmax, p0[r]);
#pragma unroll
  for (int r = 0; r < 16; ++r) pmax = fmaxf(pmax, p1[r]);
  { auto rr = __builtin_amdgcn_permlane32_swap(__float_as_uint(pmax), __float_as_uint(pmax), false, false);
    pmax = fmaxf(__uint_as_float(rr[0]), __uint_as_float(rr[1])); }
  if (__builtin_expect(__all(pmax - m_reg <= THR * LOG2E), 1)) { mn = m_reg; alpha = 1.f; }
  else { mn = fmaxf(m_reg, pmax); alpha = __builtin_amdgcn_exp2f(m_reg - mn); m_reg = mn; }
#pragma unroll
  for (int r = 0; r < 16; ++r) p0[r] -= mn;
#pragma unroll
  for (int r = 0; r < 16; ++r) p1[r] -= mn;
#pragma unroll
  for (int r = 0; r < 16; ++r) p0[r] = __builtin_amdgcn_exp2f(p0[r]);
}
template <bool FAST = false>
__device__ __forceinline__ void finishSM(f32x16& p0, f32x16& p1, float alpha, float& l_reg, bf16x8& pa0, bf16x8& pa1, bf16x8& pa2, bf16x8& pa3) {
#pragma unroll
  for (int r = 0; r < 16; ++r) p1[r] = __builtin_amdgcn_exp2f(p1[r]);
  float ps = 0;
#pragma unroll
  for (int r = 0; r < 16; ++r) ps += p0[r];
#pragma unroll
  for (int r = 0; r < 16; ++r) ps += p1[r];
  if (FAST) l_reg += ps;
  else { auto rr = __builtin_amdgcn_permlane32_swap(__float_as_uint(ps), __float_as_uint(ps), false, false);
    ps = __uint_as_float(rr[0]) + __uint_as_float(rr[1]); l_reg = l_reg * alpha + ps; }
#define PK4(P, BASE, OUT) do { unsigned a0 = cvtpk(P[BASE + 0], P[BASE + 1]), a1 = cvtpk(P[BASE + 2], P[BASE + 3]);   \
    unsigned b0 = cvtpk(P[BASE + 4], P[BASE + 5]), b1 = cvtpk(P[BASE + 6], P[BASE + 7]);                              \
    auto r0 = __builtin_amdgcn_permlane32_swap(a0, b0, false, false); auto r1 = __builtin_amdgcn_permlane32_swap(a1, b1, false, false); \
    u32x4 w = {r0[0], r1[0], r0[1], r1[1]}; OUT = *reinterpret_cast<bf16x8*>(&w); } while (0)
  PK4(p0, 0, pa0); PK4(p0, 8, pa1); PK4(p1, 0, pa2); PK4(p1, 8, pa3);
#undef PK4
}
__device__ __forceinline__ void qkt(f32x16& p0, f32x16& p1, const bf16* Ks, const bf16x8* qr, int r32, int hi) {
  p0 = f32x16{}; p1 = f32x16{};
#pragma unroll
  for (int d0 = 0; d0 < 8; ++d0) { int cb = (d0 * 16 + hi * 8) * 2;
    bf16x8 b0 = *reinterpret_cast<const bf16x8*>((const char*)Ks + KSWZ(r32, cb));
    bf16x8 b1 = *reinterpret_cast<const bf16x8*>((const char*)Ks + KSWZ(32 + r32, cb));
    p0 = __builtin_amdgcn_mfma_f32_32x32x16_bf16(b0, qr[d0], p0, 0, 0, 0);
    p1 = __builtin_amdgcn_mfma_f32_32x32x16_bf16(b1, qr[d0], p1, 0, 0, 0); }
}
__device__ __forceinline__ int v_st(int k, int c) { const int kk = (k & ~0xC) | ((k & 4) << 1) | ((k & 8) >> 1); return ((kk >> 3) * 4 + (c >> 5)) * 512 + ((kk & 7) * 32 + (c & 31)) * 2; }
__device__ __forceinline__ int v_rd_base(int lane) { return ((lane & 3) << 3) | (((lane >> 2) & 3) << 6) | (((lane >> 4) & 1) << 5) | (((lane >> 5) & 1) << 8); }
constexpr int v_rd_off(int d0, int ks, int half) { return d0 * 512 + ks * 4096 + half * 2048; }
template <int OFF> __device__ __forceinline__ s16x4 tr_read(int vb) {
  s16x4 r; asm volatile("ds_read_b64_tr_b16 %0, %1 offset:%2" : "=&v"(r) : "v"(vb), "i"(OFF) : "memory"); return r;
}
template <int D0> __device__ __forceinline__ void pv_one(f32x16& od, int vb, bf16x8 pa0, bf16x8 pa1, bf16x8 pa2, bf16x8 pa3) {
  const s16x4 l0 = tr_read<v_rd_off(D0, 0, 0)>(vb), h0 = tr_read<v_rd_off(D0, 0, 1)>(vb), l1 = tr_read<v_rd_off(D0, 1, 0)>(vb), h1 = tr_read<v_rd_off(D0, 1, 1)>(vb);
  const s16x4 l2 = tr_read<v_rd_off(D0, 2, 0)>(vb), h2 = tr_read<v_rd_off(D0, 2, 1)>(vb), l3 = tr_read<v_rd_off(D0, 3, 0)>(vb), h3 = tr_read<v_rd_off(D0, 3, 1)>(vb);
  asm volatile("s_waitcnt lgkmcnt(0)" ::: "memory"); SBAR();
#define PK(L, H) (bf16x8){L[0], L[1], L[2], L[3], H[0], H[1], H[2], H[3]}
  od = __builtin_amdgcn_mfma_f32_32x32x16_bf16(pa0, PK(l0, h0), od, 0, 0, 0);
  od = __builtin_amdgcn_mfma_f32_32x32x16_bf16(pa1, PK(l1, h1), od, 0, 0, 0);
  od = __builtin_amdgcn_mfma_f32_32x32x16_bf16(pa2, PK(l2, h2), od, 0, 0, 0);
  od = __builtin_amdgcn_mfma_f32_32x32x16_bf16(pa3, PK(l3, h3), od, 0, 0, 0);
#undef PK
}
__device__ __forceinline__ void pv_d0(f32x16* o, int vb, bf16x8 pa0, bf16x8 pa1, bf16x8 pa2, bf16x8 pa3) {
  pv_one<0>(o[0], vb, pa0, pa1, pa2, pa3); pv_one<1>(o[1], vb, pa0, pa1, pa2, pa3); pv_one<2>(o[2], vb, pa0, pa1, pa2, pa3); pv_one<3>(o[3], vb, pa0, pa1, pa2, pa3);
}
#define PKS(C, B, OUT) do { auto r0_ = __builtin_amdgcn_permlane32_swap(C[(B)], C[(B) + 2], false, false); auto r1_ = __builtin_amdgcn_permlane32_swap(C[(B) + 1], C[(B) + 3], false, false); \
    u32x4 w_ = {r0_[0], r1_[0], r0_[1], r1_[1]}; OUT = *reinterpret_cast<bf16x8*>(&w_); } while (0)
#ifndef KDEP
#define KDEP 1
#endif
#define KRD1(g_, X) do { const int cb_ = (((g_) >> 1) * 16 + hi * 8) * 2; X = *reinterpret_cast<const bf16x8*>((const char*)Ks + KSWZ(((g_) & 1) * 32 + r32, cb_)); } while (0)
template <bool FAST>
__device__ __forceinline__ void qk_fsm(f32x16& n0, f32x16& n1, const bf16* Ks, const bf16x8* qr, int r32, int hi,
                                       f32x16& p0, f32x16& p1, float alpha, float& l_reg, bf16x8& pa0, bf16x8& pa1, bf16x8& pa2, bf16x8& pa3) {
  n0 = f32x16{}; n1 = f32x16{};
  bf16x8 kf[KDEP + 1]; unsigned c[16]; float s0 = 0.f, s1 = 0.f, ps = 0.f;
  KRD1(0, kf[0]); if (KDEP > 1) KRD1(1, kf[1]);
#pragma unroll
  for (int g = 0; g < 16; ++g) { const int d0 = g >> 1;
    if (g + KDEP < 16) KRD1(g + KDEP, kf[(g + KDEP) % (KDEP + 1)]);
    if ((g & 1) == 0) n0 = __builtin_amdgcn_mfma_f32_32x32x16_bf16(kf[g % (KDEP + 1)], qr[d0], n0, 0, 0, 0);
    else              n1 = __builtin_amdgcn_mfma_f32_32x32x16_bf16(kf[g % (KDEP + 1)], qr[d0], n1, 0, 0, 0);
    if (g < 4) { p1[2 * g] = __builtin_amdgcn_exp2f(p1[2 * g]); p1[2 * g + 1] = __builtin_amdgcn_exp2f(p1[2 * g + 1]); }
    else if (g < 12) p1[g + 4] = __builtin_amdgcn_exp2f(p1[g + 4]);
    if (g < 8) { s0 += p0[2 * g]; s1 += p0[2 * g + 1]; c[g] = cvtpk(p0[2 * g], p0[2 * g + 1]); }
    if (g >= 5 && g <= 12) { const int k = g - 5; s0 += p1[2 * k]; s1 += p1[2 * k + 1]; c[8 + k] = cvtpk(p1[2 * k], p1[2 * k + 1]); }
    if (g == 4) PKS(c, 0, pa0);
    if (g == 8) PKS(c, 4, pa1);
    if (g == 9) PKS(c, 8, pa2);
    if (g == 13) { PKS(c, 12, pa3); ps = s0 + s1; }
    if (g == 14 && !FAST) { auto rr = __builtin_amdgcn_permlane32_swap(__float_as_uint(ps), __float_as_uint(ps), false, false); ps = __uint_as_float(rr[0]) + __uint_as_float(rr[1]); }
    if (g == 15) l_reg = FAST ? l_reg + ps : l_reg * alpha + ps;
    SBAR();
  }
}
#undef KRD1
template <bool FAST>
__device__ __forceinline__ void pv_psm(f32x16* o, int vb, bf16x8 pa0, bf16x8 pa1, bf16x8 pa2, bf16x8 pa3, f32x16& p0, f32x16& p1, float& m_reg, float& mn, float& alpha) {
  if constexpr (FAST) {
    pv_one<0>(o[0], vb, pa0, pa1, pa2, pa3);
#pragma unroll
    for (int r = 0; r < 4; ++r) p0[r] = __builtin_amdgcn_exp2f(p0[r]);
    pv_one<1>(o[1], vb, pa0, pa1, pa2, pa3);
#pragma unroll
    for (int r = 4; r < 8; ++r) p0[r] = __builtin_amdgcn_exp2f(p0[r]);
    pv_one<2>(o[2], vb, pa0, pa1, pa2, pa3);
#pragma unroll
    for (int r = 8; r < 12; ++r) p0[r] = __builtin_amdgcn_exp2f(p0[r]);
    pv_one<3>(o[3], vb, pa0, pa1, pa2, pa3);
#pragma unroll
    for (int r = 12; r < 16; ++r) p0[r] = __builtin_amdgcn_exp2f(p0[r]);
    asm volatile("" : "+v"(p0), "+v"(p1));
    return;
  }
  pv_one<0>(o[0], vb, pa0, pa1, pa2, pa3);
  float pmax = p0[0];
#pragma unroll
  for (int r = 1; r < 16; ++r) pmax = fmaxf(pmax, p0[r]);
  pv_one<1>(o[1], vb, pa0, pa1, pa2, pa3);
#pragma unroll
  for (int r = 0; r < 16; ++r) pmax = fmaxf(pmax, p1[r]);
  { auto rr = __builtin_amdgcn_permlane32_swap(__float_as_uint(pmax), __float_as_uint(pmax), false, false);
    pmax = fmaxf(__uint_as_float(rr[0]), __uint_as_float(rr[1])); }
  if (__builtin_expect(__all(pmax - m_reg <= THR / SCALE), 1)) { mn = m_reg; alpha = 1.f; }
  else { mn = fmaxf(m_reg, pmax); alpha = __builtin_amdgcn_exp2f((m_reg - mn) * C2); m_reg = mn; }
  const float mnC = -mn * C2;
  pv_one<2>(o[2], vb, pa0, pa1, pa2, pa3);
#pragma unroll
  for (int r = 0; r < 16; ++r) p0[r] = fmaf(p0[r], C2, mnC);
#pragma unroll
  for (int r = 0; r < 16; ++r) p1[r] = fmaf(p1[r], C2, mnC);
  pv_one<3>(o[3], vb, pa0, pa1, pa2, pa3);
#pragma unroll
  for (int r = 0; r < 16; ++r) p0[r] = __builtin_amdgcn_exp2f(p0[r]);
  asm volatile("" : "+v"(p0), "+v"(p1));
}

template <int KIND, bool FAST = false>
__device__ __forceinline__ void attn_unit(const bf16* __restrict__ Qb, long qs, const bf16* __restrict__ Kh, const bf16* __restrict__ Vh, long ks,
                                          int kt0, int NT, int ktmax, bf16* __restrict__ Ob, long os, float* __restrict__ stp, long sts,
                                          int mq0, const float* __restrict__ tbsrc, int tbn, char* lds,
                                          const float* __restrict__ qg = nullptr, const float* __restrict__ rope = nullptr, int t0 = 0) {
  int tid_ = threadIdx.x; asm volatile("" : "+v"(tid_));
  const int tid = tid_, wid = __builtin_amdgcn_readfirstlane(tid >> 6), lane = tid & 63, r32 = lane & 31, hi = lane >> 5;
  bf16* V_lds = (bf16*)lds; bf16* K_lds = (bf16*)(lds + 2 * SHM_V);
  float* ws = (float*)(lds + LDS_WS) + wid * 64; float* li_l = ws; float* al_l = ws + 32;
  float* tb = (float*)(lds + LDS_TB);
  MaskCtx mc; mc.a = 0; mc.v = 0; mc.d = 0; mc.tbl = tb;
  if (KIND == 1) { const int r = mq0 + (wid >> 1), c = (wid & 1) * 32 + r32; mc.a = r; mc.v = min(max(c - 8, 0), 48) - 4 * hi; mc.tbl = tb + TB_ORG + 15 - c + 4 * hi; }
  if (KIND == 2) { mc.v = 64 - (mq0 + wid * 32 + r32) + 4 * hi; mc.d = ktmax; mc.tbl = tb + TB_ORG + mc.v; }
  if (KIND != 0) { __syncthreads();
    for (int i = tid; i < tbn; i += 64 * NW) tb[TB_ORG + i] = tbsrc[i] * LOG2E; }
  float m_reg = -1e30f, l_reg = 0; f32x16 o[4] = {}; bf16x8 qr[8];
  const bf16* Qw = Qb + (long)(wid * QBLK + r32) * qs + hi * 8;
#pragma unroll
  for (int d0 = 0; d0 < 8; ++d0) qr[d0] = ld8(Qw + d0 * 16);
  if (KIND == 0 && qg != nullptr) {
    float x[8][8];
#pragma unroll
    for (int d0 = 0; d0 < 8; ++d0) { const u32x4 w = *reinterpret_cast<const u32x4*>(&qr[d0]);
      x[d0][0] = __uint_as_float(w[0] << 16); x[d0][1] = __uint_as_float(w[0] & 0xffff0000u); x[d0][2] = __uint_as_float(w[1] << 16); x[d0][3] = __uint_as_float(w[1] & 0xffff0000u);
      x[d0][4] = __uint_as_float(w[2] << 16); x[d0][5] = __uint_as_float(w[2] & 0xffff0000u); x[d0][6] = __uint_as_float(w[3] << 16); x[d0][7] = __uint_as_float(w[3] & 0xffff0000u); }
    float ss = 0.f;
#pragma unroll
    for (int d0 = 0; d0 < 8; ++d0)
#pragma unroll
      for (int i = 0; i < 8; ++i) ss += x[d0][i] * x[d0][i];
    ss += __shfl_xor(ss, 32);
    const float rstd = (FAST ? C2 : 1.0f) / sqrtf(ss * (1.0f / 128.0f) + 1e-6f);
#pragma unroll
    for (int d0 = 0; d0 < 8; ++d0) { const float* gp = qg + d0 * 16 + hi * 8; const float4 g0 = *reinterpret_cast<const float4*>(gp), g1 = *reinterpret_cast<const float4*>(gp + 4);
      x[d0][0] *= rstd * g0.x; x[d0][1] *= rstd * g0.y; x[d0][2] *= rstd * g0.z; x[d0][3] *= rstd * g0.w; x[d0][4] *= rstd * g1.x; x[d0][5] *= rstd * g1.y; x[d0][6] *= rstd * g1.z; x[d0][7] *= rstd * g1.w; }
    const int t = t0 + wid * QBLK + r32;
#pragma unroll
    for (int half = 0; half < 2; ++half) { const int pos = half ? (t & 63) : (t >> 6);
#pragma unroll
      for (int dd = 0; dd < 2; ++dd) { const int d1 = half * 4 + dd, d2 = d1 + 2; const float* rp = rope + pos * 32 + dd * 16 + hi * 8;
        const float4 c0 = *reinterpret_cast<const float4*>(rp), c1 = *reinterpret_cast<const float4*>(rp + 4), s0 = *reinterpret_cast<const float4*>(rp + 4096), s1 = *reinterpret_cast<const float4*>(rp + 4100);
        const float cs[8] = {c0.x, c0.y, c0.z, c0.w, c1.x, c1.y, c1.z, c1.w}, sn[8] = {s0.x, s0.y, s0.z, s0.w, s1.x, s1.y, s1.z, s1.w};
#pragma unroll
        for (int i = 0; i < 8; ++i) { const float a1 = x[d1][i], a2 = x[d2][i]; x[d1][i] = a1 * cs[i] - a2 * sn[i]; x[d2][i] = a1 * sn[i] + a2 * cs[i]; } } }
#pragma unroll
    for (int d0 = 0; d0 < 8; ++d0) { u32x4 w = {cvtpk(x[d0][0], x[d0][1]), cvtpk(x[d0][2], x[d0][3]), cvtpk(x[d0][4], x[d0][5]), cvtpk(x[d0][6], x[d0][7])}; qr[d0] = *reinterpret_cast<bf16x8*>(&w); }
  }
  const int sr = tid >> 4, sc = (tid & 15) * 8, vst0 = v_st(sr, sc), vst1 = v_st(32 + sr, sc);
  const int vb0 = (int)(uintptr_t)V_lds + v_rd_base(lane);
  const bf16* Kp = Kh + (long)sr * ks + sc; const bf16* Vp = Vh + (long)sr * ks + sc; const long o32 = 32 * ks, tstep = 64 * ks;
  struct { bf16x8 vs0, vs1, ks0, ks1; } sr_[2];
#define TCL(j) ((long)min(max(kt0 + (j), 0), ktmax - 1))
#define SLOAD(i, j) do { const long off_ = TCL(j) * tstep; sr_[i].vs0 = ld8(Vp + off_); sr_[i].vs1 = ld8(Vp + off_ + o32); sr_[i].ks0 = ld8(Kp + off_); sr_[i].ks1 = ld8(Kp + off_ + o32); } while (0)
#define SWRITE(b, i) do { *(bf16x8*)((char*)V_lds + (b) * SHM_V + vst0) = sr_[i].vs0;          \
    *(bf16x8*)((char*)V_lds + (b) * SHM_V + vst1) = sr_[i].vs1; int kc = sc * 2;               \
    *(bf16x8*)((char*)K_lds + (b) * SHM_K + KSWZ(sr, kc)) = sr_[i].ks0;                       \
    *(bf16x8*)((char*)K_lds + (b) * SHM_K + KSWZ(32 + sr, kc)) = sr_[i].ks1; } while (0)
#define SWAIT() asm volatile("s_waitcnt vmcnt(4)" ::: "memory")
#define RESC(a) do { if (__any((a) < 1.f)) { if (hi == 0) al_l[r32] = (a); asm volatile("s_waitcnt lgkmcnt(0)" ::: "memory"); \
    _Pragma("unroll") for (int d = 0; d < 4; ++d) _Pragma("unroll") for (int r = 0; r < 16; ++r) o[d][r] *= al_l[crow(r, hi)]; } } while (0)
  int never_ = 0; asm volatile("s_mov_b32 %0, 0" : "=s"(never_));
#define SEAM() do { if (__builtin_expect(never_ != 0, 0)) asm volatile("s_nop 0" ::: "memory"); } while (0)
  bf16x8 pa0, pa1, pa2, pa3;
  if constexpr (KIND == 0) {
    f32x16 pA0, pA1, pB0, pB1; float mnA, mnB, alA, alB;
    constexpr int SE = 0, SO = 1;
    SLOAD(SE, 0); asm volatile("s_waitcnt vmcnt(0)" ::: "memory"); SWRITE(0, SE); __syncthreads();
    qkt(pA0, pA1, K_lds, qr, r32, hi);
    if constexpr (FAST) { mnA = mnB = 0.f; alA = alB = 1.f;
      _Pragma("unroll") for (int r = 0; r < 16; ++r) pA0[r] = __builtin_amdgcn_exp2f(pA0[r]); }
    else partialSM(pA0, pA1, m_reg, mnA, alA);
    SLOAD(SO, 1); if (2 < NT) SLOAD(SE, 2);
    SWAIT(); SWRITE(1, SO); __syncthreads();
    for (int j = 1; j + 1 < NT; j += 2) {
      SBAR(); qk_fsm<false>(pB0, pB1, (bf16*)((char*)K_lds + SHM_K), qr, r32, hi, pA0, pA1, alA, l_reg, pa0, pa1, pa2, pa3);
      SLOAD(SO, j + 2); SBAR();
      pv_psm<FAST>(o, vb0, pa0, pa1, pa2, pa3, pB0, pB1, m_reg, mnB, alB);
      __syncthreads(); SWAIT(); SWRITE(0, SE);
      if (!FAST) RESC(alB); else SEAM(); __syncthreads();
      SBAR(); qk_fsm<false>(pA0, pA1, K_lds, qr, r32, hi, pB0, pB1, alB, l_reg, pa0, pa1, pa2, pa3);
      if (j + 3 < NT) SLOAD(SE, j + 3); SBAR();
      pv_psm<FAST>(o, vb0 + (int)SHM_V, pa0, pa1, pa2, pa3, pA0, pA1, m_reg, mnA, alA);
      __syncthreads(); SWAIT(); SWRITE(1, SO);
      if (!FAST) RESC(alA); else SEAM(); __syncthreads();
    }
    SBAR(); qk_fsm<false>(pB0, pB1, (bf16*)((char*)K_lds + SHM_K), qr, r32, hi, pA0, pA1, alA, l_reg, pa0, pa1, pa2, pa3);
    pv_psm<FAST>(o, vb0, pa0, pa1, pa2, pa3, pB0, pB1, m_reg, mnB, alB);
    __syncthreads(); if (!FAST) RESC(alB);
    finishSM(pB0, pB1, alB, l_reg, pa0, pa1, pa2, pa3); SBAR();
    pv_d0(o, vb0 + (int)SHM_V, pa0, pa1, pa2, pa3);
  } else {
    const int nd_lo = (KIND == 1) ? min(max(mq0 + (wid >> 1) - 4, 0), 120) : (mq0 + 32 * wid - 127);
    const int nd_hi = mq0 + 32 * wid + 95;
#define NEED(jt) ((KIND == 1) ? ((unsigned)((jt) - nd_lo) <= 7u) : ((unsigned)(jt) < (unsigned)ktmax && 64 * (jt) >= nd_lo && 64 * (jt) <= nd_hi))
    f32x16 p0, p1; float mn, al;
    SLOAD(0, 0); SLOAD(1, 1);
#define STEP(J, B) do { SWRITE(B, B); if ((J) + 2 < NT) SLOAD(B, (J) + 2); __syncthreads();                                     \
      if (NEED(kt0 + (J))) { qkt(p0, p1, (bf16*)((char*)K_lds + (B) * SHM_K), qr, r32, hi); partialSM_m<KIND>(p0, p1, m_reg, mn, al, kt0 + (J), mc); RESC(al); \
        finishSM(p0, p1, al, l_reg, pa0, pa1, pa2, pa3); SBAR(); pv_d0(o, vb0 + (B) * (int)SHM_V, pa0, pa1, pa2, pa3); } } while (0)
    for (int j = 0; j < NT; j += 2) { STEP(j, 0); STEP(j + 1, 1); }
#undef STEP
#undef NEED
  }
  if (hi == 0) li_l[r32] = l_reg; asm volatile("s_waitcnt lgkmcnt(0)" ::: "memory");
  if (KIND == 2) { if (hi == 0) { float* sp = stp + (long)(wid * QBLK + r32) * sts; sp[0] = m_reg; sp[1] = l_reg; } }
  float rli[16];
#pragma unroll
  for (int r = 0; r < 16; ++r) rli[r] = __builtin_amdgcn_rcpf(li_l[crow(r, hi)]);
  bf16* Ow = Ob + (long)(wid * QBLK) * os;
#pragma unroll
  for (int r = 0; r < 16; ++r) { const int orow = crow(r, hi);
#pragma unroll
    for (int d0 = 0; d0 < 4; ++d0) { const float v = o[d0][r] * rli[r]; Ow[(long)orow * os + d0 * 32 + r32] = (bf16)(cvtpk(v, v) & 0xffffu); } }
#undef TCL
#undef SLOAD
#undef SWRITE
#undef SWAIT
#undef RESC
#undef SEAM
}
}
#define GAS __attribute__((address_space(1)))
#define LAS __attribute__((address_space(3)))
typedef unsigned short bf16;
typedef unsigned v4u __attribute__((ext_vector_type(4)));
typedef float f32x4 __attribute__((ext_vector_type(4)));
typedef short bf16x8 __attribute__((ext_vector_type(8)));
typedef GAS unsigned gu32;
typedef GAS unsigned long long gu64;
#define RLX_AGENT __ATOMIC_RELAXED, __HIP_MEMORY_SCOPE_AGENT
#define LDS_WAIT() asm volatile("s_waitcnt lgkmcnt(0)" ::: "memory")
#define VM_WAIT() asm volatile("s_waitcnt vmcnt(0)" ::: "memory")
__device__ __forceinline__ unsigned long long rt() { return __builtin_amdgcn_s_memrealtime(); }
__device__ __forceinline__ unsigned f2bf(float f) { unsigned u = __builtin_bit_cast(unsigned, f); return (u + 0x7fffu + ((u >> 16) & 1u)) >> 16; }
__device__ __forceinline__ unsigned pk2(float lo, float hi) { return f2bf(lo) | (f2bf(hi) << 16); }

#define XB_TMO      128
#define XB_XCNT(j)  (256  + 64 * (j))
#define XB_XSUB(j)  (1280 + 64 * (j))
#define XB_XGEN(j)  (2304 + 64 * (j))
#define XB_TOP      3328
#define XB_TOPGEN   3392
#define XCD_BAR_WORDS 3456
#define XB_SPIN_CAP (1u << 18)

__device__ __forceinline__ unsigned xb_ld(unsigned* p)              { return __hip_atomic_load(p, __ATOMIC_RELAXED, __HIP_MEMORY_SCOPE_AGENT); }
__device__ __forceinline__ unsigned xb_add(unsigned* p, unsigned v) { return __hip_atomic_fetch_add(p, v, __ATOMIC_RELAXED, __HIP_MEMORY_SCOPE_AGENT); }
__device__ __forceinline__ unsigned xb_xcc_id() { return (unsigned)__builtin_amdgcn_s_getreg((3 << 11) | 20) & 0xFu; }
#define XB_SPIN(cond, bar) do { unsigned _sp = 0; while (cond) { __builtin_amdgcn_s_sleep(1); \
    if ((++_sp & 255u) == 0u) { if (xb_ld(&(bar)[XB_TMO])) break; if (_sp > XB_SPIN_CAP) { atomicAdd(&(bar)[XB_TMO], 1u); break; } } } } while (0)

struct XcdBarrier {
    unsigned* bar; unsigned x;
    volatile LAS unsigned* st;
};

__device__ __forceinline__ XcdBarrier xcd_barrier_post(unsigned* bar, volatile LAS unsigned* st) {
    XcdBarrier b; b.bar = bar; b.x = xb_xcc_id(); b.st = st;
    if (threadIdx.x == 0) (void)xb_add(&bar[XB_XCNT(b.x)], 1u);
    return b;
}
__device__ __forceinline__ void xcd_barrier_complete(unsigned* bar, unsigned x, unsigned& nloc, unsigned& nx) {
    const unsigned G = gridDim.x * gridDim.y * gridDim.z;
    unsigned sum, cnt, mine, sp = 0u;
    for (;;) {
        sum = 0u; cnt = 0u; mine = 0u;
#pragma unroll
        for (unsigned j = 0; j < 16; ++j) { const unsigned c = xb_ld(&bar[XB_XCNT(j)]); sum += c; cnt += (c > 0u) ? 1u : 0u; mine = (j == x) ? c : mine; }
        if (sum == G) break;
        __builtin_amdgcn_s_sleep(1);
        if ((++sp & 255u) == 0u) { if (xb_ld(&bar[XB_TMO])) break; if (sp > XB_SPIN_CAP) { atomicAdd(&bar[XB_TMO], 1u); break; } }
    }
    nloc = mine > 0u ? mine : 1u; nx = cnt > 0u ? cnt : 1u;
}

__device__ __forceinline__ void xcd_barrier(const XcdBarrier& b) {
    asm volatile("s_waitcnt vmcnt(0)" ::: "memory");
    __syncthreads();
    if (threadIdx.x == 0) {
        unsigned* bar = b.bar;
        __builtin_amdgcn_s_waitcnt(0);
        unsigned nloc = b.st[0], nx = b.st[1];
        if (nloc == 0u) { xcd_barrier_complete(bar, b.x, nloc, nx); b.st[0] = nloc; b.st[1] = nx; }
        const unsigned old = xb_add(&bar[XB_XSUB(b.x)], 1u);
        const unsigned gen = old / nloc;
        if (old + 1u == (gen + 1u) * nloc) {
            __builtin_amdgcn_fence(__ATOMIC_RELEASE, "agent");
            asm volatile("s_waitcnt vmcnt(0)" ::: "memory");
            const unsigned og = xb_add(&bar[XB_TOP], 1u);
            const unsigned tg = og / nx;
            if (og + 1u == (tg + 1u) * nx) xb_add(&bar[XB_TOPGEN], 1u);
            else XB_SPIN(xb_ld(&bar[XB_TOPGEN]) == tg, bar);
            __builtin_amdgcn_fence(__ATOMIC_ACQUIRE, "agent");
            xb_add(&bar[XB_XGEN(b.x)], 1u);
            asm volatile("s_waitcnt vmcnt(0)" ::: "memory");
        } else {
            XB_SPIN(xb_ld(&bar[XB_XGEN(b.x)]) == gen, bar);
            __builtin_amdgcn_fence(__ATOMIC_ACQUIRE, "agent");
            asm volatile("s_waitcnt vmcnt(0)" ::: "memory");
        }
    }
    __syncthreads();
}
constexpr int BATCH = 2, SEQ = 8192, DM = 4096, DEPTH = 4, HDIM = 128, H_NA = 8, H_DIL = 12, H_GQA = 12, KV_GQA = 4;
constexpr int NQKV = 10240, DFF = 16384, M = BATCH * SEQ, NMOD = 6;
constexpr int Q_NA = 0, Q_DIL = 1024, Q_GQA = 2560, K_NA = 4096, K_DIL = 5120, K_GQA = 6656, V_NA = 7168, V_DIL = 8192, V_GQA = 9728;
constexpr int O_NA = 0, O_DIL = 1024, O_GQA = 2560, DILW = H_DIL * HDIM;
constexpr float EPS = 1e-6f;
constexpr size_t MiB = 1u << 20;
constexpr size_t WS_CTL = 0, CTL_ZERO_BYTES = 1 * MiB;
constexpr size_t WS_MODP = 1 * MiB;
constexpr size_t WS_MODV = 4 * MiB;
constexpr size_t WS_ROPE = 5 * MiB;
constexpr size_t WS_DILTB = 5 * MiB + 64 * 1024;
constexpr size_t WS_DILST = 6 * MiB;
constexpr size_t WS_WIN = 16 * MiB, WS_WOUT = 336 * MiB, WS_W1 = 464 * MiB, WS_W2 = 976 * MiB;
constexpr size_t WS_H = 1488 * MiB, WS_QKV = 1616 * MiB, WS_O = 1936 * MiB, WS_Y = 2064 * MiB, WS_U = 2320 * MiB, WS_DILP = 2832 * MiB, WS_XB = 2976 * MiB, WS_END = 3104 * MiB;
static_assert(WS_DILST + (size_t)3 * M * 12 * 2 * 4 <= WS_WIN, "ws map");
constexpr int CW_BAR = 4096, CW_QUEUE = 16384;
constexpr int RING_OFF = 0, RING_BYTES = 131072, LDSCTL_OFF = RING_BYTES, MISC_OFF = LDSCTL_OFF + 320, LDS_BYTES = 147456;
constexpr int NWAVES = 8;

struct Frame {
    LAS unsigned char* lds; volatile LAS unsigned* MISC;
    int G;
};
__device__ __forceinline__ float wave_sum(float v) {
#pragma unroll
    for (int o = 1; o < 64; o <<= 1) v += __shfl_xor(v, o);
    return v;
}
__device__ __forceinline__ float bf2f(unsigned short b) { return __uint_as_float(((unsigned)b) << 16); }
struct XItem { const float* src; bf16* dst; int K, N; };
__device__ __forceinline__ void xitem_load(const XItem& it, f32x4 (&wv)[8], int lane) {
    const int lr = lane >> 3, lc = (lane & 7) * 4;
#pragma unroll
    for (int i = 0; i < 8; ++i) wv[i] = __builtin_nontemporal_load((const f32x4*)(it.src + (size_t)(16 * (i >> 1) + 2 * lr + (i & 1)) * it.N + lc));
}
__device__ __forceinline__ void xitem_finish(const XItem& it, const f32x4 (&wv)[8], LAS float* scr, int lane) {
    LAS unsigned* T = (LAS unsigned*)scr; const int lr = lane >> 3, lc = (lane & 7) * 4;
#pragma unroll
    for (int m = 0; m < 4; ++m) { const f32x4 a = wv[2 * m], b = wv[2 * m + 1]; const int kw = 8 * m + lr;
        T[(lc + 0) * 36 + kw] = pg8::cvt_pk_bf16(a.x, b.x); T[(lc + 1) * 36 + kw] = pg8::cvt_pk_bf16(a.y, b.y); T[(lc + 2) * 36 + kw] = pg8::cvt_pk_bf16(a.z, b.z); T[(lc + 3) * 36 + kw] = pg8::cvt_pk_bf16(a.w, b.w); }
    LDS_WAIT(); asm volatile("" ::: "memory");
    const int kq = lane & 7;
#pragma unroll
    for (int j = 0; j < 4; ++j) { const int n = (lane >> 3) + 8 * j; const v4u o = *(const LAS v4u*)(T + n * 36 + kq * 4);
        __builtin_nontemporal_store(o, (GAS v4u*)(it.dst + (size_t)n * it.K + 8 * kq)); }
    LDS_WAIT(); asm volatile("" ::: "memory");
}
__device__ __forceinline__ int t5_bucket_dev(int rel) {
    const int n = rel < 0 ? -rel : rel; int b;
    if (n < 8) b = n; else b = 8 + (n >= 15) + (n >= 27) + (n >= 50) + (n >= 91) + (n >= 166) + (n >= 305) + (n >= 559);
    return (rel > 0 ? 16 : 0) + b;
}

#ifndef PH_MASK
#define PH_MASK 0xFFF
#endif
#define ON(k) (((PH_MASK) >> (k)) & 1)
#define QKVH(head, row) (QKV + ((size_t)(head) * M + (size_t)(row)) * HDIM)
constexpr int I_IN = (DM / 64) * (NQKV / 32), I_OUT = (DM / 64) * (DM / 32), I_1 = (DM / 64) * (DFF / 32), I_2 = (DFF / 64) * (DM / 32), I_LAYER = I_IN + I_OUT + I_1 + I_2;
#ifndef CONV_IN_QUEUE
#define CONV_IN_QUEUE 1
#endif
constexpr int NCONV = 128, CONV_ITEMS = I_LAYER / NCONV;
static_assert(I_LAYER % NCONV == 0 && CONV_ITEMS % 16 == 0 && (I_LAYER - I_IN) % NCONV == 0 && ((I_LAYER - I_IN) / NCONV) % 16 == 0, "conversion chunking: whole chunks, an even item count per wave");
__device__ __forceinline__ XItem conv_item(int l, int r, const float* w_in, const float* w_out, const float* w_mlp_in, const float* w_mlp_out, bf16* WIN, bf16* WOUT, bf16* W1, bf16* W2) {
    const float* W; bf16* WT; int K, N;
    if (r < I_IN) { W = w_in + (size_t)l * DM * NQKV; WT = WIN + (size_t)l * NQKV * DM; K = DM; N = NQKV; }
    else if (r < I_IN + I_OUT) { r -= I_IN; W = w_out + (size_t)l * DM * DM; WT = WOUT + (size_t)l * DM * DM; K = DM; N = DM; }
    else if (r < I_IN + I_OUT + I_1) { r -= I_IN + I_OUT; W = w_mlp_in + (size_t)l * DM * DFF; WT = W1 + (size_t)l * DFF * DM; K = DM; N = DFF; }
    else { r -= I_IN + I_OUT + I_1; W = w_mlp_out + (size_t)l * DFF * DM; WT = W2 + (size_t)l * DM * DFF; K = DFF; N = DM; }
    const int nblk = N / 32, k0 = 64 * (r / nblk), n0 = 32 * (r % nblk);
    XItem it; it.src = W + (size_t)k0 * N + n0; it.dst = WT + (size_t)n0 * K + k0; it.K = K; it.N = N; return it;
}
__device__ __forceinline__ XItem conv_qitem(int l, int q, const float* w_in, const float* w_out, const float* w_mlp_in, const float* w_mlp_out, bf16* WIN, bf16* WOUT, bf16* W1, bf16* W2) {
    return (q < I_LAYER - I_IN) ? conv_item(l, q + I_IN, w_in, w_out, w_mlp_in, w_mlp_out, WIN, WOUT, W1, W2) : conv_item(l + 1, q - (I_LAYER - I_IN), w_in, w_out, w_mlp_in, w_mlp_out, WIN, WOUT, W1, W2);
}
template <bool QMAP> __device__ __forceinline__ void conv_run_t(int l, int first, int step, int end, const float* w_in, const float* w_out, const float* w_mlp_in, const float* w_mlp_out, bf16* WIN, bf16* WOUT, bf16* W1, bf16* W2, LAS float* scr, int lane) {
#define CI_(r) (QMAP ? conv_qitem(l, (r), w_in, w_out, w_mlp_in, w_mlp_out, WIN, WOUT, W1, W2) : conv_item(l, (r), w_in, w_out, w_mlp_in, w_mlp_out, WIN, WOUT, W1, W2))
    if (first >= end) return;
    f32x4 wa[8], wb[8], wc[8], wd[8];
    if ((((end - first) + step - 1) / step) & 1) { const XItem s = CI_(first); xitem_load(s, wa, lane); xitem_finish(s, wa, scr, lane); first += step; if (first >= end) return; }
    XItem a = CI_(first), b = CI_(first + step);
    xitem_load(a, wa, lane); xitem_load(b, wb, lane);
    for (int r = first; r < end; r += 4 * step) {
        const bool more = r + 2 * step < end;
        XItem c = a, d = b; if (more) { c = CI_(r + 2 * step); d = CI_(r + 3 * step); xitem_load(c, wc, lane); xitem_load(d, wd, lane); }
        xitem_finish(a, wa, scr, lane); xitem_finish(b, wb, scr, lane);
        if (!more) break;
        const bool more2 = r + 4 * step < end;
        if (more2) { a = CI_(r + 4 * step); b = CI_(r + 5 * step); xitem_load(a, wa, lane); xitem_load(b, wb, lane); }
        xitem_finish(c, wc, scr, lane); xitem_finish(d, wd, scr, lane);
        if (!more2) break;
    }
#undef CI_
}
struct Args { const float* in[14]; float* out; unsigned char* ws; };

__device__ __forceinline__ f32x4 ld_row4(const void* base, size_t row, int idx, bool is_bf) {
    if (is_bf) { const unsigned long long w = ((const unsigned long long*)((const bf16*)base + row * DM))[idx]; const unsigned lo = (unsigned)w, hi = (unsigned)(w >> 32);
        return (f32x4){__uint_as_float(lo << 16), __uint_as_float(lo & 0xffff0000u), __uint_as_float(hi << 16), __uint_as_float(hi & 0xffff0000u)}; }
    return ((const f32x4*)((const float*)base + row * DM))[idx];
}
template <bool HAS_Y>
__device__ __forceinline__ void norm_phase(Frame& F, const void* xin, bool xin_bf, const bf16* y, void* xout, bool xout_bf, bf16* h, const float* Gv, const float* Av, const float* Bv, int bstride) {
    int tid_ = threadIdx.x; asm volatile("" : "+v"(tid_)); const int tid = tid_, lane = tid & 63, wave = __builtin_amdgcn_readfirstlane(tid >> 6);
    LAS f32x4* Gs = (LAS f32x4*)(F.lds); LAS f32x4* As = (LAS f32x4*)(F.lds + 16384); LAS f32x4* Bs = (LAS f32x4*)(F.lds + 32768);
    for (int chunk = blockIdx.x; chunk < M / 64; chunk += F.G) {
        const int b = chunk / (SEQ / 64);
        __syncthreads();
        for (int i = tid; i < 1024; i += NWAVES * 64) { if (HAS_Y) Gs[i] = ((const f32x4*)(Gv + (size_t)b * bstride))[i]; if (h) { As[i] = ((const f32x4*)(Av + (size_t)b * bstride))[i]; Bs[i] = ((const f32x4*)(Bv + (size_t)b * bstride))[i]; } }
        __syncthreads();
        for (int rr = wave; rr < 64; rr += NWAVES) {
            const size_t row = (size_t)chunk * 64 + rr;
            f32x4 xv[16];
            if (HAS_Y) {
                f32x4 yv[16]; float ss = 0.f;
#pragma unroll
                for (int j = 0; j < 16; ++j) yv[j] = ld_row4(y, row, lane + 64 * j, true);
#pragma unroll
                for (int j = 0; j < 16; ++j) xv[j] = ld_row4(xin, row, lane + 64 * j, xin_bf);
#pragma unroll
                for (int j = 0; j < 16; ++j) { asm volatile("" : "+v"(xv[j]));
                    ss += (yv[j].x * yv[j].x + yv[j].y * yv[j].y) + (yv[j].z * yv[j].z + yv[j].w * yv[j].w); }
                const float ry = 1.0f / sqrtf(wave_sum(ss) * (1.0f / DM) + EPS);
#pragma unroll
                for (int j = 0; j < 16; ++j) { const f32x4 g = Gs[lane + 64 * j]; xv[j] = xv[j] + g * (yv[j] * ry); }
                if (xout_bf) { unsigned long long* xo = (unsigned long long*)((bf16*)xout + row * DM) + lane;
#pragma unroll
                    for (int j = 0; j < 16; ++j) xo[64 * j] = (unsigned long long)pg8::cvt_pk_bf16(xv[j].x, xv[j].y) | ((unsigned long long)pg8::cvt_pk_bf16(xv[j].z, xv[j].w) << 32);
                } else { f32x4* xo = (f32x4*)((float*)xout + row * DM) + lane;
#pragma unroll
                    for (int j = 0; j < 16; ++j) xo[64 * j] = xv[j]; }
            } else {
#pragma unroll
                for (int j = 0; j < 16; ++j) xv[j] = ld_row4(xin, row, lane + 64 * j, xin_bf);
            }
            if (h) {
                float ss = 0.f;
#pragma unroll
                for (int j = 0; j < 16; ++j) ss += (xv[j].x * xv[j].x + xv[j].y * xv[j].y) + (xv[j].z * xv[j].z + xv[j].w * xv[j].w);
                const float rx = 1.0f / sqrtf(wave_sum(ss) * (1.0f / DM) + EPS);
                unsigned long long* ho = (unsigned long long*)(h + row * DM) + lane;
#pragma unroll
                for (int j = 0; j < 16; ++j) { const f32x4 a = As[lane + 64 * j], bb = Bs[lane + 64 * j]; const f32x4 v = a * (xv[j] * rx) + bb;
                    ho[64 * j] = (unsigned long long)pg8::cvt_pk_bf16(v.x, v.y) | ((unsigned long long)pg8::cvt_pk_bf16(v.z, v.w) << 32); }
            }
        }
    }
}

__device__ __forceinline__ void norm_phase_bf(Frame& F, const bf16* xin, const bf16* y, void* xout, bool xout_bf, bf16* h, const float* Gv, const float* Av, const float* Bv, int bstride) {
    int tid_ = threadIdx.x; asm volatile("" : "+v"(tid_)); const int tid = tid_, lane = tid & 63, wave = __builtin_amdgcn_readfirstlane(tid >> 6);
    LAS f32x4* Gs = (LAS f32x4*)(F.lds); LAS f32x4* As = (LAS f32x4*)(F.lds + 16384); LAS f32x4* Bs = (LAS f32x4*)(F.lds + 32768);
    typedef unsigned long long u64;
#define NB_CVT(W) ((f32x4){__uint_as_float((unsigned)(W) << 16), __uint_as_float((unsigned)(W) & 0xffff0000u), __uint_as_float((unsigned)((W) >> 32) << 16), __uint_as_float((unsigned)((W) >> 32) & 0xffff0000u)})
#define NB_LOAD(YR, XR, ROW) do { _Pragma("unroll") for (int j = 0; j < 16; ++j) { YR[j] = ((const u64*)(y + (ROW) * DM))[lane + 64 * j]; XR[j] = ((const u64*)(xin + (ROW) * DM))[lane + 64 * j]; } } while (0)
#define NB_PIN(YR, XR) do { _Pragma("unroll") for (int j = 0; j < 16; ++j) { asm volatile("" : "+v"(YR[j])); asm volatile("" : "+v"(XR[j])); } } while (0)
#define NB_ROW(YR, XR, ROW) do { int lq = lane; asm volatile("" : "+v"(lq)); float ss = 0.f; f32x4 xv[16]; \
        _Pragma("unroll") for (int j = 0; j < 16; ++j) { const f32x4 yv = NB_CVT(YR[j]); ss += (yv.x * yv.x + yv.y * yv.y) + (yv.z * yv.z + yv.w * yv.w); } \
        const float ry = 1.0f / sqrtf(wave_sum(ss) * (1.0f / DM) + EPS); \
        _Pragma("unroll") for (int j = 0; j < 16; ++j) { const f32x4 g = Gs[lq + 64 * j]; xv[j] = NB_CVT(XR[j]) + g * (NB_CVT(YR[j]) * ry); } \
        if (xout_bf) { u64* xo = (u64*)((bf16*)xout + (ROW) * DM) + lane; \
            _Pragma("unroll") for (int j = 0; j < 16; ++j) xo[64 * j] = (u64)pg8::cvt_pk_bf16(xv[j].x, xv[j].y) | ((u64)pg8::cvt_pk_bf16(xv[j].z, xv[j].w) << 32); \
        } else { f32x4* xo = (f32x4*)((float*)xout + (ROW) * DM) + lane; \
            _Pragma("unroll") for (int j = 0; j < 16; ++j) xo[64 * j] = xv[j]; } \
        if (h) { float s2 = 0.f; \
            _Pragma("unroll") for (int j = 0; j < 16; ++j) s2 += (xv[j].x * xv[j].x + xv[j].y * xv[j].y) + (xv[j].z * xv[j].z + xv[j].w * xv[j].w); \
            const float rx = 1.0f / sqrtf(wave_sum(s2) * (1.0f / DM) + EPS); \
            u64* ho = (u64*)(h + (ROW) * DM) + lane; \
            _Pragma("unroll") for (int j = 0; j < 16; ++j) { const f32x4 a = As[lq + 64 * j], bb = Bs[lq + 64 * j]; const f32x4 v = a * (xv[j] * rx) + bb; \
                ho[64 * j] = (u64)pg8::cvt_pk_bf16(v.x, v.y) | ((u64)pg8::cvt_pk_bf16(v.z, v.w) << 32); } } } while (0)
    for (int chunk = blockIdx.x; chunk < M / 64; chunk += F.G) {
        const int b = chunk / (SEQ / 64);
        const size_t row0 = (size_t)chunk * 64 + wave;
        u64 yA[16], xA[16], yB[16], xB[16];
        NB_LOAD(yA, xA, row0);
        __syncthreads();
        for (int i = tid; i < 1024; i += NWAVES * 64) { Gs[i] = ((const f32x4*)(Gv + (size_t)b * bstride))[i]; if (h) { As[i] = ((const f32x4*)(Av + (size_t)b * bstride))[i]; Bs[i] = ((const f32x4*)(Bv + (size_t)b * bstride))[i]; } }
        __syncthreads();
#pragma unroll 1
        for (int it = 0; it < 4; ++it) {
            const size_t ra = row0 + 16 * it, rb = ra + 8;
            NB_LOAD(yB, xB, rb); NB_PIN(yA, xA);
            NB_ROW(yA, xA, ra);
            if (it < 3) { NB_LOAD(yA, xA, rb + 8); }
            NB_PIN(yB, xB);
            NB_ROW(yB, xB, rb);
        }
    }
#undef NB_CVT
#undef NB_LOAD
#undef NB_PIN
#undef NB_ROW
}

typedef __attribute__((address_space(4))) const unsigned char ckb_t;
__device__ __forceinline__ const void* karg(int i) { ckb_t* kp = (ckb_t*)__builtin_amdgcn_kernarg_segment_ptr(); asm volatile("" : "+s"(kp)); return *(const void* const __attribute__((address_space(4)))*)(kp + 8 * i); }
#define KIN(i) ((const float*)karg(i))
#define KOUT() ((float*)karg(14))
#define KWS() ((unsigned char*)karg(15))
__global__ void __launch_bounds__(NWAVES * 64, 2) mega_fwd(Args args_unused) {
    extern __shared__ __attribute__((aligned(16))) unsigned char lds[];
    Frame F;
    F.lds = (LAS unsigned char*)lds; F.MISC = (volatile LAS unsigned*)(F.lds + MISC_OFF); F.G = gridDim.x;
    for (int u = threadIdx.x; u < (LDS_BYTES - LDSCTL_OFF) / 4; u += NWAVES * 64) ((LAS unsigned*)(F.lds + LDSCTL_OFF))[u] = 0u;
    __syncthreads();
    (void)xcd_barrier_post((unsigned*)((gu32*)(KWS() + WS_CTL) + CW_BAR), F.MISC + 8);
#define GRID_BAR() do { XcdBarrier bar_; bar_.bar = (unsigned*)((gu32*)(KWS() + WS_CTL) + CW_BAR); bar_.x = xb_xcc_id(); bar_.st = (volatile LAS unsigned*)(F.lds + MISC_OFF) + 8; xcd_barrier(bar_); } while (0)
#define FRESH_IDS() int tid_ = threadIdx.x; asm volatile("" : "+v"(tid_)); const int ftid = tid_, flane = ftid & 63, fwave = __builtin_amdgcn_readfirstlane(ftid >> 6); \
    const int gw = blockIdx.x * NWAVES + fwave, NGW = F.G * NWAVES, gtid = blockIdx.x * (NWAVES * 64) + ftid, NGT = F.G * NWAVES * 64; (void)flane; (void)gw; (void)NGW; (void)gtid; (void)NGT
#define WSP(T, off) ((T*)(ws + (off)))
#ifndef DUP_GEMM
#define DUP_GEMM 0
#endif
#ifndef XBF16
#define XBF16 1
#endif
#ifndef DUP_NORM
#define DUP_NORM 0
#endif
#ifndef DUP_P0C
#define DUP_P0C 0
#endif
#ifndef XBAR
#define XBAR 0
#endif
#ifndef DUP_G0
#define DUP_G0 0
#endif
#ifndef DUP_G1
#define DUP_G1 0
#endif
#ifndef DUP_G2
#define DUP_G2 0
#endif
#ifndef DUP_G3
#define DUP_G3 0
#endif
#ifndef DUP_NA
#define DUP_NA 0
#endif
#ifndef DUP_DIL
#define DUP_DIL 0
#endif
#ifndef DUP_GQA
#define DUP_GQA 0
#endif
#ifndef DUP_ATT
#define DUP_ATT 0
#endif
#ifndef DUP_P0A
#define DUP_P0A 0
#endif
#ifndef DUPBAR
#define DUPBAR 0
#endif
#define REPBAR() do { if (DUPBAR && rep_ > 0) GRID_BAR(); } while (0)
#define REPEAT(n) for (int rep_ = 0, nrep_ = __builtin_amdgcn_readfirstlane(1 + (n)); rep_ < nrep_; ++rep_)

    if (ON(0)) REPEAT(DUP_P0A)
    {
        FRESH_IDS(); unsigned char* ws = KWS(); const float* in_c = KIN(1); const float* ada_w = KIN(2); float* MODP = WSP(float, WS_MODP);
        for (int task = gw; task < 96 * 16; task += NGW) {
            const int cg = task % 96, kc = task / 96; const int col = cg * 256 + flane * 4;
            f32x4 a0 = {0.f, 0.f, 0.f, 0.f}, a1 = {0.f, 0.f, 0.f, 0.f};
            const float* wp = ada_w + (size_t)(kc * 256) * (NMOD * DM) + col;
#pragma unroll 8
            for (int k = 0; k < 256; ++k) {
                const f32x4 w = *(const f32x4*)(wp + (size_t)k * (NMOD * DM));
                const float c0 = in_c[kc * 256 + k], c1 = in_c[DM + kc * 256 + k];
                const float s0 = c0 / (1.0f + __expf(-c0)), s1 = c1 / (1.0f + __expf(-c1));
                a0 = a0 + w * s0; a1 = a1 + w * s1;
            }
            *(f32x4*)(MODP + ((size_t)(kc * 2 + 0) * (NMOD * DM)) + col) = a0;
            *(f32x4*)(MODP + ((size_t)(kc * 2 + 1) * (NMOD * DM)) + col) = a1;
        }
        LAS float* scr = (LAS float*)(F.lds + RING_OFF + fwave * 16384);
        const float* w_in = KIN(6); const float* w_out = KIN(7); const float* w_mlp_in = KIN(12); const float* w_mlp_out = KIN(13);
        bf16* WIN = WSP(bf16, WS_WIN); bf16* WOUT = WSP(bf16, WS_WOUT); bf16* W1 = WSP(bf16, WS_W1); bf16* W2 = WSP(bf16, WS_W2);
        if (CONV_IN_QUEUE) conv_run_t<false>(0, gw, NGW, I_IN, w_in, w_out, w_mlp_in, w_mlp_out, WIN, WOUT, W1, W2, scr, flane);
        else for (int cl_ = 0; cl_ < DEPTH; ++cl_) conv_run_t<false>(cl_, gw, NGW, I_LAYER, w_in, w_out, w_mlp_in, w_mlp_out, WIN, WOUT, W1, W2, scr, flane);
    }
    GRID_BAR();
    if (ON(1))
    {
        FRESH_IDS(); unsigned char* ws = KWS(); const float* ada_b = KIN(3); const float* ada_emb = KIN(4); const float* gains = KIN(5); const float* t5_table = KIN(11);
        float* MODP = WSP(float, WS_MODP); float* MODV = WSP(float, WS_MODV); float* ROPE = WSP(float, WS_ROPE); float* DILTB = WSP(float, WS_DILTB);
        for (int i = gtid; i < DEPTH * 2 * NMOD * DM; i += NGT) {
            const int col = i % DM, j = (i / DM) % NMOD, b = (i / (DM * NMOD)) % 2, l = i / (DM * NMOD * 2);
            float m = ada_b[j * DM + col];
#pragma unroll
            for (int kc = 0; kc < 16; ++kc) m += MODP[(size_t)(kc * 2 + b) * (NMOD * DM) + j * DM + col];
            m += ada_emb[((size_t)l * NMOD + j) * DM + col];
            const float* gl = gains + (size_t)l * 4 * DM;
            float v;
            if (j == 0) v = m; else if (j == 1) v = gl[0 * DM + col] * (1.0f + m); else if (j == 2) v = m * gl[1 * DM + col];
            else if (j == 3) v = m; else if (j == 4) v = gl[2 * DM + col] * (1.0f + m); else v = m * gl[3 * DM + col];
            MODV[i] = v;
        }
        if (blockIdx.x == 0 && ftid < 32) {
            const int f = ftid; const double th = (double)__builtin_amdgcn_exp2f(-(float)f * 0.41524101186092029f);
            double c1 = 1.0, s1 = th, tc = 1.0, ts = th; const double x2 = th * th;
            for (int n = 1; n <= 12; ++n) { tc *= -x2 / (double)((2 * n - 1) * (2 * n)); ts *= -x2 / (double)((2 * n) * (2 * n + 1)); c1 += tc; s1 += ts; }
            double c = 1.0, s = 0.0;
            for (int pos = 0; pos < 128; ++pos) { ROPE[pos * 32 + f] = (float)c; ROPE[4096 + pos * 32 + f] = (float)s; const double cn = c * c1 - s * s1; s = s * c1 + c * s1; c = cn; }
        }
        if (blockIdx.x == 1 || F.G == 1) {
            for (int i = ftid; i < 3 * H_DIL * 129; i += NWAVES * 64) { const int p = i / (H_DIL * 129), hh = (i / 129) % H_DIL, jj = i % 129 - 64; const int d = p == 0 ? 1 : (p == 1 ? 4 : 16);
                DILTB[i] = t5_table[t5_bucket_dev(jj * d) * H_DIL + hh]; }
        }
    }
    GRID_BAR();
    if (ON(2))
    REPEAT(DUP_P0C) { unsigned char* ws = KWS(); float* MODV = WSP(float, WS_MODV);
      norm_phase<false>(F, KIN(0), false, nullptr, nullptr, false, WSP(bf16, WS_H), nullptr, MODV + 1 * DM, MODV + 0 * DM, NMOD * DM); }
    GRID_BAR();

    for (int l = 0; l < DEPTH; ++l) {
        for (int xb_ = 0; xb_ < XBAR; ++xb_) GRID_BAR();
    if (ON(3)) REPEAT(DUP_GEMM + DUP_G0)
        {
            REPBAR();
            unsigned char* ws = KWS();
            pg8::Gemm g{WSP(bf16, WS_H), WSP(bf16, WS_WIN) + (size_t)l * NQKV * DM, M, NQKV, DM}; pg8::StaticOrder S; S.init(M, NQKV, F.G, (int)blockIdx.x);
            pg8::EpiQKV E{WSP(bf16, WS_QKV), M};
            pg8::gemm_phase<pg8::EpiQKV, pg8::StaticOrder, true, true>(F.lds + RING_OFF, g, S, E);
        }
        GRID_BAR();
    if (ON(4))
        {
            FRESH_IDS(); const int i16 = ftid & 15; const int g16 = gtid >> 4, NG16 = NGT >> 4;
            unsigned char* ws = KWS(); bf16* QKV = WSP(bf16, WS_QKV); const float* ROPE = WSP(float, WS_ROPE); const float* q_gain = KIN(8); const float* k_gain = KIN(9);
            for (int task = g16; task < KV_GQA * (M / 8); task += NG16) {
                const int hh = task >> 11, row0 = (task & (M / 8 - 1)) * 8;
                const int head = K_GQA / HDIM + hh;
                const float* gp = k_gain + l * HDIM + 8 * i16;
                bf16* p = QKVH(head, row0) + 8 * i16;
                const int jj = i16 & 7, fb = 8 * (jj & 3);
                v4u raw[8]; f32x4 c0[8], c1[8], s0[8], s1[8];
#pragma unroll
                for (int k = 0; k < 8; ++k) raw[k] = *(const v4u*)(p + (size_t)k * HDIM);
                const f32x4 g0 = *(const f32x4*)gp, g1 = *(const f32x4*)(gp + 4);
#pragma unroll
                for (int k = 0; k < 8; ++k) { const int t = (row0 + k) & (SEQ - 1); const int pos = (i16 < 8) ? (t >> 6) : (t & 63); const float* rp = ROPE + pos * 32 + fb;
                    c0[k] = *(const f32x4*)rp; c1[k] = *(const f32x4*)(rp + 4); s0[k] = *(const f32x4*)(rp + 4096); s1[k] = *(const f32x4*)(rp + 4100); }
#pragma unroll
                for (int k = 0; k < 8; ++k) {
                    float x[8];
                    x[0] = __uint_as_float(raw[k].x << 16); x[1] = __uint_as_float(raw[k].x & 0xffff0000u); x[2] = __uint_as_float(raw[k].y << 16); x[3] = __uint_as_float(raw[k].y & 0xffff0000u);
                    x[4] = __uint_as_float(raw[k].z << 16); x[5] = __uint_as_float(raw[k].z & 0xffff0000u); x[6] = __uint_as_float(raw[k].w << 16); x[7] = __uint_as_float(raw[k].w & 0xffff0000u);
                    float ss = 0.f;
#pragma unroll
                    for (int e = 0; e < 8; ++e) ss += x[e] * x[e];
                    ss += __shfl_xor(ss, 1); ss += __shfl_xor(ss, 2); ss += __shfl_xor(ss, 4); ss += __shfl_xor(ss, 8);
                    const float rstd = 1.0f / sqrtf(ss * (1.0f / HDIM) + EPS);
                    x[0] *= rstd * g0.x; x[1] *= rstd * g0.y; x[2] *= rstd * g0.z; x[3] *= rstd * g0.w; x[4] *= rstd * g1.x; x[5] *= rstd * g1.y; x[6] *= rstd * g1.z; x[7] *= rstd * g1.w;
                    const float cs[8] = {c0[k].x, c0[k].y, c0[k].z, c0[k].w, c1[k].x, c1[k].y, c1[k].z, c1[k].w}; const float sn[8] = {s0[k].x, s0[k].y, s0[k].z, s0[k].w, s1[k].x, s1[k].y, s1[k].z, s1[k].w};
                    float o[8];
#pragma unroll
                    for (int e = 0; e < 8; ++e) { const float pv = __shfl_xor(x[e], 4); o[e] = (jj < 4) ? (x[e] * cs[e] - pv * sn[e]) : (pv * sn[e] + x[e] * cs[e]); }
                    v4u w; w.x = pg8::cvt_pk_bf16(o[0], o[1]); w.y = pg8::cvt_pk_bf16(o[2], o[3]); w.z = pg8::cvt_pk_bf16(o[4], o[5]); w.w = pg8::cvt_pk_bf16(o[6], o[7]);
                    *(v4u*)(p + (size_t)k * HDIM) = w;
                }
            }
        }
    if (ON(5))
        {
            char* alds = (char*)lds + RING_OFF;
            (void)alds;
        }
        GRID_BAR();
    if (ON(5)) REPEAT(DUP_ATT)
        {
            char* alds = (char*)lds + RING_OFF;
            { unsigned char* ws = KWS(); bf16* QKV = WSP(bf16, WS_QKV); bf16* O = WSP(bf16, WS_O); const float* na_rpb = KIN(10);
              bf16* DILP = WSP(bf16, WS_DILP); float* DILST = WSP(float, WS_DILST); const float* DILTB = WSP(float, WS_DILTB);
              gu32* qhead = (gu32*)(ws + WS_CTL) + CW_QUEUE + 64 * l; volatile LAS unsigned* qslot = (volatile LAS unsigned*)(F.lds + MISC_OFF) + 16;
              const int nconv = CONV_IN_QUEUE ? NCONV : 0;
              bool gqa_fast;
              { int tid_ = threadIdx.x; asm volatile("" : "+v"(tid_)); const int gl = tid_ & 63; const float* qgp = KIN(8) + l * HDIM; const float* kgp = KIN(9) + l * HDIM;
                float qa = fmaxf(fabsf(qgp[gl]), fabsf(qgp[gl + 64])), ka = fmaxf(fabsf(kgp[gl]), fabsf(kgp[gl + 64]));
#pragma unroll
                for (int o_ = 1; o_ < 64; o_ <<= 1) { qa = fmaxf(qa, __shfl_xor(qa, o_)); ka = fmaxf(ka, __shfl_xor(ka, o_)); }
                const float bound = 128.0f * att::C2 * 1.02f * qa * ka;
                gqa_fast = __builtin_amdgcn_readfirstlane((int)(bound <= 64.0f)) != 0; }
              unsigned nx_ = 0u; if (threadIdx.x == 0) nx_ = __hip_atomic_fetch_add(qhead, 1u, RLX_AGENT);
              for (int guard_ = 0; guard_ < 4096; ++guard_) {
                __syncthreads();
                if (threadIdx.x == 0) qslot[0] = nx_;
                __syncthreads();
                const int uq = (int)__builtin_amdgcn_readfirstlane(qslot[0]);
                if (uq >= 768 + nconv + 2816) break;
                if (threadIdx.x == 0) nx_ = __hip_atomic_fetch_add(qhead, 1u, RLX_AGENT);
                int u;
                if (uq < 768 + nconv) {
                    if (nconv && uq % 7 == 6) {
                        int tid_ = threadIdx.x; asm volatile("" : "+v"(tid_)); const int cl = tid_ & 63, cw = __builtin_amdgcn_readfirstlane(tid_ >> 6);
                        LAS float* scr = (LAS float*)(F.lds + RING_OFF + cw * 16384); const int citems = (l + 1 < DEPTH) ? CONV_ITEMS : (I_LAYER - I_IN) / NCONV, c0 = (uq / 7) * citems;
                        const float* w_in = KIN(6); const float* w_out = KIN(7); const float* w_mlp_in = KIN(12); const float* w_mlp_out = KIN(13);
                        conv_run_t<true>(l, c0 + cw, NWAVES, c0 + citems, w_in, w_out, w_mlp_in, w_mlp_out, WSP(bf16, WS_WIN), WSP(bf16, WS_WOUT), WSP(bf16, WS_W1), WSP(bf16, WS_W2), scr, cl);
                        continue;
                    }
                    u = nconv ? uq - uq / 7 : uq;
                } else u = uq - nconv;
                if (u < 768) {
                    const int grp = u / 96, within = u % 96; const int b = grp >> 2, kvh = grp & 3, hq = kvh * 3 + within / 32, qb = within % 32;
                    const size_t r0 = (size_t)b * SEQ + (size_t)qb * 256;
                    if (gqa_fast) att::attn_unit<0, true>(QKVH(Q_GQA / HDIM + hq, r0), HDIM, QKVH(K_GQA / HDIM + kvh, (size_t)b * SEQ), QKVH(V_GQA / HDIM + kvh, (size_t)b * SEQ), HDIM,
                                      0, SEQ / 64, SEQ / 64, O + r0 * DM + O_GQA + hq * HDIM, DM, nullptr, 0, 0, nullptr, 0, alds, KIN(8) + l * HDIM, WSP(float, WS_ROPE), qb * 256);
                    else att::attn_unit<0, false>(QKVH(Q_GQA / HDIM + hq, r0), HDIM, QKVH(K_GQA / HDIM + kvh, (size_t)b * SEQ), QKVH(V_GQA / HDIM + kvh, (size_t)b * SEQ), HDIM,
                                      0, SEQ / 64, SEQ / 64, O + r0 * DM + O_GQA + hq * HDIM, DM, nullptr, 0, 0, nullptr, 0, alds, KIN(8) + l * HDIM, WSP(float, WS_ROPE), qb * 256);
                    continue;
                }
                if (u < 768 + 512) {
                    const int un = u - 768; const int b = un >> 8, hh = (un >> 5) & 7, qb = un & 31; const size_t r0 = (size_t)b * SEQ + (size_t)qb * 256;
                    att::attn_unit<1>(QKVH(Q_NA / HDIM + hh, r0), HDIM, QKVH(K_NA / HDIM + hh, (size_t)b * SEQ), QKVH(V_NA / HDIM + hh, (size_t)b * SEQ), HDIM,
                                      qb * 4 - 4, 12, SEQ / 64, O + r0 * DM + O_NA + hh * HDIM, DM, nullptr, 0, qb * 4, na_rpb + ((size_t)l * H_NA + hh) * 465, 465, alds);
                } else {
                    const int v = u - 768 - 512, p = v / 768, w = v % 768, pair = w >> 5, b = pair / H_DIL, hh = pair % H_DIL, blk = w & 31;
                    const int d = p == 0 ? 1 : (p == 1 ? 4 : 16), nub = 32 / d, res = blk / nub, ub = blk % nub, u0 = ub * 256, L = SEQ / d;
                    const size_t rq = (size_t)b * SEQ + (size_t)u0 * d + res, rk = (size_t)b * SEQ + res;
                    att::attn_unit<2>(QKVH(Q_DIL / HDIM + hh, rq), (long)d * HDIM, QKVH(K_DIL / HDIM + hh, rk), QKVH(V_DIL / HDIM + hh, rk), (long)d * HDIM,
                                      u0 / 64 - 1, 6, L / 64, DILP + (size_t)p * M * DILW + rq * DILW + hh * HDIM, (long)d * DILW,
                                      DILST + (((size_t)p * M + rq) * H_DIL + hh) * 2, (long)d * H_DIL * 2, u0, DILTB + (p * H_DIL + hh) * 129, 129, alds);
                }
              } }
        }
        GRID_BAR();
    if (ON(6))
        {
            FRESH_IDS(); const int i16 = ftid & 15; const int g16 = gtid >> 4, NG16 = NGT >> 4;
            unsigned char* ws = KWS(); bf16* O = WSP(bf16, WS_O); const bf16* DILP = WSP(bf16, WS_DILP); const float* DILST = WSP(float, WS_DILST);
            typedef float f32x2v __attribute__((ext_vector_type(2)));
            for (int task0 = g16; task0 < M * H_DIL; task0 += 8 * NG16) {
                f32x2v st[8][3]; v4u raw[8][3];
#pragma unroll
                for (int k = 0; k < 8; ++k) { const int task = task0 + k * NG16; const bool on = task < M * H_DIL; const int tt = on ? task : task0; const int row = tt / H_DIL, hh = tt % H_DIL;
#pragma unroll
                    for (int p = 0; p < 3; ++p) { st[k][p] = *(const f32x2v*)(DILST + (((size_t)p * M + row) * H_DIL + hh) * 2); raw[k][p] = *(const v4u*)(DILP + (size_t)p * M * DILW + (size_t)row * DILW + hh * HDIM + 8 * i16); } }
#pragma unroll
                for (int k = 0; k < 8; ++k) { const int task = task0 + k * NG16; if (task < M * H_DIL) { const int row = task / H_DIL, hh = task % H_DIL;
                    const float mx = fmaxf(st[k][0].x, fmaxf(st[k][1].x, st[k][2].x));
                    float wv[3]; float wsum = 0.f;
#pragma unroll
                    for (int p = 0; p < 3; ++p) { wv[p] = st[k][p].y * __builtin_amdgcn_exp2f(st[k][p].x - mx); wsum += wv[p]; }
                    const float inv = 1.0f / wsum;
                    float acc[8] = {0.f, 0.f, 0.f, 0.f, 0.f, 0.f, 0.f, 0.f};
#pragma unroll
                    for (int p = 0; p < 3; ++p) { const v4u r = raw[k][p]; const float wp = wv[p] * inv;
                        acc[0] += wp * __uint_as_float(r.x << 16); acc[1] += wp * __uint_as_float(r.x & 0xffff0000u); acc[2] += wp * __uint_as_float(r.y << 16); acc[3] += wp * __uint_as_float(r.y & 0xffff0000u);
                        acc[4] += wp * __uint_as_float(r.z << 16); acc[5] += wp * __uint_as_float(r.z & 0xffff0000u); acc[6] += wp * __uint_as_float(r.w << 16); acc[7] += wp * __uint_as_float(r.w & 0xffff0000u); }
                    v4u w; w.x = pg8::cvt_pk_bf16(acc[0], acc[1]); w.y = pg8::cvt_pk_bf16(acc[2], acc[3]); w.z = pg8::cvt_pk_bf16(acc[4], acc[5]); w.w = pg8::cvt_pk_bf16(acc[6], acc[7]);
                    *(v4u*)(O + (size_t)row * DM + O_DIL + hh * HDIM + 8 * i16) = w; } }
            }
        }
        GRID_BAR();
    if (ON(7)) REPEAT(DUP_GEMM + DUP_G1)
        {
            REPBAR();
            unsigned char* ws = KWS();
            pg8::Gemm g{WSP(bf16, WS_O), WSP(bf16, WS_WOUT) + (size_t)l * DM * DM, M, DM, DM}; pg8::StaticOrder S; S.init(M, DM, F.G, (int)blockIdx.x);
            pg8::EpiBf16<0> E{WSP(bf16, WS_Y), DM};
            pg8::gemm_phase<pg8::EpiBf16<0>, pg8::StaticOrder, true, true>(F.lds + RING_OFF, g, S, E);
        }
        GRID_BAR();
    if (ON(8))
        { unsigned char* ws = KWS(); const float* mv = WSP(float, WS_MODV) + (size_t)l * 2 * NMOD * DM;
#if DUP_NORM
          norm_phase<true>(F, l == 0 ? (const void*)KIN(0) : (const void*)KOUT(), false, WSP(bf16, WS_Y), WSP(float, WS_U), false, WSP(bf16, WS_U + 256 * MiB), mv + 2 * DM, mv + 4 * DM, mv + 3 * DM, NMOD * DM);
#endif
#if XBF16
          if (l == 0) norm_phase<true>(F, (const void*)KIN(0), false, WSP(bf16, WS_Y), WSP(bf16, WS_XB), true, WSP(bf16, WS_H), mv + 2 * DM, mv + 4 * DM, mv + 3 * DM, NMOD * DM);
          else norm_phase_bf(F, WSP(bf16, WS_XB), WSP(bf16, WS_Y), WSP(bf16, WS_XB), true, WSP(bf16, WS_H), mv + 2 * DM, mv + 4 * DM, mv + 3 * DM, NMOD * DM); }
#else
          norm_phase<true>(F, l == 0 ? (const void*)KIN(0) : (const void*)KOUT(), false, WSP(bf16, WS_Y), KOUT(), false, WSP(bf16, WS_H), mv + 2 * DM, mv + 4 * DM, mv + 3 * DM, NMOD * DM); }
#endif
        GRID_BAR();
    if (ON(9)) REPEAT(DUP_GEMM + DUP_G2)
        {
            REPBAR();
            unsigned char* ws = KWS();
            pg8::Gemm g{WSP(bf16, WS_H), WSP(bf16, WS_W1) + (size_t)l * DFF * DM, M, DFF, DM}; pg8::StaticOrder S; S.init(M, DFF, F.G, (int)blockIdx.x);
            pg8::EpiBf16<3> E{WSP(bf16, WS_U), DFF};
            pg8::gemm_phase<pg8::EpiBf16<3>, pg8::StaticOrder, true, true>(F.lds + RING_OFF, g, S, E);
        }
        GRID_BAR();
    if (ON(10)) REPEAT(DUP_GEMM + DUP_G3)
        {
            REPBAR();
            unsigned char* ws = KWS();
            pg8::Gemm g{WSP(bf16, WS_U), WSP(bf16, WS_W2) + (size_t)l * DM * DFF, M, DM, DFF}; pg8::StaticOrder S; S.init(M, DM, F.G, (int)blockIdx.x);
            pg8::EpiBf16<0> E{WSP(bf16, WS_Y), DM};
            pg8::gemm_phase<pg8::EpiBf16<0>, pg8::StaticOrder, true, true>(F.lds + RING_OFF, g, S, E);
        }
        GRID_BAR();
    if (ON(11))
        {
            unsigned char* ws = KWS(); const float* mv = WSP(float, WS_MODV) + (size_t)l * 2 * NMOD * DM; float* out = KOUT();
            const float* mvn = WSP(float, WS_MODV) + (size_t)(l + 1 < DEPTH ? l + 1 : l) * 2 * NMOD * DM;
#if XBF16
            norm_phase_bf(F, WSP(bf16, WS_XB), WSP(bf16, WS_Y), (l + 1 < DEPTH) ? (void*)WSP(bf16, WS_XB) : (void*)out, l + 1 < DEPTH, (l + 1 < DEPTH) ? WSP(bf16, WS_H) : (bf16*)nullptr, mv + 5 * DM, mvn + 1 * DM, mvn + 0 * DM, NMOD * DM);
#else
            norm_phase<true>(F, out, false, WSP(bf16, WS_Y), out, false, (l + 1 < DEPTH) ? WSP(bf16, WS_H) : (bf16*)nullptr, mv + 5 * DM, mvn + 1 * DM, mvn + 0 * DM, NMOD * DM);
#endif
        }
        if (l + 1 < DEPTH) GRID_BAR();
    }
    __syncthreads();
    if (__hip_atomic_load((gu32*)(KWS() + WS_CTL) + CW_BAR + XB_TMO, RLX_AGENT) != 0u) {
        const float q = __builtin_nanf(""); float* out = KOUT();
        for (int chunk = blockIdx.x; chunk < M / 64; chunk += F.G) for (int i = threadIdx.x; i < 64 * DM / 4; i += NWAVES * 64) ((f32x4*)(out + (size_t)chunk * 64 * DM))[i] = (f32x4){q, q, q, q};
    }
}

extern "C" void kernel_launch(void* const* d_in, const int* in_sizes, int n_in, void* d_out, int out_size, void* d_ws, size_t ws_size, hipStream_t stream) {
    static int grid = 0;
    if (grid == 0) {
        if (n_in != 14 || in_sizes[0] != M * DM || out_size != M * DM || ws_size < WS_END) { fprintf(stderr, "kernel_launch: shape/workspace mismatch (n_in %d, in0 %d, out %d, ws %zu, need %zu)\n", n_in, n_in > 0 ? in_sizes[0] : -1, out_size, ws_size, (size_t)WS_END); grid = -1; return; }
        int dev = 0, cus = 0, per_cu = 0;
        if (hipGetDevice(&dev) != hipSuccess || hipDeviceGetAttribute(&cus, hipDeviceAttributeMultiprocessorCount, dev) != hipSuccess) { grid = -1; return; }
        if (hipFuncSetAttribute((const void*)mega_fwd, hipFuncAttributeMaxDynamicSharedMemorySize, LDS_BYTES) != hipSuccess) { fprintf(stderr, "kernel_launch: hipFuncSetAttribute failed\n"); grid = -1; return; }
        if (hipOccupancyMaxActiveBlocksPerMultiprocessor(&per_cu, (const void*)mega_fwd, NWAVES * 64, LDS_BYTES) != hipSuccess || per_cu < 1) { fprintf(stderr, "kernel_launch: occupancy query reports %d blocks per CU\n", per_cu); }
        (void)hipGetLastError();
        grid = cus;
    }
    if (grid < 0) return;
    if (hipMemsetAsync((char*)d_ws + WS_CTL, 0, CTL_ZERO_BYTES, stream) != hipSuccess) return;
    Args a{};
    for (int i = 0; i < 14; ++i) a.in[i] = (const float*)d_in[i];
    a.out = (float*)d_out; a.ws = (unsigned char*)d_ws;
    hipLaunchKernelGGL(mega_fwd, dim3(grid), dim3(NWAVES * 64), LDS_BYTES, stream, a);
    const hipError_t le = hipPeekAtLastError();
    if (le != hipSuccess) fprintf(stderr, "kernel_launch: launch failed: %s\n", hipGetErrorName(le));
}
```

```cpp
#include <hip/hip_runtime.h>
#include <cstdio>
#include <cstdint>
namespace pg8 {
#define PG8_LAS __attribute__((address_space(3)))
typedef unsigned short bf16_t;
typedef short bf16x8 __attribute__((ext_vector_type(8)));
typedef float f32x4 __attribute__((ext_vector_type(4)));
typedef unsigned u32x4 __attribute__((ext_vector_type(4)));
constexpr int BM = 256, BK = 64, HALF = 128, HTB = HALF * BK * 2  , STAGE_BYTES = 8 * HTB, NXCD = 8, WGM = 8;

__host__ __device__ __forceinline__ int lds_byte(int r, int c) { const int st = (r >> 4) * 2 + (c >> 5), rr = r & 15, cc = c & 31, ob = rr * 64 + cc * 2; return st * 1024 + (ob ^ (((ob >> 9) & 1) << 5)); }
__host__ __device__ __forceinline__ void stage_rc(int b, int& R, int& C) { const int st = b / 1024, sb = b % 1024, swz = sb ^ (((sb >> 9) & 1) << 5); R = (st >> 1) * 16 + swz / 64; C = (st & 1) * 32 + (swz % 64) / 2; }
__host__ __device__ __forceinline__ int perm32(int rho) { const int n = rho >> 4, i = rho & 15; return 8 * (i >> 2) + 4 * n + (i & 3); }

struct Unit { int pm, pn; };
struct Gemm { const bf16_t* A; const bf16_t* Bt; int M, N, K; };

struct StaticOrder {
    int nM, nN, nwg, G, c;
    __host__ __device__ void init(int M, int N, int G_, int c_) { nM = M / BM; nN = N / BM; nwg = nM * nN; G = G_; c = c_; }
    __host__ __device__ bool next(int i, Unit& u) const {
        const long L = (long)i * G + c; if (L >= nwg) return false;
        int wgid = (int)L; { const int q = nwg / NXCD, r = nwg % NXCD, xcd = wgid % NXCD, off = wgid / NXCD; wgid = (xcd < r ? xcd * (q + 1) : r * (q + 1) + (xcd - r) * q) + off; }
        const int nig = WGM * nN, gid = wgid / nig, fm = gid * WGM, gsz = (nM - fm) < WGM ? (nM - fm) : WGM;
        u.pm = fm + ((wgid % nig) % gsz); u.pn = (wgid % nig) / gsz; return true;
    }
    __device__ __forceinline__ void a_ready(const Unit&) const {}
    __device__ __forceinline__ void done(const Unit&) const {}
};

__device__ __forceinline__ unsigned cvt_pk_bf16(float lo, float hi) { unsigned r; asm volatile("v_cvt_pk_bf16_f32 %0, %1, %2" : "=v"(r) : "v"(lo), "v"(hi)); return r; }
typedef float f32x2 __attribute__((ext_vector_type(2)));
struct EpiF32 {
    static constexpr bool PERM = false, AFTER_DRAIN = false;
    float* C; int ldc;
    __device__ __forceinline__ void operator()(const f32x4 (&acc)[2][2][4][2], const Unit& u, int wr, int wc, int fr, int fq) const {
        const int row0 = u.pm * BM + wr * 64 + fr, col0 = u.pn * BM + wc * 32 + 4 * fq;
#pragma unroll
        for (int ai = 0; ai < 2; ++ai)
#pragma unroll
            for (int m = 0; m < 4; ++m) { float* rowp = C + (size_t)(row0 + ai * HALF + m * 16) * ldc + col0;
#pragma unroll
                for (int bj = 0; bj < 2; ++bj)
#pragma unroll
                    for (int n = 0; n < 2; ++n) *(f32x4*)(rowp + bj * HALF + n * 16) = acc[ai][bj][m][n]; }
    }
};
template <int ACT  > struct EpiBf16 {
    static constexpr bool PERM = true, AFTER_DRAIN = false;
    bf16_t* O; int ldc;
    __device__ __forceinline__ void operator()(const f32x4 (&acc)[2][2][4][2], const Unit& u, int wr, int wc, int fr, int fq) const {
        const int row0 = u.pm * BM + wr * 64 + fr; const int col0 = u.pn * BM + wc * 32 + 8 * fq;
#pragma unroll
        for (int ai = 0; ai < 2; ++ai)
#pragma unroll
            for (int m = 0; m < 4; ++m) { bf16_t* rowp = O + (size_t)(row0 + ai * HALF + m * 16) * ldc + col0;
#pragma unroll
                for (int bj = 0; bj < 2; ++bj) { f32x4 v0 = acc[ai][bj][m][0], v1 = acc[ai][bj][m][1];
                    if (ACT == 3) {
#pragma unroll
                        for (int j = 0; j < 4; ++j) { const float a = fmaxf(v0[j], 0.f), b = fmaxf(v1[j], 0.f); v0[j] = a * a; v1[j] = b * b; } }
                    u32x4 w; w.x = cvt_pk_bf16(v0[0], v0[1]); w.y = cvt_pk_bf16(v0[2], v0[3]); w.z = cvt_pk_bf16(v1[0], v1[1]); w.w = cvt_pk_bf16(v1[2], v1[3]);
                    *(u32x4*)(rowp + bj * HALF) = w; } }
    }
};
struct EpiQKV {
    static constexpr bool PERM = true, AFTER_DRAIN = false;
    bf16_t* O; int Mrows;
    __device__ __forceinline__ void operator()(const f32x4 (&acc)[2][2][4][2], const Unit& u, int wr, int wc, int fr, int fq) const {
        const int row0 = u.pm * BM + wr * 64 + fr;
#pragma unroll
        for (int bj = 0; bj < 2; ++bj) { bf16_t* hb = O + (size_t)(u.pn * 2 + bj) * Mrows * 128 + wc * 32 + 8 * fq;
#pragma unroll
            for (int ai = 0; ai < 2; ++ai)
#pragma unroll
                for (int m = 0; m < 4; ++m) { const f32x4 v0 = acc[ai][bj][m][0], v1 = acc[ai][bj][m][1];
                    u32x4 w; w.x = cvt_pk_bf16(v0[0], v0[1]); w.y = cvt_pk_bf16(v0[2], v0[3]); w.z = cvt_pk_bf16(v1[0], v1[1]); w.w = cvt_pk_bf16(v1[2], v1[3]);
                    *(u32x4*)(hb + (size_t)(row0 + ai * HALF + m * 16) * 128) = w; } }
    }
};
template <class Epi, class Sched, bool ALIGN_EPI = false, bool SP2 = false>
__device__ __forceinline__ void gemm_phase(PG8_LAS unsigned char* lds, const Gemm g, const Sched& S, const Epi& E) {
    int tid_ = threadIdx.x; asm volatile("" : "+v"(tid_));
    const int tid = tid_, wid = __builtin_amdgcn_readfirstlane(tid >> 6), lane = tid & 63, wr = wid >> 2, wc = wid & 3, fr = lane & 15, fq = lane >> 4;
    const int K = g.K, nt = K / BK;
    unsigned voffA[2], voffB[2];
#pragma unroll
    for (int i = 0; i < 2; ++i) { int R, C; stage_rc(tid * 16 + i * 8192, R, C); const int Rb = Epi::PERM ? ((R & ~31) + perm32(R & 31)) : R;
        voffA[i] = (unsigned)(R * K + C) * 2u; voffB[i] = (unsigned)(Rb * K + C) * 2u; }
    const size_t kstep = (size_t)(BK * 2);
    const size_t hstep = (size_t)HALF * K * 2;
    const size_t tstep = 2 * hstep;
    const unsigned ldsw = (unsigned)wid * 1024u;
    const int aoff = lds_byte(wr * 64 + fr, fq * 8), boff = lds_byte(wc * 32 + fr, fq * 8);
#define PG8_SA(b, h) (((b) * 2 + (h)) * HTB)
#define PG8_SB(b, h) ((4 + (b) * 2 + (h)) * HTB)
#define PG8_STAGE(bufoff, gbase, voff) do { _Pragma("unroll") for (int _i = 0; _i < 2; ++_i) \
        __builtin_amdgcn_global_load_lds((const unsigned*)((const char*)(gbase) + (voff)[_i]), (PG8_LAS unsigned*)(lds + (bufoff) + ldsw + _i * 8192), 16, 0, 0); } while (0)
#define PG8_LDA(dst, b, h) do { _Pragma("unroll") for (int m = 0; m < 4; ++m) _Pragma("unroll") for (int k = 0; k < 2; ++k) dst[m][k] = *(const PG8_LAS bf16x8*)(lds + PG8_SA(b, h) + aoff + m * 2048 + k * 1024); } while (0)
#define PG8_LDB(dst, b, h) do { _Pragma("unroll") for (int n = 0; n < 2; ++n) _Pragma("unroll") for (int k = 0; k < 2; ++k) dst[n][k] = *(const PG8_LAS bf16x8*)(lds + PG8_SB(b, h) + boff + n * 2048 + k * 1024); } while (0)
#define PG8_MMA(ai, bj, At, Bt) do { __builtin_amdgcn_s_setprio(1); _Pragma("unroll") for (int m = 0; m < 4; ++m) _Pragma("unroll") for (int n = 0; n < 2; ++n) _Pragma("unroll") for (int k = 0; k < 2; ++k) \
        acc[ai][bj][m][n] = __builtin_amdgcn_mfma_f32_16x16x32_bf16(Bt[n][k], At[m][k], acc[ai][bj][m][n], 0, 0, 0); __builtin_amdgcn_s_setprio(0); } while (0)
#define PG8_WAIT_V(n) asm volatile("s_waitcnt vmcnt(" #n ")" ::: "memory")
#define PG8_WAIT_L(n) asm volatile("s_waitcnt lgkmcnt(" #n ")" ::: "memory")
#define PG8_BAR __builtin_amdgcn_s_barrier()
#define PG8_SCHED __builtin_amdgcn_sched_barrier(0)
    Unit cur, nxt; int ui = 0;
    if (!S.next(0, cur)) return;
    f32x4 acc[2][2][4][2];
#pragma unroll
    for (int a = 0; a < 2; ++a)
#pragma unroll
        for (int b = 0; b < 2; ++b)
#pragma unroll
            for (int m = 0; m < 4; ++m)
#pragma unroll
                for (int n = 0; n < 2; ++n) acc[a][b][m][n] = (f32x4){0.f, 0.f, 0.f, 0.f};
    bf16x8 At[4][2], B0[2][2], B1[2][2];
    const char* cA = (const char*)g.A + (size_t)cur.pm * tstep; const char* cB = (const char*)g.Bt + (size_t)cur.pn * tstep;
    S.a_ready(cur);
    if constexpr (SP2) {
        PG8_STAGE(PG8_SB(0, 0), cB, voffB); PG8_STAGE(PG8_SB(0, 1), cB + hstep, voffB); PG8_STAGE(PG8_SA(0, 0), cA, voffA); PG8_STAGE(PG8_SA(0, 1), cA + hstep, voffA);
        if (wr == 1) PG8_BAR;
        PG8_WAIT_V(2); PG8_BAR;
        PG8_STAGE(PG8_SB(1, 0), cB + kstep, voffB); PG8_STAGE(PG8_SA(1, 0), cA + kstep, voffA); PG8_STAGE(PG8_SB(1, 1), cB + hstep + kstep, voffB);
        PG8_WAIT_V(6); PG8_BAR;
    } else {
        PG8_STAGE(PG8_SB(0, 0), cB, voffB); PG8_STAGE(PG8_SA(0, 0), cA, voffA); PG8_STAGE(PG8_SB(0, 1), cB + hstep, voffB); PG8_STAGE(PG8_SA(0, 1), cA + hstep, voffA);
        if (wr == 1) PG8_BAR;
        PG8_WAIT_V(4); PG8_BAR;
        PG8_STAGE(PG8_SB(1, 0), cB + kstep, voffB); PG8_STAGE(PG8_SA(1, 0), cA + kstep, voffA); PG8_STAGE(PG8_SB(1, 1), cB + hstep + kstep, voffB);
        PG8_WAIT_V(6); PG8_BAR;
    }
    for (;;) {
        const bool has_next = S.next(ui + 1, nxt);
        const char* nA = has_next ? (const char*)g.A + (size_t)nxt.pm * tstep : cA; const char* nB = has_next ? (const char*)g.Bt + (size_t)nxt.pn * tstep : cB;
        for (int t = 0; t < nt; t += 2) {
            const bool last = (t == nt - 2);
            const char* a1 = cA + (size_t)(t + 1) * kstep;
            const char* a2 = last ? nA : cA + (size_t)(t + 2) * kstep; const char* b2 = last ? nB : cB + (size_t)(t + 2) * kstep;
            const char* a3 = a2 + kstep; const char* b3 = b2 + kstep;
            if (last && has_next) S.a_ready(nxt);
            if constexpr (SP2) {
            PG8_LDB(B0, 0, 0); PG8_LDB(B1, 0, 1); PG8_SCHED; PG8_LDA(At, 0, 0); PG8_STAGE(PG8_SA(1, 1), a1 + hstep, voffA);
            PG8_WAIT_V(8); PG8_WAIT_L(0); PG8_BAR; PG8_MMA(0, 0, At, B0); PG8_MMA(0, 1, At, B1); PG8_BAR; PG8_SCHED;
            PG8_LDA(At, 0, 1); PG8_STAGE(PG8_SB(0, 0), b2, voffB); PG8_STAGE(PG8_SB(0, 1), b2 + hstep, voffB); PG8_STAGE(PG8_SA(0, 0), a2, voffA);
            PG8_WAIT_V(8); PG8_WAIT_L(0); PG8_BAR; PG8_MMA(1, 0, At, B0); PG8_MMA(1, 1, At, B1); PG8_BAR; PG8_SCHED;
            PG8_LDB(B0, 1, 0); PG8_LDB(B1, 1, 1); PG8_SCHED; PG8_LDA(At, 1, 0); PG8_STAGE(PG8_SA(0, 1), a2 + hstep, voffA);
            PG8_WAIT_V(8); PG8_WAIT_L(0); PG8_BAR; PG8_MMA(0, 0, At, B0); PG8_MMA(0, 1, At, B1); PG8_BAR; PG8_SCHED;
            PG8_LDA(At, 1, 1); PG8_STAGE(PG8_SB(1, 0), b3, voffB); PG8_STAGE(PG8_SB(1, 1), b3 + hstep, voffB); PG8_STAGE(PG8_SA(1, 0), a3, voffA);
            PG8_WAIT_V(8); PG8_WAIT_L(0); PG8_BAR; PG8_MMA(1, 0, At, B0); PG8_MMA(1, 1, At, B1); PG8_BAR; PG8_SCHED;
            } else {
            PG8_LDB(B0, 0, 0); PG8_SCHED; PG8_LDA(At, 0, 0); PG8_STAGE(PG8_SA(1, 1), a1 + hstep, voffA);
            PG8_WAIT_L(8); PG8_BAR; PG8_WAIT_L(0); PG8_MMA(0, 0, At, B0); PG8_BAR; PG8_SCHED;
            PG8_LDB(B1, 0, 1); PG8_STAGE(PG8_SB(0, 0), b2, voffB);
            PG8_BAR; PG8_WAIT_L(0); PG8_MMA(0, 1, At, B1); PG8_BAR;
            PG8_LDA(At, 0, 1); PG8_STAGE(PG8_SA(0, 0), a2, voffA);
            PG8_BAR; PG8_WAIT_L(0); PG8_MMA(1, 0, At, B0); PG8_BAR; PG8_SCHED;
            PG8_STAGE(PG8_SB(0, 1), b2 + hstep, voffB);
            PG8_WAIT_V(6); PG8_BAR; PG8_MMA(1, 1, At, B1); PG8_BAR;
            PG8_LDB(B0, 1, 0); PG8_SCHED; PG8_LDA(At, 1, 0); PG8_STAGE(PG8_SA(0, 1), a2 + hstep, voffA);
            PG8_WAIT_L(8); PG8_BAR; PG8_WAIT_L(0); PG8_MMA(0, 0, At, B0); PG8_BAR; PG8_SCHED;
            PG8_LDB(B1, 1, 1); PG8_STAGE(PG8_SB(1, 0), b3, voffB);
            PG8_BAR; PG8_WAIT_L(0); PG8_MMA(0, 1, At, B1); PG8_BAR;
            PG8_LDA(At, 1, 1); PG8_STAGE(PG8_SA(1, 0), a3, voffA);
            PG8_BAR; PG8_WAIT_L(0); PG8_MMA(1, 0, At, B0); PG8_BAR; PG8_SCHED;
            PG8_STAGE(PG8_SB(1, 1), b3 + hstep, voffB);
            PG8_WAIT_V(6); PG8_BAR; PG8_MMA(1, 1, At, B1); PG8_BAR;
            }
        }
        if constexpr (ALIGN_EPI) { if (wr == 0) PG8_BAR; }
        if constexpr (!Epi::AFTER_DRAIN) { E(acc, cur, wr, wc, fr, fq); S.done(cur); }
        if (!has_next) break;
#pragma unroll
        for (int a = 0; a < 2; ++a)
#pragma unroll
            for (int b = 0; b < 2; ++b)
#pragma unroll
                for (int m = 0; m < 4; ++m)
#pragma unroll
                    for (int n = 0; n < 2; ++n) acc[a][b][m][n] = (f32x4){0.f, 0.f, 0.f, 0.f};
        cur = nxt; cA = nA; cB = nB; ++ui;
        if constexpr (ALIGN_EPI) { if (wr == 1) PG8_BAR; }
    }
    PG8_WAIT_V(0);
    if constexpr (!ALIGN_EPI) { if (wr == 0) PG8_BAR; }
    PG8_BAR;
    if constexpr (Epi::AFTER_DRAIN) { E.fused(acc, cur, wr, wc, fr, fq, lds, wid, lane); S.done(cur); }
#undef PG8_SA
#undef PG8_SB
#undef PG8_STAGE
#undef PG8_LDA
#undef PG8_LDB
#undef PG8_MMA
#undef PG8_WAIT_V
#undef PG8_WAIT_L
#undef PG8_BAR
#undef PG8_SCHED
}
}
namespace att {
typedef unsigned short bf16;
using bf16x8 = __attribute__((ext_vector_type(8))) short;
using s16x4  = __attribute__((ext_vector_type(4))) short;
using f32x16 = __attribute__((ext_vector_type(16))) float;
using u32x4  = __attribute__((ext_vector_type(4))) unsigned;
constexpr int   D = 128, NW = 8, QBLK = 32, KVBLK = 64;
constexpr float SCALE = 0.088388347648318440f;
constexpr float LOG2E = 1.4426950408889634f;
constexpr float C2 = SCALE * LOG2E;
constexpr float THR = 8.f;
constexpr int SHM_V = KVBLK * D * 2, SHM_K = KVBLK * D * 2;
constexpr int LDS_WS = 2 * SHM_V + 2 * SHM_K, LDS_TB = LDS_WS + NW * 64 * 4, LDS_ATT_BYTES = LDS_TB + 4096;
#define KSWZ(row, colB) ((row) * 256 + ((colB) ^ (((row) & 7) << 4)))
#define SBAR() __builtin_amdgcn_sched_barrier(0)
__device__ __forceinline__ int crow(int r, int hi) { return (r & 3) + 8 * (r >> 2) + 4 * hi; }
typedef float f32x2_ __attribute__((ext_vector_type(2)));
typedef __bf16 bf16x2_ __attribute__((ext_vector_type(2)));
__device__ __forceinline__ unsigned cvtpk(float lo, float hi) { const f32x2_ v = {lo, hi}; const bf16x2_ r = __builtin_convertvector(v, bf16x2_); return *reinterpret_cast<const unsigned*>(&r); }
#define SGB(mask, n) __builtin_amdgcn_sched_group_barrier(mask, n, 0)
#define SG_QK() do { SGB(0x100, 2); _Pragma("unroll") for (int i_ = 0; i_ < 16; ++i_) { SGB(0x008, 1); if (i_ < 14) SGB(0x100, 1); SGB(0x400, 1); SGB(0x002, 4); } } while (0)
__device__ __forceinline__ bf16x8 ld8(const bf16* p) { return *reinterpret_cast<const bf16x8*>(p); }

struct MaskCtx { int a, v, d; const float* tbl; };
constexpr int TB_ORG = 256;

__device__ __forceinline__ void partialSM(f32x16& p0, f32x16& p1, float& m_reg, float& mn, float& alpha) {
  float pmax = p0[0];
#pragma unroll
  for (int r = 1; r < 16; ++r) pmax = fmaxf(pmax, p0[r]);
#pragma unroll
  for (int r = 0; r < 16; ++r) pmax = fmaxf(pmax, p1[r]);
  { auto rr = __builtin_amdgcn_permlane32_swap(__float_as_uint(pmax), __float_as_uint(pmax), false, false);
    pmax = fmaxf(__uint_as_float(rr[0]), __uint_as_float(rr[1])); }
  if (__builtin_expect(__all(pmax - m_reg <= THR / SCALE), 1)) { mn = m_reg; alpha = 1.f; }
  else { mn = fmaxf(m_reg, pmax); alpha = __builtin_amdgcn_exp2f((m_reg - mn) * C2); m_reg = mn; }
  float mnC = -mn * C2;
#pragma unroll
  for (int r = 0; r < 16; ++r) p0[r] = fmaf(p0[r], C2, mnC);
#pragma unroll
  for (int r = 0; r < 16; ++r) p1[r] = fmaf(p1[r], C2, mnC);
#pragma unroll
  for (int r = 0; r < 16; ++r) p0[r] = __builtin_amdgcn_exp2f(p0[r]);
}
template <int KIND>
__device__ __forceinline__ void partialSM_m(f32x16& p0, f32x16& p1, float& m_reg, float& mn, float& alpha, int jt, const MaskCtx& mc) {
  const float* tp = (KIND == 1) ? mc.tbl + (jt - mc.a + 7) * 31 : mc.tbl + jt * 64;
  float b0[16], b1[16];
#pragma unroll
  for (int r = 0; r < 16; ++r) { const int kc = (r & 3) + 8 * (r >> 2); b0[r] = tp[kc]; b1[r] = tp[kc + 32]; }
#pragma unroll
  for (int r = 0; r < 16; ++r) asm volatile("" : "+v"(b0[r]), "+v"(b1[r]));
  if (KIND == 1) {
    const bool rowok = (unsigned)(jt - min(max(mc.a - 4, 0), 120)) <= 7u;
#pragma unroll
    for (int r = 0; r < 16; ++r) { const int kc = (r & 3) + 8 * (r >> 2);
      { const bool ok = rowok && (unsigned)(kc - mc.v) <= 15u; const float t = fmaf(p0[r], C2, b0[r]); p0[r] = ok ? t : -1e30f; }
      { const bool ok = rowok && (unsigned)(kc + 32 - mc.v) <= 15u; const float t = fmaf(p1[r], C2, b1[r]); p1[r] = ok ? t : -1e30f; } }
  } else {
    const bool tok = (unsigned)jt < (unsigned)mc.d;
    const int db = jt * 64 + mc.v;
#pragma unroll
    for (int r = 0; r < 16; ++r) { const int kc = (r & 3) + 8 * (r >> 2);
      { const bool ok = tok && (unsigned)(db + kc) <= 128u; const float t = fmaf(p0[r], C2, b0[r]); p0[r] = ok ? t : -1e30f; }
      { const bool ok = tok && (unsigned)(db + kc + 32) <= 128u; const float t = fmaf(p1[r], C2, b1[r]); p1[r] = ok ? t : -1e30f; } }
  }
  float pmax = p0[0];
#pragma unroll
  for (int r = 1; r < 16; ++r) pmax = fmaxf(pmax, p0[r]);
#pragma unroll
  for (int r = 0; r < 16; ++r) pmax = fmaxf(pmax, p1[r]);
  { auto rr = __builtin_amdgcn_permlane32_swap(__float_as_uint(pmax), __float_as_uint(pmax), false, false);
    pmax = fmaxf(__uint_as_float(rr[0]), __uint_as_float(rr[1])); }
  if (__builtin_expect(__all(pmax - m_reg <= THR * LOG2E), 1)) { mn = m_reg; alpha = 1.f; }
  else { mn = fmaxf(m_reg, pmax); alpha = __builtin_amdgcn_exp2f(m_reg - mn); m_reg = mn; }
#pragma unroll
  for (int r = 0; r < 16; ++r) p0[r] -= mn;
#pragma unroll
  for (int r = 0; r < 16; ++r) p1[r] -= mn;
#pragma unroll
  for (int r = 0; r < 16; ++r) p0[r] = __builtin_amdgcn_exp2f(p0[r]);
}
template <bool FAST = false>
__device__ __forceinline__ void finishSM(f32x16& p0, f32x16& p1, float alpha, float& l_reg, bf16x8& pa0, bf16x8& pa1, bf16x8& pa2, bf16x8& pa3) {
#pragma unroll
  for (int r = 0; r < 16; ++r) p1[r] = __builtin_amdgcn_exp2f(p1[r]);
  float ps = 0;
#pragma unroll
  for (int r = 0; r < 16; ++r) ps += p0[r];
#pragma unroll
  for (int r = 0; r < 16; ++r) ps += p1[r];
  if (FAST) l_reg += ps;
  else { auto rr = __builtin_amdgcn_permlane32_swap(__float_as_uint(ps), __float_as_uint(ps), false, false);
    ps = __uint_as_float(rr[0]) + __uint_as_float(rr[1]); l_reg = l_reg * alpha + ps; }
#define PK4(P, BASE, OUT) do { unsigned a0 = cvtpk(P[BASE + 0], P[BASE + 1]), a1 = cvtpk(P[BASE + 2], P[BASE + 3]);   \
    unsigned b0 = cvtpk(P[BASE + 4], P[BASE + 5]), b1 = cvtpk(P[BASE + 6], P[BASE + 7]);                              \
    auto r0 = __builtin_amdgcn_permlane32_swap(a0, b0, false, false); auto r1 = __builtin_amdgcn_permlane32_swap(a1, b1, false, false); \
    u32x4 w = {r0[0], r1[0], r0[1], r1[1]}; OUT = *reinterpret_cast<bf16x8*>(&w); } while (0)
  PK4(p0, 0, pa0); PK4(p0, 8, pa1); PK4(p1, 0, pa2); PK4(p1, 8, pa3);
#undef PK4
}
__device__ __forceinline__ void qkt(f32x16& p0, f32x16& p1, const bf16* Ks, const bf16x8* qr, int r32, int hi) {
  p0 = f32x16{}; p1 = f32x16{};
#pragma unroll
  for (int d0 = 0; d0 < 8; ++d0) { int cb = (d0 * 16 + hi * 8) * 2;
    bf16x8 b0 = *reinterpret_cast<const bf16x8*>((const char*)Ks + KSWZ(r32, cb));
    bf16x8 b1 = *reinterpret_cast<const bf16x8*>((const char*)Ks + KSWZ(32 + r32, cb));
    p0 = __builtin_amdgcn_mfma_f32_32x32x16_bf16(b0, qr[d0], p0, 0, 0, 0);
    p1 = __builtin_amdgcn_mfma_f32_32x32x16_bf16(b1, qr[d0], p1, 0, 0, 0); }
}
__device__ __forceinline__ int v_st(int k, int c) { const int kk = (k & ~0xC) | ((k & 4) << 1) | ((k & 8) >> 1); return ((kk >> 3) * 4 + (c >> 5)) * 512 + ((kk & 7) * 32 + (c & 31)) * 2; }
__device__ __forceinline__ int v_rd_base(int lane) { return ((lane & 3) << 3) | (((lane >> 2) & 3) << 6) | (((lane >> 4) & 1) << 5) | (((lane >> 5) & 1) << 8); }
constexpr int v_rd_off(int d0, int ks, int half) { return d0 * 512 + ks * 4096 + half * 2048; }
template <int OFF> __device__ __forceinline__ s16x4 tr_read(int vb) {
  s16x4 r; asm volatile("ds_read_b64_tr_b16 %0, %1 offset:%2" : "=&v"(r) : "v"(vb), "i"(OFF) : "memory"); return r;
}
template <int D0> __device__ __forceinline__ void pv_one(f32x16& od, int vb, bf16x8 pa0, bf16x8 pa1, bf16x8 pa2, bf16x8 pa3) {
  const s16x4 l0 = tr_read<v_rd_off(D0, 0, 0)>(vb), h0 = tr_read<v_rd_off(D0, 0, 1)>(vb), l1 = tr_read<v_rd_off(D0, 1, 0)>(vb), h1 = tr_read<v_rd_off(D0, 1, 1)>(vb);
  const s16x4 l2 = tr_read<v_rd_off(D0, 2, 0)>(vb), h2 = tr_read<v_rd_off(D0, 2, 1)>(vb), l3 = tr_read<v_rd_off(D0, 3, 0)>(vb), h3 = tr_read<v_rd_off(D0, 3, 1)>(vb);
  asm volatile("s_waitcnt lgkmcnt(0)" ::: "memory"); SBAR();
#define PK(L, H) (bf16x8){L[0], L[1], L[2], L[3], H[0], H[1], H[2], H[3]}
  od = __builtin_amdgcn_mfma_f32_32x32x16_bf16(pa0, PK(l0, h0), od, 0, 0, 0);
  od = __builtin_amdgcn_mfma_f32_32x32x16_bf16(pa1, PK(l1, h1), od, 0, 0, 0);
  od = __builtin_amdgcn_mfma_f32_32x32x16_bf16(pa2, PK(l2, h2), od, 0, 0, 0);
  od = __builtin_amdgcn_mfma_f32_32x32x16_bf16(pa3, PK(l3, h3), od, 0, 0, 0);
#undef PK
}
__device__ __forceinline__ void pv_d0(f32x16* o, int vb, bf16x8 pa0, bf16x8 pa1, bf16x8 pa2, bf16x8 pa3) {
  pv_one<0>(o[0], vb, pa0, pa1, pa2, pa3); pv_one<1>(o[1], vb, pa0, pa1, pa2, pa3); pv_one<2>(o[2], vb, pa0, pa1, pa2, pa3); pv_one<3>(o[3], vb, pa0, pa1, pa2, pa3);
}
#define PKS(C, B, OUT) do { auto r0_ = __builtin_amdgcn_permlane32_swap(C[(B)], C[(B) + 2], false, false); auto r1_ = __builtin_amdgcn_permlane32_swap(C[(B) + 1], C[(B) + 3], false, false); \
    u32x4 w_ = {r0_[0], r1_[0], r0_[1], r1_[1]}; OUT = *reinterpret_cast<bf16x8*>(&w_); } while (0)
#ifndef KDEP
#define KDEP 1
#endif
#define KRD1(g_, X) do { const int cb_ = (((g_) >> 1) * 16 + hi * 8) * 2; X = *reinterpret_cast<const bf16x8*>((const char*)Ks + KSWZ(((g_) & 1) * 32 + r32, cb_)); } while (0)
template <bool FAST>
__device__ __forceinline__ void qk_fsm(f32x16& n0, f32x16& n1, const bf16* Ks, const bf16x8* qr, int r32, int hi,
                                       f32x16& p0, f32x16& p1, float alpha, float& l_reg, bf16x8& pa0, bf16x8& pa1, bf16x8& pa2, bf16x8& pa3) {
  n0 = f32x16{}; n1 = f32x16{};
  bf16x8 kf[KDEP + 1]; unsigned c[16]; float s0 = 0.f, s1 = 0.f, ps = 0.f;
  KRD1(0, kf[0]); if (KDEP > 1) KRD1(1, kf[1]);
#pragma unroll
  for (int g = 0; g < 16; ++g) { const int d0 = g >> 1;
    if (g + KDEP < 16) KRD1(g + KDEP, kf[(g + KDEP) % (KDEP + 1)]);
    if ((g & 1) == 0) n0 = __builtin_amdgcn_mfma_f32_32x32x16_bf16(kf[g % (KDEP + 1)], qr[d0], n0, 0, 0, 0);
    else              n1 = __builtin_amdgcn_mfma_f32_32x32x16_bf16(kf[g % (KDEP + 1)], qr[d0], n1, 0, 0, 0);
    if (g < 4) { p1[2 * g] = __builtin_amdgcn_exp2f(p1[2 * g]); p1[2 * g + 1] = __builtin_amdgcn_exp2f(p1[2 * g + 1]); }
    else if (g < 12) p1[g + 4] = __builtin_amdgcn_exp2f(p1[g + 4]);
    if (g < 8) { s0 += p0[2 * g]; s1 += p0[2 * g + 1]; c[g] = cvtpk(p0[2 * g], p0[2 * g + 1]); }
    if (g >= 5 && g <= 12) { const int k = g - 5; s0 += p1[2 * k]; s1 += p1[2 * k + 1]; c[8 + k] = cvtpk(p1[2 * k], p1[2 * k + 1]); }
    if (g <= 12) asm volatile("" : "+v"(s0), "+v"(s1));
    if (g == 4) PKS(c, 0, pa0);
    if (g == 8) PKS(c, 4, pa1);
    if (g == 9) PKS(c, 8, pa2);
    if (g == 13) { PKS(c, 12, pa3); ps = s0 + s1; }
    if (g == 14 && !FAST) { auto rr = __builtin_amdgcn_permlane32_swap(__float_as_uint(ps), __float_as_uint(ps), false, false); ps = __uint_as_float(rr[0]) + __uint_as_float(rr[1]); }
    if (g == 15) l_reg = FAST ? l_reg + ps : l_reg * alpha + ps;
    SBAR();
  }
}
#undef KRD1
template <bool FAST>
__device__ __forceinline__ void pv_psm(f32x16* o, int vb, bf16x8 pa0, bf16x8 pa1, bf16x8 pa2, bf16x8 pa3, f32x16& p0, f32x16& p1, float& m_reg, float& mn, float& alpha) {
  if constexpr (FAST) {
    pv_one<0>(o[0], vb, pa0, pa1, pa2, pa3);
#pragma unroll
    for (int r = 0; r < 4; ++r) p0[r] = __builtin_amdgcn_exp2f(p0[r]);
    pv_one<1>(o[1], vb, pa0, pa1, pa2, pa3);
#pragma unroll
    for (int r = 4; r < 8; ++r) p0[r] = __builtin_amdgcn_exp2f(p0[r]);
    pv_one<2>(o[2], vb, pa0, pa1, pa2, pa3);
#pragma unroll
    for (int r = 8; r < 12; ++r) p0[r] = __builtin_amdgcn_exp2f(p0[r]);
    pv_one<3>(o[3], vb, pa0, pa1, pa2, pa3);
#pragma unroll
    for (int r = 12; r < 16; ++r) p0[r] = __builtin_amdgcn_exp2f(p0[r]);
    asm volatile("" : "+v"(p0), "+v"(p1));
    return;
  }
  pv_one<0>(o[0], vb, pa0, pa1, pa2, pa3);
  float pmax = p0[0];
#pragma unroll
  for (int r = 1; r < 16; ++r) pmax = fmaxf(pmax, p0[r]);
  pv_one<1>(o[1], vb, pa0, pa1, pa2, pa3);
#pragma unroll
  for (int r = 0; r < 16; ++r) pmax = fmaxf(pmax, p1[r]);
  { auto rr = __builtin_amdgcn_permlane32_swap(__float_as_uint(pmax), __float_as_uint(pmax), false, false);
    pmax = fmaxf(__uint_as_float(rr[0]), __uint_as_float(rr[1])); }
  if (__builtin_expect(__all(pmax - m_reg <= THR / SCALE), 1)) { mn = m_reg; alpha = 1.f; }
  else { mn = fmaxf(m_reg, pmax); alpha = __builtin_amdgcn_exp2f((m_reg - mn) * C2); m_reg = mn; }
  const float mnC = -mn * C2;
  pv_one<2>(o[2], vb, pa0, pa1, pa2, pa3);
#pragma unroll
  for (int r = 0; r < 16; ++r) p0[r] = fmaf(p0[r], C2, mnC);
#pragma unroll
  for (int r = 0; r < 16; ++r) p1[r] = fmaf(p1[r], C2, mnC);
  pv_one<3>(o[3], vb, pa0, pa1, pa2, pa3);
#pragma unroll
  for (int r = 0; r < 16; ++r) p0[r] = __builtin_amdgcn_exp2f(p0[r]);
  asm volatile("" : "+v"(p0), "+v"(p1));
}

template <int KIND, bool FAST = false>
__device__ __forceinline__ void attn_unit(const bf16* __restrict__ Qb, long qs, const bf16* __restrict__ Kh, const bf16* __restrict__ Vh, long ks,
                                          int kt0, int NT, int ktmax, bf16* __restrict__ Ob, long os, float* __restrict__ stp, long sts,
                                          int mq0, const float* __restrict__ tbsrc, int tbn, char* lds,
                                          const float* __restrict__ qg = nullptr, const float* __restrict__ rope = nullptr, int t0 = 0) {
  int tid_ = threadIdx.x; asm volatile("" : "+v"(tid_));
  const int tid = tid_, wid = __builtin_amdgcn_readfirstlane(tid >> 6), lane = tid & 63, r32 = lane & 31, hi = lane >> 5;
  bf16* V_lds = (bf16*)lds; bf16* K_lds = (bf16*)(lds + 2 * SHM_V);
  float* ws = (float*)(lds + (FAST ? 3 * (SHM_V + SHM_K) : LDS_WS)) + wid * 64; float* li_l = ws; float* al_l = ws + 32;
  float* tb = (float*)(lds + LDS_TB);
  MaskCtx mc; mc.a = 0; mc.v = 0; mc.d = 0; mc.tbl = tb;
  if (KIND == 1) { const int r = mq0 + (wid >> 1), c = (wid & 1) * 32 + r32; mc.a = r; mc.v = min(max(c - 8, 0), 48) - 4 * hi; mc.tbl = tb + TB_ORG + 15 - c + 4 * hi; }
  if (KIND == 2) { mc.v = 64 - (mq0 + wid * 32 + r32) + 4 * hi; mc.d = ktmax; mc.tbl = tb + TB_ORG + mc.v; }
  if (KIND != 0) { __syncthreads();
    for (int i = tid; i < tbn; i += 64 * NW) tb[TB_ORG + i] = tbsrc[i] * LOG2E; }
  float m_reg = -1e30f, l_reg = 0; f32x16 o[4] = {}; bf16x8 qr[8];
  const bf16* Qw = Qb + (long)(wid * QBLK + r32) * qs + hi * 8;
#pragma unroll
  for (int d0 = 0; d0 < 8; ++d0) qr[d0] = ld8(Qw + d0 * 16);
  if (KIND == 0 && qg != nullptr) {
#define UNPK(X, W) do { X[0] = __uint_as_float(W[0] << 16); X[1] = __uint_as_float(W[0] & 0xffff0000u); X[2] = __uint_as_float(W[1] << 16); X[3] = __uint_as_float(W[1] & 0xffff0000u); \
      X[4] = __uint_as_float(W[2] << 16); X[5] = __uint_as_float(W[2] & 0xffff0000u); X[6] = __uint_as_float(W[3] << 16); X[7] = __uint_as_float(W[3] & 0xffff0000u); } while (0)
    float ss = 0.f;
#pragma unroll
    for (int d0 = 0; d0 < 8; ++d0) { const u32x4 w = *reinterpret_cast<const u32x4*>(&qr[d0]); float x[8]; UNPK(x, w);
#pragma unroll
      for (int i = 0; i < 8; ++i) ss += x[i] * x[i]; }
    { auto rr = __builtin_amdgcn_permlane32_swap(__float_as_uint(ss), __float_as_uint(ss), false, false); ss = __uint_as_float(rr[0]) + __uint_as_float(rr[1]); }
    const float rstd = (FAST ? C2 : 1.0f) / sqrtf(ss * (1.0f / 128.0f) + 1e-6f);
    const int t = t0 + wid * QBLK + r32;
#pragma unroll
    for (int d0 = 0; d0 < 8; ++d0) asm volatile("" : "+v"(qr[d0]));
#pragma unroll
    for (int half = 0; half < 2; ++half) { const int pos = half ? (t & 63) : (t >> 6);
#pragma unroll
      for (int dd = 0; dd < 2; ++dd) { const int d1 = half * 4 + dd, d2 = d1 + 2; const float* rp = rope + pos * 32 + dd * 16 + hi * 8;
        const float4 c0 = *reinterpret_cast<const float4*>(rp), c1 = *reinterpret_cast<const float4*>(rp + 4), s0 = *reinterpret_cast<const float4*>(rp + 4096), s1 = *reinterpret_cast<const float4*>(rp + 4100);
        const float cs[8] = {c0.x, c0.y, c0.z, c0.w, c1.x, c1.y, c1.z, c1.w}, sn[8] = {s0.x, s0.y, s0.z, s0.w, s1.x, s1.y, s1.z, s1.w};
        const float* gp1 = qg + d1 * 16 + hi * 8; const float* gp2 = qg + d2 * 16 + hi * 8;
        const float4 ga = *reinterpret_cast<const float4*>(gp1), gb = *reinterpret_cast<const float4*>(gp1 + 4), gc = *reinterpret_cast<const float4*>(gp2), gd = *reinterpret_cast<const float4*>(gp2 + 4);
        const float g1[8] = {ga.x, ga.y, ga.z, ga.w, gb.x, gb.y, gb.z, gb.w}, g2[8] = {gc.x, gc.y, gc.z, gc.w, gd.x, gd.y, gd.z, gd.w};
        const u32x4 w1 = *reinterpret_cast<const u32x4*>(&qr[d1]), w2 = *reinterpret_cast<const u32x4*>(&qr[d2]); float x1[8], x2[8], y1[8], y2[8]; UNPK(x1, w1); UNPK(x2, w2);
#pragma unroll
        for (int i = 0; i < 8; ++i) { const float a1 = x1[i] * (rstd * g1[i]), a2 = x2[i] * (rstd * g2[i]); y1[i] = a1 * cs[i] - a2 * sn[i]; y2[i] = a1 * sn[i] + a2 * cs[i]; }
        { u32x4 w = {cvtpk(y1[0], y1[1]), cvtpk(y1[2], y1[3]), cvtpk(y1[4], y1[5]), cvtpk(y1[6], y1[7])}; qr[d1] = *reinterpret_cast<bf16x8*>(&w); }
        { u32x4 w = {cvtpk(y2[0], y2[1]), cvtpk(y2[2], y2[3]), cvtpk(y2[4], y2[5]), cvtpk(y2[6], y2[7])}; qr[d2] = *reinterpret_cast<bf16x8*>(&w); } } }
#undef UNPK
  }
  const int sr = tid >> 4, sc = (tid & 15) * 8, vst0 = v_st(sr, sc), vst1 = v_st(32 + sr, sc);
  const int vb0 = (int)(uintptr_t)V_lds + v_rd_base(lane);
  const bf16* Kp = Kh + (long)sr * ks + sc; const bf16* Vp = Vh + (long)sr * ks + sc; const long o32 = 32 * ks, tstep = 64 * ks;
  struct { bf16x8 vs0, vs1, ks0, ks1; } sr_[2];
#define TCL(j) ((long)min(max(kt0 + (j), 0), ktmax - 1))
#define SLOAD(i, j) do { const long off_ = TCL(j) * tstep; sr_[i].vs0 = ld8(Vp + off_); sr_[i].vs1 = ld8(Vp + off_ + o32); sr_[i].ks0 = ld8(Kp + off_); sr_[i].ks1 = ld8(Kp + off_ + o32); } while (0)
#define SWRITE(b, i) do { *(bf16x8*)((char*)V_lds + (b) * SHM_V + vst0) = sr_[i].vs0;          \
    *(bf16x8*)((char*)V_lds + (b) * SHM_V + vst1) = sr_[i].vs1; int kc = sc * 2;               \
    *(bf16x8*)((char*)K_lds + (b) * SHM_K + KSWZ(sr, kc)) = sr_[i].ks0;                       \
    *(bf16x8*)((char*)K_lds + (b) * SHM_K + KSWZ(32 + sr, kc)) = sr_[i].ks1; } while (0)
#define SWAIT() asm volatile("s_waitcnt vmcnt(4)" ::: "memory")
#define RESC(a) do { if (__any((a) < 1.f)) { if (hi == 0) al_l[r32] = (a); asm volatile("s_waitcnt lgkmcnt(0)" ::: "memory"); \
    _Pragma("unroll") for (int d = 0; d < 4; ++d) _Pragma("unroll") for (int r = 0; r < 16; ++r) o[d][r] *= al_l[crow(r, hi)]; } } while (0)
  if constexpr (KIND == 0 && FAST) {
    typedef __attribute__((address_space(3))) unsigned* ldsp_t;
    char* Vr = lds; char* Kr = lds + 3 * SHM_V;
    unsigned kof[2], vof[2];
#pragma unroll
    for (int i = 0; i < 2; ++i) { const int I = 2 * wid + i;
      const int r = 4 * I + (lane >> 4), sl = lane & 15; kof[i] = (unsigned)(r * (int)ks * 2 + ((sl ^ (r & 7)) << 4));
      const int G = I * 64 + lane, S = G >> 5, kk = ((S >> 2) << 3) | ((G >> 2) & 7), c = ((S & 3) << 5) | ((G & 3) << 3);
      const int k = (kk & ~0xC) | ((kk & 4) << 1) | ((kk & 8) >> 1); vof[i] = (unsigned)(k * (int)ks * 2 + c * 2); }
    const long tstep_ = 64 * ks;
#define DMA(b, j) do { const long tb_ = (long)min(max(kt0 + (j), 0), ktmax - 1) * tstep_; const char* kg_ = (const char*)(Kh + tb_); const char* vg_ = (const char*)(Vh + tb_);          \
      _Pragma("unroll") for (int i_ = 0; i_ < 2; ++i_) {                                                                                                                                    \
        __builtin_amdgcn_global_load_lds((const unsigned*)(kg_ + kof[i_]), (ldsp_t)(Kr + (b) * SHM_K + (2 * wid + i_) * 1024), 16, 0, 0);                                                 \
        __builtin_amdgcn_global_load_lds((const unsigned*)(vg_ + vof[i_]), (ldsp_t)(Vr + (b) * SHM_V + (2 * wid + i_) * 1024), 16, 0, 0); } } while (0)
#define KB(b) ((const bf16*)(Kr + (b) * SHM_K))
#define VB(b) ((int)(uintptr_t)Vr + v_rd_base(lane) + (b) * (int)SHM_V)
    f32x16 pA0, pA1, pB0, pB1; float mnD = 0.f, alD = 1.f; bf16x8 pa0, pa1, pa2, pa3;
    DMA(0, 0); DMA(1, 1);
    asm volatile("s_waitcnt vmcnt(4)" ::: "memory"); __syncthreads();
    qkt(pA0, pA1, KB(0), qr, r32, hi);
#pragma unroll
    for (int r = 0; r < 16; ++r) pA0[r] = __builtin_amdgcn_exp2f(pA0[r]);
#define IT(N0, N1, O0, O1, BK, BV, BW, J) do {                                                                                                      \
      asm volatile("s_waitcnt vmcnt(0)" ::: "memory"); __syncthreads();                         \
      DMA(BW, (J) + 1); SBAR();                                                                                                                     \
      qk_fsm<false>(N0, N1, KB(BK), qr, r32, hi, O0, O1, 1.f, l_reg, pa0, pa1, pa2, pa3);                                                           \
      pv_psm<true>(o, VB(BV), pa0, pa1, pa2, pa3, N0, N1, m_reg, mnD, alD); } while (0)
    int sk = 1, sv = 0, sw = 2;
#define ROT() do { sv = sk; sk = sw; sw = (sw == 2) ? 0 : sw + 1; } while (0)
    for (int j = 1; j + 1 < NT; j += 2) {
      IT(pB0, pB1, pA0, pA1, sk, sv, sw, j); ROT();
      IT(pA0, pA1, pB0, pB1, sk, sv, sw, j + 1); ROT();
    }
    asm volatile("s_waitcnt vmcnt(0)" ::: "memory"); __syncthreads();
    SBAR(); qk_fsm<false>(pB0, pB1, KB(sk), qr, r32, hi, pA0, pA1, 1.f, l_reg, pa0, pa1, pa2, pa3);
    pv_psm<true>(o, VB(sv), pa0, pa1, pa2, pa3, pB0, pB1, m_reg, mnD, alD);
    finishSM(pB0, pB1, 1.f, l_reg, pa0, pa1, pa2, pa3); SBAR();
    pv_d0(o, VB(sk), pa0, pa1, pa2, pa3);
#undef ROT
#undef IT
#undef DMA
#undef KB
#undef VB
  } else
  {
  bf16x8 pa0, pa1, pa2, pa3;
  {
    const int nd_lo = (KIND == 1) ? min(max(mq0 + (wid >> 1) - 4, 0), 120) : (mq0 + 32 * wid - 127);
    const int nd_hi = mq0 + 32 * wid + 95;
#define NEED(jt) ((KIND == 0) ? true : (KIND == 1) ? ((unsigned)((jt) - nd_lo) <= 7u) : ((unsigned)(jt) < (unsigned)ktmax && 64 * (jt) >= nd_lo && 64 * (jt) <= nd_hi))
    f32x16 p0, p1; float mn, al;
    SLOAD(0, 0); SLOAD(1, 1);
#define STEP(J, B) do { SWRITE(B, B); if ((J) + 2 < NT) SLOAD(B, (J) + 2); __syncthreads();                                     \
      if (NEED(kt0 + (J))) { qkt(p0, p1, (bf16*)((char*)K_lds + (B) * SHM_K), qr, r32, hi); if constexpr (KIND == 0) partialSM(p0, p1, m_reg, mn, al); else partialSM_m<KIND>(p0, p1, m_reg, mn, al, kt0 + (J), mc); RESC(al); \
        finishSM(p0, p1, al, l_reg, pa0, pa1, pa2, pa3); SBAR(); pv_d0(o, vb0 + (B) * (int)SHM_V, pa0, pa1, pa2, pa3); } } while (0)
    for (int j = 0; j < NT; j += 2) { STEP(j, 0); STEP(j + 1, 1); }
#undef STEP
#undef NEED
  }
  }
  if (hi == 0) li_l[r32] = l_reg; asm volatile("s_waitcnt lgkmcnt(0)" ::: "memory");
  if (KIND == 2) { if (hi == 0) { float* sp = stp + (long)(wid * QBLK + r32) * sts; sp[0] = m_reg; sp[1] = l_reg; } }
  float rli[16];
#pragma unroll
  for (int r = 0; r < 16; ++r) rli[r] = __builtin_amdgcn_rcpf(li_l[crow(r, hi)]);
  bf16* Ow = Ob + (long)(wid * QBLK) * os;
#pragma unroll
  for (int r = 0; r < 16; ++r) { const int orow = crow(r, hi);
#pragma unroll
    for (int d0 = 0; d0 < 4; ++d0) { const float v = o[d0][r] * rli[r]; Ow[(long)orow * os + d0 * 32 + r32] = (bf16)(cvtpk(v, v) & 0xffffu); } }
#undef TCL
#undef SLOAD
#undef SWRITE
#undef SWAIT
#undef RESC
}
}
#define GAS __attribute__((address_space(1)))
#define LAS __attribute__((address_space(3)))
typedef unsigned short bf16;
typedef unsigned v4u __attribute__((ext_vector_type(4)));
typedef float f32x4 __attribute__((ext_vector_type(4)));
typedef short bf16x8 __attribute__((ext_vector_type(8)));
typedef GAS unsigned gu32;
typedef GAS unsigned long long gu64;
#define RLX_AGENT __ATOMIC_RELAXED, __HIP_MEMORY_SCOPE_AGENT
#define LDS_WAIT() asm volatile("s_waitcnt lgkmcnt(0)" ::: "memory")
#define VM_WAIT() asm volatile("s_waitcnt vmcnt(0)" ::: "memory")
__device__ __forceinline__ unsigned long long rt() { return __builtin_amdgcn_s_memrealtime(); }
__device__ __forceinline__ unsigned f2bf(float f) { unsigned u = __builtin_bit_cast(unsigned, f); return (u + 0x7fffu + ((u >> 16) & 1u)) >> 16; }
__device__ __forceinline__ unsigned pk2(float lo, float hi) { return f2bf(lo) | (f2bf(hi) << 16); }

#define XB_TMO      128
#define XB_XCNT(j)  (256  + 64 * (j))
#define XB_XSUB(j)  (1280 + 64 * (j))
#define XB_XGEN(j)  (2304 + 64 * (j))
#define XB_TOP      3328
#define XB_TOPGEN   3392
#define XCD_BAR_WORDS 3456
#define XB_SPIN_CAP (1u << 18)

__device__ __forceinline__ unsigned xb_ld(unsigned* p)              { return __hip_atomic_load(p, __ATOMIC_RELAXED, __HIP_MEMORY_SCOPE_AGENT); }
__device__ __forceinline__ unsigned xb_add(unsigned* p, unsigned v) { return __hip_atomic_fetch_add(p, v, __ATOMIC_RELAXED, __HIP_MEMORY_SCOPE_AGENT); }
__device__ __forceinline__ unsigned xb_xcc_id() { return (unsigned)__builtin_amdgcn_s_getreg((3 << 11) | 20) & 0xFu; }
#define XB_SPIN(cond, bar) do { unsigned _sp = 0; while (cond) { __builtin_amdgcn_s_sleep(1); \
    if ((++_sp & 255u) == 0u) { if (xb_ld(&(bar)[XB_TMO])) break; if (_sp > XB_SPIN_CAP) { atomicAdd(&(bar)[XB_TMO], 1u); break; } } } } while (0)

struct XcdBarrier {
    unsigned* bar; unsigned x;
    volatile LAS unsigned* st;
};

__device__ __forceinline__ XcdBarrier xcd_barrier_post(unsigned* bar, volatile LAS unsigned* st) {
    XcdBarrier b; b.bar = bar; b.x = xb_xcc_id(); b.st = st;
    if (threadIdx.x == 0) (void)xb_add(&bar[XB_XCNT(b.x)], 1u);
    return b;
}
__device__ __forceinline__ void xcd_barrier_complete(unsigned* bar, unsigned x, unsigned& nloc, unsigned& nx) {
    const unsigned G = gridDim.x * gridDim.y * gridDim.z;
    unsigned sum, cnt, mine, sp = 0u;
    for (;;) {
        sum = 0u; cnt = 0u; mine = 0u;
#pragma unroll
        for (unsigned j = 0; j < 16; ++j) { const unsigned c = xb_ld(&bar[XB_XCNT(j)]); sum += c; cnt += (c > 0u) ? 1u : 0u; mine = (j == x) ? c : mine; }
        if (sum == G) break;
        __builtin_amdgcn_s_sleep(1);
        if ((++sp & 255u) == 0u) { if (xb_ld(&bar[XB_TMO])) break; if (sp > XB_SPIN_CAP) { atomicAdd(&bar[XB_TMO], 1u); break; } }
    }
    nloc = mine > 0u ? mine : 1u; nx = cnt > 0u ? cnt : 1u;
}

__device__ __forceinline__ void xcd_barrier(const XcdBarrier& b) {
    asm volatile("s_waitcnt vmcnt(0)" ::: "memory");
    __syncthreads();
    if (threadIdx.x == 0) {
        unsigned* bar = b.bar;
        __builtin_amdgcn_s_waitcnt(0);
        unsigned nloc = b.st[0], nx = b.st[1];
        if (nloc == 0u) { xcd_barrier_complete(bar, b.x, nloc, nx); b.st[0] = nloc; b.st[1] = nx; }
        const unsigned old = xb_add(&bar[XB_XSUB(b.x)], 1u);
        const unsigned gen = old / nloc;
        if (old + 1u == (gen + 1u) * nloc) {
            __builtin_amdgcn_fence(__ATOMIC_RELEASE, "agent");
            asm volatile("s_waitcnt vmcnt(0)" ::: "memory");
            const unsigned og = xb_add(&bar[XB_TOP], 1u);
            const unsigned tg = og / nx;
            if (og + 1u == (tg + 1u) * nx) xb_add(&bar[XB_TOPGEN], 1u);
            else XB_SPIN(xb_ld(&bar[XB_TOPGEN]) == tg, bar);
            __builtin_amdgcn_fence(__ATOMIC_ACQUIRE, "agent");
            xb_add(&bar[XB_XGEN(b.x)], 1u);
            asm volatile("s_waitcnt vmcnt(0)" ::: "memory");
        } else {
            XB_SPIN(xb_ld(&bar[XB_XGEN(b.x)]) == gen, bar);
            __builtin_amdgcn_fence(__ATOMIC_ACQUIRE, "agent");
            asm volatile("s_waitcnt vmcnt(0)" ::: "memory");
        }
    }
    __syncthreads();
}
constexpr int BATCH = 2, SEQ = 8192, DM = 4096, DEPTH = 4, HDIM = 128, H_NA = 8, H_DIL = 12, H_GQA = 12, KV_GQA = 4;
constexpr int NQKV = 10240, DFF = 16384, M = BATCH * SEQ, NMOD = 6;
constexpr int Q_NA = 0, Q_DIL = 1024, Q_GQA = 2560, K_NA = 4096, K_DIL = 5120, K_GQA = 6656, V_NA = 7168, V_DIL = 8192, V_GQA = 9728;
constexpr int O_NA = 0, O_DIL = 1024, O_GQA = 2560, DILW = H_DIL * HDIM;
constexpr float EPS = 1e-6f;
constexpr size_t MiB = 1u << 20;
constexpr size_t WS_CTL = 0, CTL_ZERO_BYTES = 1 * MiB;
constexpr size_t WS_MODP = 1 * MiB;
constexpr size_t WS_MODV = 4 * MiB;
constexpr size_t WS_ROPE = 5 * MiB;
constexpr size_t WS_DILTB = 5 * MiB + 64 * 1024;
constexpr size_t WS_DILST = 6 * MiB;
constexpr size_t WS_WIN = 16 * MiB, WS_WOUT = 336 * MiB, WS_W1 = 464 * MiB, WS_W2 = 976 * MiB;
constexpr size_t WS_H = 1488 * MiB, WS_QKV = 1616 * MiB, WS_O = 1936 * MiB, WS_Y = 2064 * MiB, WS_U = 2320 * MiB, WS_DILP = 2832 * MiB, WS_XB = 2976 * MiB, WS_END = 3104 * MiB;
static_assert(WS_DILST + (size_t)3 * M * 12 * 2 * 4 <= WS_WIN, "ws map");
constexpr int CW_BAR = 4096, CW_QUEUE = 16384;
constexpr int RING_OFF = 0, RING_BYTES = 131072, LDSCTL_OFF = RING_BYTES, MISC_OFF = LDSCTL_OFF + 320, LDS_BYTES = 147456;
constexpr int NWAVES = 8;

struct Frame {
    LAS unsigned char* lds; volatile LAS unsigned* MISC;
    int G;
};
__device__ __forceinline__ float wave_sum(float v) {
#pragma unroll
    for (int o = 1; o < 64; o <<= 1) v += __shfl_xor(v, o);
    return v;
}
__device__ __forceinline__ float bf2f(unsigned short b) { return __uint_as_float(((unsigned)b) << 16); }
struct XItem { const float* src; bf16* dst; int K, N; };
__device__ __forceinline__ void xitem_load(const XItem& it, f32x4 (&wv)[8], int lane) {
    const int lr = lane >> 3, lc = (lane & 7) * 4;
#pragma unroll
    for (int i = 0; i < 8; ++i) wv[i] = __builtin_nontemporal_load((const f32x4*)(it.src + (size_t)(16 * (i >> 1) + 2 * lr + (i & 1)) * it.N + lc));
}
__device__ __forceinline__ void xitem_finish(const XItem& it, const f32x4 (&wv)[8], LAS float* scr, int lane) {
    LAS unsigned* T = (LAS unsigned*)scr; const int lr = lane >> 3, lc = (lane & 7) * 4;
#pragma unroll
    for (int m = 0; m < 4; ++m) { const f32x4 a = wv[2 * m], b = wv[2 * m + 1]; const int kw = 8 * m + lr;
        T[(lc + 0) * 36 + kw] = pg8::cvt_pk_bf16(a.x, b.x); T[(lc + 1) * 36 + kw] = pg8::cvt_pk_bf16(a.y, b.y); T[(lc + 2) * 36 + kw] = pg8::cvt_pk_bf16(a.z, b.z); T[(lc + 3) * 36 + kw] = pg8::cvt_pk_bf16(a.w, b.w); }
    LDS_WAIT(); asm volatile("" ::: "memory");
    const int kq = lane & 7;
#pragma unroll
    for (int j = 0; j < 4; ++j) { const int n = (lane >> 3) + 8 * j; const v4u o = *(const LAS v4u*)(T + n * 36 + kq * 4);
        __builtin_nontemporal_store(o, (GAS v4u*)(it.dst + (size_t)n * it.K + 8 * kq)); }
    LDS_WAIT(); asm volatile("" ::: "memory");
}
__device__ __forceinline__ int t5_bucket_dev(int rel) {
    const int n = rel < 0 ? -rel : rel; int b;
    if (n < 8) b = n; else b = 8 + (n >= 15) + (n >= 27) + (n >= 50) + (n >= 91) + (n >= 166) + (n >= 305) + (n >= 559);
    return (rel > 0 ? 16 : 0) + b;
}

#ifndef PH_MASK
#define PH_MASK 0xFFF
#endif
#define ON(k) (((PH_MASK) >> (k)) & 1)
#define QKVH(head, row) (QKV + ((size_t)(head) * M + (size_t)(row)) * HDIM)
constexpr int I_IN = (DM / 64) * (NQKV / 32), I_OUT = (DM / 64) * (DM / 32), I_1 = (DM / 64) * (DFF / 32), I_2 = (DFF / 64) * (DM / 32), I_LAYER = I_IN + I_OUT + I_1 + I_2;
#ifndef CONV_IN_QUEUE
#define CONV_IN_QUEUE 1
#endif
constexpr int NCONV = 128, CONV_ITEMS = I_LAYER / NCONV;
static_assert(I_LAYER % NCONV == 0 && CONV_ITEMS % 16 == 0 && (I_LAYER - I_IN) % NCONV == 0 && ((I_LAYER - I_IN) / NCONV) % 16 == 0, "conversion chunking: whole chunks, an even item count per wave");
__device__ __forceinline__ XItem conv_item(int l, int r, const float* w_in, const float* w_out, const float* w_mlp_in, const float* w_mlp_out, bf16* WIN, bf16* WOUT, bf16* W1, bf16* W2) {
    const float* W; bf16* WT; int K, N;
    if (r < I_IN) { W = w_in + (size_t)l * DM * NQKV; WT = WIN + (size_t)l * NQKV * DM; K = DM; N = NQKV; }
    else if (r < I_IN + I_OUT) { r -= I_IN; W = w_out + (size_t)l * DM * DM; WT = WOUT + (size_t)l * DM * DM; K = DM; N = DM; }
    else if (r < I_IN + I_OUT + I_1) { r -= I_IN + I_OUT; W = w_mlp_in + (size_t)l * DM * DFF; WT = W1 + (size_t)l * DFF * DM; K = DM; N = DFF; }
    else { r -= I_IN + I_OUT + I_1; W = w_mlp_out + (size_t)l * DFF * DM; WT = W2 + (size_t)l * DM * DFF; K = DFF; N = DM; }
    const int nblk = N / 32, k0 = 64 * (r / nblk), n0 = 32 * (r % nblk);
    XItem it; it.src = W + (size_t)k0 * N + n0; it.dst = WT + (size_t)n0 * K + k0; it.K = K; it.N = N; return it;
}
__device__ __forceinline__ XItem conv_qitem(int l, int q, const float* w_in, const float* w_out, const float* w_mlp_in, const float* w_mlp_out, bf16* WIN, bf16* WOUT, bf16* W1, bf16* W2) {
    return (q < I_LAYER - I_IN) ? conv_item(l, q + I_IN, w_in, w_out, w_mlp_in, w_mlp_out, WIN, WOUT, W1, W2) : conv_item(l + 1, q - (I_LAYER - I_IN), w_in, w_out, w_mlp_in, w_mlp_out, WIN, WOUT, W1, W2);
}
template <bool QMAP> __device__ __forceinline__ void conv_run_t(int l, int first, int step, int end, const float* w_in, const float* w_out, const float* w_mlp_in, const float* w_mlp_out, bf16* WIN, bf16* WOUT, bf16* W1, bf16* W2, LAS float* scr, int lane) {
#define CI_(r) (QMAP ? conv_qitem(l, (r), w_in, w_out, w_mlp_in, w_mlp_out, WIN, WOUT, W1, W2) : conv_item(l, (r), w_in, w_out, w_mlp_in, w_mlp_out, WIN, WOUT, W1, W2))
    if (first >= end) return;
    f32x4 wa[8], wb[8], wc[8], wd[8];
    if ((((end - first) + step - 1) / step) & 1) { const XItem s = CI_(first); xitem_load(s, wa, lane); xitem_finish(s, wa, scr, lane); first += step; if (first >= end) return; }
    XItem a = CI_(first), b = CI_(first + step);
    xitem_load(a, wa, lane); xitem_load(b, wb, lane);
    for (int r = first; r < end; r += 4 * step) {
        const bool more = r + 2 * step < end;
        XItem c = a, d = b; if (more) { c = CI_(r + 2 * step); d = CI_(r + 3 * step); xitem_load(c, wc, lane); xitem_load(d, wd, lane); }
        xitem_finish(a, wa, scr, lane); xitem_finish(b, wb, scr, lane);
        if (!more) break;
        const bool more2 = r + 4 * step < end;
        if (more2) { a = CI_(r + 4 * step); b = CI_(r + 5 * step); xitem_load(a, wa, lane); xitem_load(b, wb, lane); }
        xitem_finish(c, wc, scr, lane); xitem_finish(d, wd, scr, lane);
        if (!more2) break;
    }
#undef CI_
}
struct Args { const float* in[14]; float* out; unsigned char* ws; };

__device__ __forceinline__ f32x4 ld_row4(const void* base, size_t row, int idx, bool is_bf) {
    if (is_bf) { const unsigned long long w = ((const unsigned long long*)((const bf16*)base + row * DM))[idx]; const unsigned lo = (unsigned)w, hi = (unsigned)(w >> 32);
        return (f32x4){__uint_as_float(lo << 16), __uint_as_float(lo & 0xffff0000u), __uint_as_float(hi << 16), __uint_as_float(hi & 0xffff0000u)}; }
    return ((const f32x4*)((const float*)base + row * DM))[idx];
}
template <bool HAS_Y>
__device__ __forceinline__ void norm_phase(Frame& F, const void* xin, bool xin_bf, const bf16* y, void* xout, bool xout_bf, bf16* h, const float* Gv, const float* Av, const float* Bv, int bstride) {
    int tid_ = threadIdx.x; asm volatile("" : "+v"(tid_)); const int tid = tid_, lane = tid & 63, wave = __builtin_amdgcn_readfirstlane(tid >> 6);
    LAS f32x4* Gs = (LAS f32x4*)(F.lds); LAS f32x4* As = (LAS f32x4*)(F.lds + 16384); LAS f32x4* Bs = (LAS f32x4*)(F.lds + 32768);
    for (int chunk = blockIdx.x; chunk < M / 64; chunk += F.G) {
        const int b = chunk / (SEQ / 64);
        __syncthreads();
        for (int i = tid; i < 1024; i += NWAVES * 64) { if (HAS_Y) Gs[i] = ((const f32x4*)(Gv + (size_t)b * bstride))[i]; if (h) { As[i] = ((const f32x4*)(Av + (size_t)b * bstride))[i]; Bs[i] = ((const f32x4*)(Bv + (size_t)b * bstride))[i]; } }
        __syncthreads();
        for (int rr = wave; rr < 64; rr += NWAVES) {
            const size_t row = (size_t)chunk * 64 + rr;
            f32x4 xv[16];
            if (HAS_Y) {
                f32x4 yv[16]; float ss = 0.f;
#pragma unroll
                for (int j = 0; j < 16; ++j) yv[j] = ld_row4(y, row, lane + 64 * j, true);
#pragma unroll
                for (int j = 0; j < 16; ++j) xv[j] = ld_row4(xin, row, lane + 64 * j, xin_bf);
#pragma unroll
                for (int j = 0; j < 16; ++j) { asm volatile("" : "+v"(xv[j]));
                    ss += (yv[j].x * yv[j].x + yv[j].y * yv[j].y) + (yv[j].z * yv[j].z + yv[j].w * yv[j].w); }
                const float ry = 1.0f / sqrtf(wave_sum(ss) * (1.0f / DM) + EPS);
#pragma unroll
                for (int j = 0; j < 16; ++j) { const f32x4 g = Gs[lane + 64 * j]; xv[j] = xv[j] + g * (yv[j] * ry); }
                if (xout_bf) { unsigned long long* xo = (unsigned long long*)((bf16*)xout + row * DM) + lane;
#pragma unroll
                    for (int j = 0; j < 16; ++j) xo[64 * j] = (unsigned long long)pg8::cvt_pk_bf16(xv[j].x, xv[j].y) | ((unsigned long long)pg8::cvt_pk_bf16(xv[j].z, xv[j].w) << 32);
                } else { f32x4* xo = (f32x4*)((float*)xout + row * DM) + lane;
#pragma unroll
                    for (int j = 0; j < 16; ++j) xo[64 * j] = xv[j]; }
            } else {
#pragma unroll
                for (int j = 0; j < 16; ++j) xv[j] = ld_row4(xin, row, lane + 64 * j, xin_bf);
            }
            if (h) {
                float ss = 0.f;
#pragma unroll
                for (int j = 0; j < 16; ++j) ss += (xv[j].x * xv[j].x + xv[j].y * xv[j].y) + (xv[j].z * xv[j].z + xv[j].w * xv[j].w);
                const float rx = 1.0f / sqrtf(wave_sum(ss) * (1.0f / DM) + EPS);
                unsigned long long* ho = (unsigned long long*)(h + row * DM) + lane;
#pragma unroll
                for (int j = 0; j < 16; ++j) { const f32x4 a = As[lane + 64 * j], bb = Bs[lane + 64 * j]; const f32x4 v = a * (xv[j] * rx) + bb;
                    ho[64 * j] = (unsigned long long)pg8::cvt_pk_bf16(v.x, v.y) | ((unsigned long long)pg8::cvt_pk_bf16(v.z, v.w) << 32); }
            }
        }
    }
}

__device__ __forceinline__ void norm_phase_bf(Frame& F, const bf16* xin, const bf16* y, void* xout, bool xout_bf, bf16* h, const float* Gv, const float* Av, const float* Bv, int bstride) {
    int tid_ = threadIdx.x; asm volatile("" : "+v"(tid_)); const int tid = tid_, lane = tid & 63, wave = __builtin_amdgcn_readfirstlane(tid >> 6);
    LAS f32x4* Gs = (LAS f32x4*)(F.lds); LAS f32x4* As = (LAS f32x4*)(F.lds + 16384); LAS f32x4* Bs = (LAS f32x4*)(F.lds + 32768);
    typedef unsigned long long u64;
#define NB_CVT(W) ((f32x4){__uint_as_float((unsigned)(W) << 16), __uint_as_float((unsigned)(W) & 0xffff0000u), __uint_as_float((unsigned)((W) >> 32) << 16), __uint_as_float((unsigned)((W) >> 32) & 0xffff0000u)})
#define NB_LOAD(YR, XR, ROW) do { _Pragma("unroll") for (int j = 0; j < 16; ++j) { YR[j] = ((const u64*)(y + (ROW) * DM))[lane + 64 * j]; XR[j] = ((const u64*)(xin + (ROW) * DM))[lane + 64 * j]; } } while (0)
#define NB_PIN(YR, XR) do { _Pragma("unroll") for (int j = 0; j < 16; ++j) { asm volatile("" : "+v"(YR[j])); asm volatile("" : "+v"(XR[j])); } } while (0)
#define NB_ROW(YR, XR, ROW) do { int lq = lane; asm volatile("" : "+v"(lq)); float ss = 0.f; f32x4 xv[16]; \
        _Pragma("unroll") for (int j = 0; j < 16; ++j) { const f32x4 yv = NB_CVT(YR[j]); ss += (yv.x * yv.x + yv.y * yv.y) + (yv.z * yv.z + yv.w * yv.w); } \
        const float ry = 1.0f / sqrtf(wave_sum(ss) * (1.0f / DM) + EPS); \
        _Pragma("unroll") for (int j = 0; j < 16; ++j) { const f32x4 g = Gs[lq + 64 * j]; xv[j] = NB_CVT(XR[j]) + g * (NB_CVT(YR[j]) * ry); } \
        if (xout_bf) { u64* xo = (u64*)((bf16*)xout + (ROW) * DM) + lane; \
            _Pragma("unroll") for (int j = 0; j < 16; ++j) xo[64 * j] = (u64)pg8::cvt_pk_bf16(xv[j].x, xv[j].y) | ((u64)pg8::cvt_pk_bf16(xv[j].z, xv[j].w) << 32); \
        } else { f32x4* xo = (f32x4*)((float*)xout + (ROW) * DM) + lane; \
            _Pragma("unroll") for (int j = 0; j < 16; ++j) xo[64 * j] = xv[j]; } \
        if (h) { float s2 = 0.f; \
            _Pragma("unroll") for (int j = 0; j < 16; ++j) s2 += (xv[j].x * xv[j].x + xv[j].y * xv[j].y) + (xv[j].z * xv[j].z + xv[j].w * xv[j].w); \
            const float rx = 1.0f / sqrtf(wave_sum(s2) * (1.0f / DM) + EPS); \
            u64* ho = (u64*)(h + (ROW) * DM) + lane; \
            _Pragma("unroll") for (int j = 0; j < 16; ++j) { const f32x4 a = As[lq + 64 * j], bb = Bs[lq + 64 * j]; const f32x4 v = a * (xv[j] * rx) + bb; \
                ho[64 * j] = (u64)pg8::cvt_pk_bf16(v.x, v.y) | ((u64)pg8::cvt_pk_bf16(v.z, v.w) << 32); } } } while (0)
    for (int chunk = blockIdx.x; chunk < M / 64; chunk += F.G) {
        const int b = chunk / (SEQ / 64);
        const size_t row0 = (size_t)chunk * 64 + wave;
        u64 yA[16], xA[16], yB[16], xB[16];
        NB_LOAD(yA, xA, row0);
        __syncthreads();
        for (int i = tid; i < 1024; i += NWAVES * 64) { Gs[i] = ((const f32x4*)(Gv + (size_t)b * bstride))[i]; if (h) { As[i] = ((const f32x4*)(Av + (size_t)b * bstride))[i]; Bs[i] = ((const f32x4*)(Bv + (size_t)b * bstride))[i]; } }
        __syncthreads();
#pragma unroll 1
        for (int it = 0; it < 4; ++it) {
            const size_t ra = row0 + 16 * it, rb = ra + 8;
            NB_LOAD(yB, xB, rb); NB_PIN(yA, xA);
            NB_ROW(yA, xA, ra);
            if (it < 3) { NB_LOAD(yA, xA, rb + 8); }
            NB_PIN(yB, xB);
            NB_ROW(yB, xB, rb);
        }
    }
#undef NB_CVT
#undef NB_LOAD
#undef NB_PIN
#undef NB_ROW
}

typedef __attribute__((address_space(4))) const unsigned char ckb_t;
__device__ __forceinline__ const void* karg(int i) { ckb_t* kp = (ckb_t*)__builtin_amdgcn_kernarg_segment_ptr(); asm volatile("" : "+s"(kp)); return *(const void* const __attribute__((address_space(4)))*)(kp + 8 * i); }
#define KIN(i) ((const float*)karg(i))
#define KOUT() ((float*)karg(14))
#define KWS() ((unsigned char*)karg(15))
__global__ void __launch_bounds__(NWAVES * 64, 2) mega_fwd(Args args_unused) {
    extern __shared__ __attribute__((aligned(16))) unsigned char lds[];
    Frame F;
    F.lds = (LAS unsigned char*)lds; F.MISC = (volatile LAS unsigned*)(F.lds + MISC_OFF); F.G = gridDim.x;
    for (int u = threadIdx.x; u < (LDS_BYTES - LDSCTL_OFF) / 4; u += NWAVES * 64) ((LAS unsigned*)(F.lds + LDSCTL_OFF))[u] = 0u;
    __syncthreads();
    (void)xcd_barrier_post((unsigned*)((gu32*)(KWS() + WS_CTL) + CW_BAR), F.MISC + 8);
#define GRID_BAR() do { XcdBarrier bar_; bar_.bar = (unsigned*)((gu32*)(KWS() + WS_CTL) + CW_BAR); bar_.x = xb_xcc_id(); bar_.st = (volatile LAS unsigned*)(F.lds + MISC_OFF) + 8; xcd_barrier(bar_); } while (0)
#define FRESH_IDS() int tid_ = threadIdx.x; asm volatile("" : "+v"(tid_)); const int ftid = tid_, flane = ftid & 63, fwave = __builtin_amdgcn_readfirstlane(ftid >> 6); \
    const int gw = blockIdx.x * NWAVES + fwave, NGW = F.G * NWAVES, gtid = blockIdx.x * (NWAVES * 64) + ftid, NGT = F.G * NWAVES * 64; (void)flane; (void)gw; (void)NGW; (void)gtid; (void)NGT
#define WSP(T, off) ((T*)(ws + (off)))
#ifndef DUP_GEMM
#define DUP_GEMM 0
#endif
#ifndef XBF16
#define XBF16 1
#endif
#ifndef DUP_NORM
#define DUP_NORM 0
#endif
#ifndef DUP_P0C
#define DUP_P0C 0
#endif
#ifndef XBAR
#define XBAR 0
#endif
#ifndef DUP_G0
#define DUP_G0 0
#endif
#ifndef DUP_G1
#define DUP_G1 0
#endif
#ifndef DUP_G2
#define DUP_G2 0
#endif
#ifndef DUP_G3
#define DUP_G3 0
#endif
#ifndef DUP_NA
#define DUP_NA 0
#endif
#ifndef DUP_DIL
#define DUP_DIL 0
#endif
#ifndef DUP_GQA
#define DUP_GQA 0
#endif
#ifndef DUP_ATT
#define DUP_ATT 0
#endif
#ifndef DUP_P0A
#define DUP_P0A 0
#endif
#ifndef DUPBAR
#define DUPBAR 0
#endif
#define REPBAR() do { if (DUPBAR && rep_ > 0) GRID_BAR(); } while (0)
#define REPEAT(n) for (int rep_ = 0, nrep_ = __builtin_amdgcn_readfirstlane(1 + (n)); rep_ < nrep_; ++rep_)

    if (ON(0)) REPEAT(DUP_P0A)
    {
        FRESH_IDS(); unsigned char* ws = KWS(); const float* in_c = KIN(1); const float* ada_w = KIN(2); float* MODP = WSP(float, WS_MODP);
        for (int task = gw; task < 96 * 16; task += NGW) {
            const int cg = task % 96, kc = task / 96; const int col = cg * 256 + flane * 4;
            f32x4 a0 = {0.f, 0.f, 0.f, 0.f}, a1 = {0.f, 0.f, 0.f, 0.f};
            const float* wp = ada_w + (size_t)(kc * 256) * (NMOD * DM) + col;
#pragma unroll 8
            for (int k = 0; k < 256; ++k) {
                const f32x4 w = *(const f32x4*)(wp + (size_t)k * (NMOD * DM));
                const float c0 = in_c[kc * 256 + k], c1 = in_c[DM + kc * 256 + k];
                const float s0 = c0 / (1.0f + __expf(-c0)), s1 = c1 / (1.0f + __expf(-c1));
                a0 = a0 + w * s0; a1 = a1 + w * s1;
            }
            *(f32x4*)(MODP + ((size_t)(kc * 2 + 0) * (NMOD * DM)) + col) = a0;
            *(f32x4*)(MODP + ((size_t)(kc * 2 + 1) * (NMOD * DM)) + col) = a1;
        }
        LAS float* scr = (LAS float*)(F.lds + RING_OFF + fwave * 16384);
        const float* w_in = KIN(6); const float* w_out = KIN(7); const float* w_mlp_in = KIN(12); const float* w_mlp_out = KIN(13);
        bf16* WIN = WSP(bf16, WS_WIN); bf16* WOUT = WSP(bf16, WS_WOUT); bf16* W1 = WSP(bf16, WS_W1); bf16* W2 = WSP(bf16, WS_W2);
        if (CONV_IN_QUEUE) conv_run_t<false>(0, gw, NGW, I_IN, w_in, w_out, w_mlp_in, w_mlp_out, WIN, WOUT, W1, W2, scr, flane);
        else for (int cl_ = 0; cl_ < DEPTH; ++cl_) conv_run_t<false>(cl_, gw, NGW, I_LAYER, w_in, w_out, w_mlp_in, w_mlp_out, WIN, WOUT, W1, W2, scr, flane);
    }
    GRID_BAR();
    if (ON(1))
    {
        FRESH_IDS(); unsigned char* ws = KWS(); const float* ada_b = KIN(3); const float* ada_emb = KIN(4); const float* gains = KIN(5); const float* t5_table = KIN(11);
        float* MODP = WSP(float, WS_MODP); float* MODV = WSP(float, WS_MODV); float* ROPE = WSP(float, WS_ROPE); float* DILTB = WSP(float, WS_DILTB);
        for (int i = gtid; i < DEPTH * 2 * NMOD * DM; i += NGT) {
            const int col = i % DM, j = (i / DM) % NMOD, b = (i / (DM * NMOD)) % 2, l = i / (DM * NMOD * 2);
            float m = ada_b[j * DM + col];
#pragma unroll
            for (int kc = 0; kc < 16; ++kc) m += MODP[(size_t)(kc * 2 + b) * (NMOD * DM) + j * DM + col];
            m += ada_emb[((size_t)l * NMOD + j) * DM + col];
            const float* gl = gains + (size_t)l * 4 * DM;
            float v;
            if (j == 0) v = m; else if (j == 1) v = gl[0 * DM + col] * (1.0f + m); else if (j == 2) v = m * gl[1 * DM + col];
            else if (j == 3) v = m; else if (j == 4) v = gl[2 * DM + col] * (1.0f + m); else v = m * gl[3 * DM + col];
            MODV[i] = v;
        }
        if (blockIdx.x == 0 && ftid < 32) {
            const int f = ftid; const double th = (double)__builtin_amdgcn_exp2f(-(float)f * 0.41524101186092029f);
            double c1 = 1.0, s1 = th, tc = 1.0, ts = th; const double x2 = th * th;
            for (int n = 1; n <= 12; ++n) { tc *= -x2 / (double)((2 * n - 1) * (2 * n)); ts *= -x2 / (double)((2 * n) * (2 * n + 1)); c1 += tc; s1 += ts; }
            double c = 1.0, s = 0.0;
            for (int pos = 0; pos < 128; ++pos) { ROPE[pos * 32 + f] = (float)c; ROPE[4096 + pos * 32 + f] = (float)s; const double cn = c * c1 - s * s1; s = s * c1 + c * s1; c = cn; }
        }
        if (blockIdx.x == 1 || F.G == 1) {
            for (int i = ftid; i < 3 * H_DIL * 129; i += NWAVES * 64) { const int p = i / (H_DIL * 129), hh = (i / 129) % H_DIL, jj = i % 129 - 64; const int d = p == 0 ? 1 : (p == 1 ? 4 : 16);
                DILTB[i] = t5_table[t5_bucket_dev(jj * d) * H_DIL + hh]; }
        }
    }
    GRID_BAR();
    if (ON(2))
    REPEAT(DUP_P0C) { unsigned char* ws = KWS(); float* MODV = WSP(float, WS_MODV);
      norm_phase<false>(F, KIN(0), false, nullptr, nullptr, false, WSP(bf16, WS_H), nullptr, MODV + 1 * DM, MODV + 0 * DM, NMOD * DM); }
    GRID_BAR();

    for (int l = 0; l < DEPTH; ++l) {
        for (int xb_ = 0; xb_ < XBAR; ++xb_) GRID_BAR();
    if (ON(3)) REPEAT(DUP_GEMM + DUP_G0)
        {
            REPBAR();
            unsigned char* ws = KWS();
            pg8::Gemm g{WSP(bf16, WS_H), WSP(bf16, WS_WIN) + (size_t)l * NQKV * DM, M, NQKV, DM}; pg8::StaticOrder S; S.init(M, NQKV, F.G, (int)blockIdx.x);
            pg8::EpiQKV E{WSP(bf16, WS_QKV), M};
            pg8::gemm_phase<pg8::EpiQKV, pg8::StaticOrder, true, true>(F.lds + RING_OFF, g, S, E);
        }
        GRID_BAR();
    if (ON(4))
        {
            FRESH_IDS(); const int i16 = ftid & 15; const int g16 = gtid >> 4, NG16 = NGT >> 4;
            unsigned char* ws = KWS(); bf16* QKV = WSP(bf16, WS_QKV); const float* ROPE = WSP(float, WS_ROPE); const float* q_gain = KIN(8); const float* k_gain = KIN(9);
            for (int task = g16; task < KV_GQA * (M / 8); task += NG16) {
                const int hh = task >> 11, row0 = (task & (M / 8 - 1)) * 8;
                const int head = K_GQA / HDIM + hh;
                const float* gp = k_gain + l * HDIM + 8 * i16;
                bf16* p = QKVH(head, row0) + 8 * i16;
                const int jj = i16 & 7, fb = 8 * (jj & 3);
                v4u raw[8]; f32x4 c0[8], c1[8], s0[8], s1[8];
#pragma unroll
                for (int k = 0; k < 8; ++k) raw[k] = *(const v4u*)(p + (size_t)k * HDIM);
                const f32x4 g0 = *(const f32x4*)gp, g1 = *(const f32x4*)(gp + 4);
#pragma unroll
                for (int k = 0; k < 8; ++k) { const int t = (row0 + k) & (SEQ - 1); const int pos = (i16 < 8) ? (t >> 6) : (t & 63); const float* rp = ROPE + pos * 32 + fb;
                    c0[k] = *(const f32x4*)rp; c1[k] = *(const f32x4*)(rp + 4); s0[k] = *(const f32x4*)(rp + 4096); s1[k] = *(const f32x4*)(rp + 4100); }
#pragma unroll
                for (int k = 0; k < 8; ++k) {
                    float x[8];
                    x[0] = __uint_as_float(raw[k].x << 16); x[1] = __uint_as_float(raw[k].x & 0xffff0000u); x[2] = __uint_as_float(raw[k].y << 16); x[3] = __uint_as_float(raw[k].y & 0xffff0000u);
                    x[4] = __uint_as_float(raw[k].z << 16); x[5] = __uint_as_float(raw[k].z & 0xffff0000u); x[6] = __uint_as_float(raw[k].w << 16); x[7] = __uint_as_float(raw[k].w & 0xffff0000u);
                    float ss = 0.f;
#pragma unroll
                    for (int e = 0; e < 8; ++e) ss += x[e] * x[e];
                    ss += __shfl_xor(ss, 1); ss += __shfl_xor(ss, 2); ss += __shfl_xor(ss, 4); ss += __shfl_xor(ss, 8);
                    const float rstd = 1.0f / sqrtf(ss * (1.0f / HDIM) + EPS);
                    x[0] *= rstd * g0.x; x[1] *= rstd * g0.y; x[2] *= rstd * g0.z; x[3] *= rstd * g0.w; x[4] *= rstd * g1.x; x[5] *= rstd * g1.y; x[6] *= rstd * g1.z; x[7] *= rstd * g1.w;
                    const float cs[8] = {c0[k].x, c0[k].y, c0[k].z, c0[k].w, c1[k].x, c1[k].y, c1[k].z, c1[k].w}; const float sn[8] = {s0[k].x, s0[k].y, s0[k].z, s0[k].w, s1[k].x, s1[k].y, s1[k].z, s1[k].w};
                    float o[8];
#pragma unroll
                    for (int e = 0; e < 8; ++e) { const float pv = __shfl_xor(x[e], 4); o[e] = (jj < 4) ? (x[e] * cs[e] - pv * sn[e]) : (pv * sn[e] + x[e] * cs[e]); }
                    v4u w; w.x = pg8::cvt_pk_bf16(o[0], o[1]); w.y = pg8::cvt_pk_bf16(o[2], o[3]); w.z = pg8::cvt_pk_bf16(o[4], o[5]); w.w = pg8::cvt_pk_bf16(o[6], o[7]);
                    *(v4u*)(p + (size_t)k * HDIM) = w;
                }
            }
        }
    if (ON(5))
        {
            char* alds = (char*)lds + RING_OFF;
            (void)alds;
        }
        GRID_BAR();
    if (ON(5)) REPEAT(DUP_ATT)
        {
            char* alds = (char*)lds + RING_OFF;
            { unsigned char* ws = KWS(); bf16* QKV = WSP(bf16, WS_QKV); bf16* O = WSP(bf16, WS_O); const float* na_rpb = KIN(10);
              bf16* DILP = WSP(bf16, WS_DILP); float* DILST = WSP(float, WS_DILST); const float* DILTB = WSP(float, WS_DILTB);
              gu32* qhead = (gu32*)(ws + WS_CTL) + CW_QUEUE + 64 * l; volatile LAS unsigned* qslot = (volatile LAS unsigned*)(F.lds + MISC_OFF) + 16;
              const int nconv = CONV_IN_QUEUE ? NCONV : 0;
              bool gqa_fast;
              { int tid_ = threadIdx.x; asm volatile("" : "+v"(tid_)); const int gl = tid_ & 63; const float* qgp = KIN(8) + l * HDIM; const float* kgp = KIN(9) + l * HDIM;
                const bool small = fabsf(qgp[gl]) <= 1.96f && fabsf(qgp[gl + 64]) <= 1.96f && fabsf(kgp[gl]) <= 1.96f && fabsf(kgp[gl + 64]) <= 1.96f;
                gqa_fast = __all(small) != 0; }
              unsigned nx_ = 0u; if (threadIdx.x == 0) nx_ = __hip_atomic_fetch_add(qhead, 1u, RLX_AGENT);
              for (int guard_ = 0; guard_ < 4096; ++guard_) {
                __syncthreads();
                if (threadIdx.x == 0) qslot[0] = nx_;
                __syncthreads();
                const int uq = (int)__builtin_amdgcn_readfirstlane(qslot[0]);
                if (uq >= 768 + nconv + 2816) break;
                if (threadIdx.x == 0) nx_ = __hip_atomic_fetch_add(qhead, 1u, RLX_AGENT);
                int u;
                if (uq < 768 + nconv) {
                    if (nconv && uq % 7 == 6) {
                        int tid_ = threadIdx.x; asm volatile("" : "+v"(tid_)); const int cl = tid_ & 63, cw = __builtin_amdgcn_readfirstlane(tid_ >> 6);
                        LAS float* scr = (LAS float*)(F.lds + RING_OFF + cw * 16384); const int citems = (l + 1 < DEPTH) ? CONV_ITEMS : (I_LAYER - I_IN) / NCONV, c0 = (uq / 7) * citems;
                        const float* w_in = KIN(6); const float* w_out = KIN(7); const float* w_mlp_in = KIN(12); const float* w_mlp_out = KIN(13);
                        conv_run_t<true>(l, c0 + cw, NWAVES, c0 + citems, w_in, w_out, w_mlp_in, w_mlp_out, WSP(bf16, WS_WIN), WSP(bf16, WS_WOUT), WSP(bf16, WS_W1), WSP(bf16, WS_W2), scr, cl);
                        continue;
                    }
                    u = nconv ? uq - uq / 7 : uq;
                } else u = uq - nconv;
                if (u < 768) {
                    const int grp = u / 96, within = u % 96; const int b = grp >> 2, kvh = grp & 3, hq = kvh * 3 + within / 32, qb = within % 32;
                    const size_t r0 = (size_t)b * SEQ + (size_t)qb * 256;
                    if (gqa_fast) att::attn_unit<0, true>(QKVH(Q_GQA / HDIM + hq, r0), HDIM, QKVH(K_GQA / HDIM + kvh, (size_t)b * SEQ), QKVH(V_GQA / HDIM + kvh, (size_t)b * SEQ), HDIM,
                                      0, SEQ / 64, SEQ / 64, O + r0 * DM + O_GQA + hq * HDIM, DM, nullptr, 0, 0, nullptr, 0, alds, KIN(8) + l * HDIM, WSP(float, WS_ROPE), qb * 256);
                    else att::attn_unit<0, false>(QKVH(Q_GQA / HDIM + hq, r0), HDIM, QKVH(K_GQA / HDIM + kvh, (size_t)b * SEQ), QKVH(V_GQA / HDIM + kvh, (size_t)b * SEQ), HDIM,
                                      0, SEQ / 64, SEQ / 64, O + r0 * DM + O_GQA + hq * HDIM, DM, nullptr, 0, 0, nullptr, 0, alds, KIN(8) + l * HDIM, WSP(float, WS_ROPE), qb * 256);
                    continue;
                }
                if (u < 768 + 512) {
                    const int un = u - 768; const int b = un >> 8, hh = (un >> 5) & 7, qb = un & 31; const size_t r0 = (size_t)b * SEQ + (size_t)qb * 256;
                    att::attn_unit<1>(QKVH(Q_NA / HDIM + hh, r0), HDIM, QKVH(K_NA / HDIM + hh, (size_t)b * SEQ), QKVH(V_NA / HDIM + hh, (size_t)b * SEQ), HDIM,
                                      qb * 4 - 4, 12, SEQ / 64, O + r0 * DM + O_NA + hh * HDIM, DM, nullptr, 0, qb * 4, na_rpb + ((size_t)l * H_NA + hh) * 465, 465, alds);
                } else {
                    const int v = u - 768 - 512, p = v / 768, w = v % 768, pair = w >> 5, b = pair / H_DIL, hh = pair % H_DIL, blk = w & 31;
                    const int d = p == 0 ? 1 : (p == 1 ? 4 : 16), nub = 32 / d, res = blk / nub, ub = blk % nub, u0 = ub * 256, L = SEQ / d;
                    const size_t rq = (size_t)b * SEQ + (size_t)u0 * d + res, rk = (size_t)b * SEQ + res;
                    att::attn_unit<2>(QKVH(Q_DIL / HDIM + hh, rq), (long)d * HDIM, QKVH(K_DIL / HDIM + hh, rk), QKVH(V_DIL / HDIM + hh, rk), (long)d * HDIM,
                                      u0 / 64 - 1, 6, L / 64, DILP + (size_t)p * M * DILW + rq * DILW + hh * HDIM, (long)d * DILW,
                                      DILST + (((size_t)p * M + rq) * H_DIL + hh) * 2, (long)d * H_DIL * 2, u0, DILTB + (p * H_DIL + hh) * 129, 129, alds);
                }
              } }
        }
        GRID_BAR();
    if (ON(6))
        {
            FRESH_IDS(); const int i16 = ftid & 15; const int g16 = gtid >> 4, NG16 = NGT >> 4;
            unsigned char* ws = KWS(); bf16* O = WSP(bf16, WS_O); const bf16* DILP = WSP(bf16, WS_DILP); const float* DILST = WSP(float, WS_DILST);
            typedef float f32x2v __attribute__((ext_vector_type(2)));
            for (int task0 = g16; task0 < M * H_DIL; task0 += 8 * NG16) {
                f32x2v st[8][3]; v4u raw[8][3];
#pragma unroll
                for (int k = 0; k < 8; ++k) { const int task = task0 + k * NG16; const bool on = task < M * H_DIL; const int tt = on ? task : task0; const int row = tt / H_DIL, hh = tt % H_DIL;
#pragma unroll
                    for (int p = 0; p < 3; ++p) { st[k][p] = *(const f32x2v*)(DILST + (((size_t)p * M + row) * H_DIL + hh) * 2); raw[k][p] = *(const v4u*)(DILP + (size_t)p * M * DILW + (size_t)row * DILW + hh * HDIM + 8 * i16); } }
#pragma unroll
                for (int k = 0; k < 8; ++k) { const int task = task0 + k * NG16; if (task < M * H_DIL) { const int row = task / H_DIL, hh = task % H_DIL;
                    const float mx = fmaxf(st[k][0].x, fmaxf(st[k][1].x, st[k][2].x));
                    float wv[3]; float wsum = 0.f;
#pragma unroll
                    for (int p = 0; p < 3; ++p) { wv[p] = st[k][p].y * __builtin_amdgcn_exp2f(st[k][p].x - mx); wsum += wv[p]; }
                    const float inv = 1.0f / wsum;
                    float acc[8] = {0.f, 0.f, 0.f, 0.f, 0.f, 0.f, 0.f, 0.f};
#pragma unroll
                    for (int p = 0; p < 3; ++p) { const v4u r = raw[k][p]; const float wp = wv[p] * inv;
                        acc[0] += wp * __uint_as_float(r.x << 16); acc[1] += wp * __uint_as_float(r.x & 0xffff0000u); acc[2] += wp * __uint_as_float(r.y << 16); acc[3] += wp * __uint_as_float(r.y & 0xffff0000u);
                        acc[4] += wp * __uint_as_float(r.z << 16); acc[5] += wp * __uint_as_float(r.z & 0xffff0000u); acc[6] += wp * __uint_as_float(r.w << 16); acc[7] += wp * __uint_as_float(r.w & 0xffff0000u); }
                    v4u w; w.x = pg8::cvt_pk_bf16(acc[0], acc[1]); w.y = pg8::cvt_pk_bf16(acc[2], acc[3]); w.z = pg8::cvt_pk_bf16(acc[4], acc[5]); w.w = pg8::cvt_pk_bf16(acc[6], acc[7]);
                    *(v4u*)(O + (size_t)row * DM + O_DIL + hh * HDIM + 8 * i16) = w; } }
            }
        }
        GRID_BAR();
    if (ON(7)) REPEAT(DUP_GEMM + DUP_G1)
        {
            REPBAR();
            unsigned char* ws = KWS();
            pg8::Gemm g{WSP(bf16, WS_O), WSP(bf16, WS_WOUT) + (size_t)l * DM * DM, M, DM, DM}; pg8::StaticOrder S; S.init(M, DM, F.G, (int)blockIdx.x);
            pg8::EpiBf16<0> E{WSP(bf16, WS_Y), DM};
            pg8::gemm_phase<pg8::EpiBf16<0>, pg8::StaticOrder, true, true>(F.lds + RING_OFF, g, S, E);
        }
        GRID_BAR();
    if (ON(8))
        { unsigned char* ws = KWS(); const float* mv = WSP(float, WS_MODV) + (size_t)l * 2 * NMOD * DM;
#if DUP_NORM
          norm_phase<true>(F, l == 0 ? (const void*)KIN(0) : (const void*)KOUT(), false, WSP(bf16, WS_Y), WSP(float, WS_U), false, WSP(bf16, WS_U + 256 * MiB), mv + 2 * DM, mv + 4 * DM, mv + 3 * DM, NMOD * DM);
#endif
#if XBF16
          if (l == 0) norm_phase<true>(F, (const void*)KIN(0), false, WSP(bf16, WS_Y), WSP(bf16, WS_XB), true, WSP(bf16, WS_H), mv + 2 * DM, mv + 4 * DM, mv + 3 * DM, NMOD * DM);
          else norm_phase_bf(F, WSP(bf16, WS_XB), WSP(bf16, WS_Y), WSP(bf16, WS_XB), true, WSP(bf16, WS_H), mv + 2 * DM, mv + 4 * DM, mv + 3 * DM, NMOD * DM); }
#else
          norm_phase<true>(F, l == 0 ? (const void*)KIN(0) : (const void*)KOUT(), false, WSP(bf16, WS_Y), KOUT(), false, WSP(bf16, WS_H), mv + 2 * DM, mv + 4 * DM, mv + 3 * DM, NMOD * DM); }
#endif
        GRID_BAR();
    if (ON(9)) REPEAT(DUP_GEMM + DUP_G2)
        {
            REPBAR();
            unsigned char* ws = KWS();
            pg8::Gemm g{WSP(bf16, WS_H), WSP(bf16, WS_W1) + (size_t)l * DFF * DM, M, DFF, DM}; pg8::StaticOrder S; S.init(M, DFF, F.G, (int)blockIdx.x);
            pg8::EpiBf16<3> E{WSP(bf16, WS_U), DFF};
            pg8::gemm_phase<pg8::EpiBf16<3>, pg8::StaticOrder, true, true>(F.lds + RING_OFF, g, S, E);
        }
        GRID_BAR();
    if (ON(10)) REPEAT(DUP_GEMM + DUP_G3)
        {
            REPBAR();
            unsigned char* ws = KWS();
            pg8::Gemm g{WSP(bf16, WS_U), WSP(bf16, WS_W2) + (size_t)l * DM * DFF, M, DM, DFF}; pg8::StaticOrder S; S.init(M, DM, F.G, (int)blockIdx.x);
            pg8::EpiBf16<0> E{WSP(bf16, WS_Y), DM};
            pg8::gemm_phase<pg8::EpiBf16<0>, pg8::StaticOrder, true, true>(F.lds + RING_OFF, g, S, E);
        }
        GRID_BAR();
    if (ON(11))
        {
            unsigned char* ws = KWS(); const float* mv = WSP(float, WS_MODV) + (size_t)l * 2 * NMOD * DM; float* out = KOUT();
            const float* mvn = WSP(float, WS_MODV) + (size_t)(l + 1 < DEPTH ? l + 1 : l) * 2 * NMOD * DM;
#if XBF16
            norm_phase_bf(F, WSP(bf16, WS_XB), WSP(bf16, WS_Y), (l + 1 < DEPTH) ? (void*)WSP(bf16, WS_XB) : (void*)out, l + 1 < DEPTH, (l + 1 < DEPTH) ? WSP(bf16, WS_H) : (bf16*)nullptr, mv + 5 * DM, mvn + 1 * DM, mvn + 0 * DM, NMOD * DM);
#else
            norm_phase<true>(F, out, false, WSP(bf16, WS_Y), out, false, (l + 1 < DEPTH) ? WSP(bf16, WS_H) : (bf16*)nullptr, mv + 5 * DM, mvn + 1 * DM, mvn + 0 * DM, NMOD * DM);
#endif
        }
        if (l + 1 < DEPTH) GRID_BAR();
    }
    __syncthreads();
    if (__hip_atomic_load((gu32*)(KWS() + WS_CTL) + CW_BAR + XB_TMO, RLX_AGENT) != 0u) {
        const float q = __builtin_nanf(""); float* out = KOUT();
        for (int chunk = blockIdx.x; chunk < M / 64; chunk += F.G) for (int i = threadIdx.x; i < 64 * DM / 4; i += NWAVES * 64) ((f32x4*)(out + (size_t)chunk * 64 * DM))[i] = (f32x4){q, q, q, q};
    }
}

extern "C" void kernel_launch(void* const* d_in, const int* in_sizes, int n_in, void* d_out, int out_size, void* d_ws, size_t ws_size, hipStream_t stream) {
    static int grid = 0;
    if (grid == 0) {
        if (n_in != 14 || in_sizes[0] != M * DM || out_size != M * DM || ws_size < WS_END) { fprintf(stderr, "kernel_launch: shape/workspace mismatch (n_in %d, in0 %d, out %d, ws %zu, need %zu)\n", n_in, n_in > 0 ? in_sizes[0] : -1, out_size, ws_size, (size_t)WS_END); grid = -1; return; }
        int dev = 0, cus = 0, per_cu = 0;
        if (hipGetDevice(&dev) != hipSuccess || hipDeviceGetAttribute(&cus, hipDeviceAttributeMultiprocessorCount, dev) != hipSuccess) { grid = -1; return; }
        if (hipFuncSetAttribute((const void*)mega_fwd, hipFuncAttributeMaxDynamicSharedMemorySize, LDS_BYTES) != hipSuccess) { fprintf(stderr, "kernel_launch: hipFuncSetAttribute failed\n"); grid = -1; return; }
        if (hipOccupancyMaxActiveBlocksPerMultiprocessor(&per_cu, (const void*)mega_fwd, NWAVES * 64, LDS_BYTES) != hipSuccess || per_cu < 1) { fprintf(stderr, "kernel_launch: occupancy query reports %d blocks per CU\n", per_cu); }
        (void)hipGetLastError();
        grid = cus;
    }
    if (grid < 0) return;
    if (hipMemsetAsync((char*)d_ws + WS_CTL, 0, CTL_ZERO_BYTES, stream) != hipSuccess) return;
    Args a{};
    for (int i = 0; i < 14; ++i) a.in[i] = (const float*)d_in[i];
    a.out = (float*)d_out; a.ws = (unsigned char*)d_ws;
    hipLaunchKernelGGL(mega_fwd, dim3(grid), dim3(NWAVES * 64), LDS_BYTES, stream, a);
    const hipError_t le = hipPeekAtLastError();
    if (le != hipSuccess) fprintf(stderr, "kernel_launch: launch failed: %s\n", hipGetErrorName(le));
}
```

```cpp
#include <hip/hip_runtime.h>
#include <cstdio>
#include <cstdint>
namespace pg8 {
#define PG8_LAS __attribute__((address_space(3)))
typedef unsigned short bf16_t;
typedef short bf16x8 __attribute__((ext_vector_type(8)));
typedef float f32x4 __attribute__((ext_vector_type(4)));
typedef unsigned u32x4 __attribute__((ext_vector_type(4)));
constexpr int BM = 256, BK = 64, HALF = 128, HTB = HALF * BK * 2  , STAGE_BYTES = 8 * HTB, NXCD = 8, WGM = 8;

__host__ __device__ __forceinline__ int lds_byte(int r, int c) { const int st = (r >> 4) * 2 + (c >> 5), rr = r & 15, cc = c & 31, ob = rr * 64 + cc * 2; return st * 1024 + (ob ^ (((ob >> 9) & 1) << 5)); }
__host__ __device__ __forceinline__ void stage_rc(int b, int& R, int& C) { const int st = b / 1024, sb = b % 1024, swz = sb ^ (((sb >> 9) & 1) << 5); R = (st >> 1) * 16 + swz / 64; C = (st & 1) * 32 + (swz % 64) / 2; }
__host__ __device__ __forceinline__ int perm32(int rho) { const int n = rho >> 4, i = rho & 15; return 8 * (i >> 2) + 4 * n + (i & 3); }

struct Unit { int pm, pn; };
struct Gemm { const bf16_t* A; const bf16_t* Bt; int M, N, K; };

struct StaticOrder {
    int nM, nN, nwg, G, c;
    __host__ __device__ void init(int M, int N, int G_, int c_) { nM = M / BM; nN = N / BM; nwg = nM * nN; G = G_; c = c_; }
    __host__ __device__ bool next(int i, Unit& u) const {
        const long L = (long)i * G + c; if (L >= nwg) return false;
        int wgid = (int)L; { const int q = nwg / NXCD, r = nwg % NXCD, xcd = wgid % NXCD, off = wgid / NXCD; wgid = (xcd < r ? xcd * (q + 1) : r * (q + 1) + (xcd - r) * q) + off; }
        const int nig = WGM * nN, gid = wgid / nig, fm = gid * WGM, gsz = (nM - fm) < WGM ? (nM - fm) : WGM;
        u.pm = fm + ((wgid % nig) % gsz); u.pn = (wgid % nig) / gsz; return true;
    }
    __device__ __forceinline__ void a_ready(const Unit&) const {}
    __device__ __forceinline__ void done(const Unit&) const {}
};

__device__ __forceinline__ unsigned cvt_pk_bf16(float lo, float hi) { unsigned r; asm volatile("v_cvt_pk_bf16_f32 %0, %1, %2" : "=v"(r) : "v"(lo), "v"(hi)); return r; }
typedef float f32x2 __attribute__((ext_vector_type(2)));
struct EpiF32 {
    static constexpr bool PERM = false, AFTER_DRAIN = false;
    float* C; int ldc;
    __device__ __forceinline__ void operator()(const f32x4 (&acc)[2][2][4][2], const Unit& u, int wr, int wc, int fr, int fq) const {
        const int row0 = u.pm * BM + wr * 64 + fr, col0 = u.pn * BM + wc * 32 + 4 * fq;
#pragma unroll
        for (int ai = 0; ai < 2; ++ai)
#pragma unroll
            for (int m = 0; m < 4; ++m) { float* rowp = C + (size_t)(row0 + ai * HALF + m * 16) * ldc + col0;
#pragma unroll
                for (int bj = 0; bj < 2; ++bj)
#pragma unroll
                    for (int n = 0; n < 2; ++n) *(f32x4*)(rowp + bj * HALF + n * 16) = acc[ai][bj][m][n]; }
    }
};
template <int ACT  > struct EpiBf16 {
    static constexpr bool PERM = true, AFTER_DRAIN = false;
    bf16_t* O; int ldc;
    __device__ __forceinline__ void operator()(const f32x4 (&acc)[2][2][4][2], const Unit& u, int wr, int wc, int fr, int fq) const {
        const int row0 = u.pm * BM + wr * 64 + fr; const int col0 = u.pn * BM + wc * 32 + 8 * fq;
#pragma unroll
        for (int ai = 0; ai < 2; ++ai)
#pragma unroll
            for (int m = 0; m < 4; ++m) { bf16_t* rowp = O + (size_t)(row0 + ai * HALF + m * 16) * ldc + col0;
#pragma unroll
                for (int bj = 0; bj < 2; ++bj) { f32x4 v0 = acc[ai][bj][m][0], v1 = acc[ai][bj][m][1];
                    if (ACT == 3) {
#pragma unroll
                        for (int j = 0; j < 4; ++j) { const float a = fmaxf(v0[j], 0.f), b = fmaxf(v1[j], 0.f); v0[j] = a * a; v1[j] = b * b; } }
                    u32x4 w; w.x = cvt_pk_bf16(v0[0], v0[1]); w.y = cvt_pk_bf16(v0[2], v0[3]); w.z = cvt_pk_bf16(v1[0], v1[1]); w.w = cvt_pk_bf16(v1[2], v1[3]);
                    *(u32x4*)(rowp + bj * HALF) = w; } }
    }
};
struct EpiQKV {
    static constexpr bool PERM = true, AFTER_DRAIN = false;
    bf16_t* O; int Mrows;
    __device__ __forceinline__ void operator()(const f32x4 (&acc)[2][2][4][2], const Unit& u, int wr, int wc, int fr, int fq) const {
        const int row0 = u.pm * BM + wr * 64 + fr;
#pragma unroll
        for (int bj = 0; bj < 2; ++bj) { bf16_t* hb = O + (size_t)(u.pn * 2 + bj) * Mrows * 128 + wc * 32 + 8 * fq;
#pragma unroll
            for (int ai = 0; ai < 2; ++ai)
#pragma unroll
                for (int m = 0; m < 4; ++m) { const f32x4 v0 = acc[ai][bj][m][0], v1 = acc[ai][bj][m][1];
                    u32x4 w; w.x = cvt_pk_bf16(v0[0], v0[1]); w.y = cvt_pk_bf16(v0[2], v0[3]); w.z = cvt_pk_bf16(v1[0], v1[1]); w.w = cvt_pk_bf16(v1[2], v1[3]);
                    *(u32x4*)(hb + (size_t)(row0 + ai * HALF + m * 16) * 128) = w; } }
    }
};
template <class Epi, class Sched, bool ALIGN_EPI = false, bool SP2 = false>
__device__ __forceinline__ void gemm_phase(PG8_LAS unsigned char* lds, const Gemm g, const Sched& S, const Epi& E) {
    int tid_ = threadIdx.x; asm volatile("" : "+v"(tid_));
    const int tid = tid_, wid = __builtin_amdgcn_readfirstlane(tid >> 6), lane = tid & 63, wr = wid >> 2, wc = wid & 3, fr = lane & 15, fq = lane >> 4;
    const int K = g.K, nt = K / BK;
    unsigned voffA[2], voffB[2];
#pragma unroll
    for (int i = 0; i < 2; ++i) { int R, C; stage_rc(tid * 16 + i * 8192, R, C); const int Rb = Epi::PERM ? ((R & ~31) + perm32(R & 31)) : R;
        voffA[i] = (unsigned)(R * K + C) * 2u; voffB[i] = (unsigned)(Rb * K + C) * 2u; }
    const size_t kstep = (size_t)(BK * 2);
    const size_t hstep = (size_t)HALF * K * 2;
    const size_t tstep = 2 * hstep;
    const unsigned ldsw = (unsigned)wid * 1024u;
    const int aoff = lds_byte(wr * 64 + fr, fq * 8), boff = lds_byte(wc * 32 + fr, fq * 8);
#define PG8_SA(b, h) (((b) * 2 + (h)) * HTB)
#define PG8_SB(b, h) ((4 + (b) * 2 + (h)) * HTB)
#define PG8_STAGE(bufoff, gbase, voff) do { _Pragma("unroll") for (int _i = 0; _i < 2; ++_i) \
        __builtin_amdgcn_global_load_lds((const unsigned*)((const char*)(gbase) + (voff)[_i]), (PG8_LAS unsigned*)(lds + (bufoff) + ldsw + _i * 8192), 16, 0, 0); } while (0)
#define PG8_LDA(dst, b, h) do { _Pragma("unroll") for (int m = 0; m < 4; ++m) _Pragma("unroll") for (int k = 0; k < 2; ++k) dst[m][k] = *(const PG8_LAS bf16x8*)(lds + PG8_SA(b, h) + aoff + m * 2048 + k * 1024); } while (0)
#define PG8_LDB(dst, b, h) do { _Pragma("unroll") for (int n = 0; n < 2; ++n) _Pragma("unroll") for (int k = 0; k < 2; ++k) dst[n][k] = *(const PG8_LAS bf16x8*)(lds + PG8_SB(b, h) + boff + n * 2048 + k * 1024); } while (0)
#define PG8_MMA(ai, bj, At, Bt) do { __builtin_amdgcn_s_setprio(1); _Pragma("unroll") for (int m = 0; m < 4; ++m) _Pragma("unroll") for (int n = 0; n < 2; ++n) _Pragma("unroll") for (int k = 0; k < 2; ++k) \
        acc[ai][bj][m][n] = __builtin_amdgcn_mfma_f32_16x16x32_bf16(Bt[n][k], At[m][k], acc[ai][bj][m][n], 0, 0, 0); __builtin_amdgcn_s_setprio(0); } while (0)
#define PG8_WAIT_V(n) asm volatile("s_waitcnt vmcnt(" #n ")" ::: "memory")
#define PG8_WAIT_L(n) asm volatile("s_waitcnt lgkmcnt(" #n ")" ::: "memory")
#define PG8_BAR __builtin_amdgcn_s_barrier()
#define PG8_SCHED __builtin_amdgcn_sched_barrier(0)
    Unit cur, nxt; int ui = 0;
    if (!S.next(0, cur)) return;
    f32x4 acc[2][2][4][2];
#pragma unroll
    for (int a = 0; a < 2; ++a)
#pragma unroll
        for (int b = 0; b < 2; ++b)
#pragma unroll
            for (int m = 0; m < 4; ++m)
#pragma unroll
                for (int n = 0; n < 2; ++n) acc[a][b][m][n] = (f32x4){0.f, 0.f, 0.f, 0.f};
    bf16x8 At[4][2], B0[2][2], B1[2][2];
    const char* cA = (const char*)g.A + (size_t)cur.pm * tstep; const char* cB = (const char*)g.Bt + (size_t)cur.pn * tstep;
    S.a_ready(cur);
    if constexpr (SP2) {
        PG8_STAGE(PG8_SB(0, 0), cB, voffB); PG8_STAGE(PG8_SB(0, 1), cB + hstep, voffB); PG8_STAGE(PG8_SA(0, 0), cA, voffA); PG8_STAGE(PG8_SA(0, 1), cA + hstep, voffA);
        if (wr == 1) PG8_BAR;
        PG8_WAIT_V(2); PG8_BAR;
        PG8_STAGE(PG8_SB(1, 0), cB + kstep, voffB); PG8_STAGE(PG8_SA(1, 0), cA + kstep, voffA); PG8_STAGE(PG8_SB(1, 1), cB + hstep + kstep, voffB);
        PG8_WAIT_V(6); PG8_BAR;
    } else {
        PG8_STAGE(PG8_SB(0, 0), cB, voffB); PG8_STAGE(PG8_SA(0, 0), cA, voffA); PG8_STAGE(PG8_SB(0, 1), cB + hstep, voffB); PG8_STAGE(PG8_SA(0, 1), cA + hstep, voffA);
        if (wr == 1) PG8_BAR;
        PG8_WAIT_V(4); PG8_BAR;
        PG8_STAGE(PG8_SB(1, 0), cB + kstep, voffB); PG8_STAGE(PG8_SA(1, 0), cA + kstep, voffA); PG8_STAGE(PG8_SB(1, 1), cB + hstep + kstep, voffB);
        PG8_WAIT_V(6); PG8_BAR;
    }
    for (;;) {
        const bool has_next = S.next(ui + 1, nxt);
        const char* nA = has_next ? (const char*)g.A + (size_t)nxt.pm * tstep : cA; const char* nB = has_next ? (const char*)g.Bt + (size_t)nxt.pn * tstep : cB;
        for (int t = 0; t < nt; t += 2) {
            const bool last = (t == nt - 2);
            const char* a1 = cA + (size_t)(t + 1) * kstep;
            const char* a2 = last ? nA : cA + (size_t)(t + 2) * kstep; const char* b2 = last ? nB : cB + (size_t)(t + 2) * kstep;
            const char* a3 = a2 + kstep; const char* b3 = b2 + kstep;
            if (last && has_next) S.a_ready(nxt);
            if constexpr (SP2) {
            PG8_LDB(B0, 0, 0); PG8_LDB(B1, 0, 1); PG8_SCHED; PG8_LDA(At, 0, 0); PG8_STAGE(PG8_SA(1, 1), a1 + hstep, voffA);
            PG8_WAIT_V(8); PG8_WAIT_L(0); PG8_BAR; PG8_MMA(0, 0, At, B0); PG8_MMA(0, 1, At, B1); PG8_BAR; PG8_SCHED;
            PG8_LDA(At, 0, 1); PG8_STAGE(PG8_SB(0, 0), b2, voffB); PG8_STAGE(PG8_SB(0, 1), b2 + hstep, voffB); PG8_STAGE(PG8_SA(0, 0), a2, voffA);
            PG8_WAIT_V(8); PG8_WAIT_L(0); PG8_BAR; PG8_MMA(1, 0, At, B0); PG8_MMA(1, 1, At, B1); PG8_BAR; PG8_SCHED;
            PG8_LDB(B0, 1, 0); PG8_LDB(B1, 1, 1); PG8_SCHED; PG8_LDA(At, 1, 0); PG8_STAGE(PG8_SA(0, 1), a2 + hstep, voffA);
            PG8_WAIT_V(8); PG8_WAIT_L(0); PG8_BAR; PG8_MMA(0, 0, At, B0); PG8_MMA(0, 1, At, B1); PG8_BAR; PG8_SCHED;
            PG8_LDA(At, 1, 1); PG8_STAGE(PG8_SB(1, 0), b3, voffB); PG8_STAGE(PG8_SB(1, 1), b3 + hstep, voffB); PG8_STAGE(PG8_SA(1, 0), a3, voffA);
            PG8_WAIT_V(8); PG8_WAIT_L(0); PG8_BAR; PG8_MMA(1, 0, At, B0); PG8_MMA(1, 1, At, B1); PG8_BAR; PG8_SCHED;
            } else {
            PG8_LDB(B0, 0, 0); PG8_SCHED; PG8_LDA(At, 0, 0); PG8_STAGE(PG8_SA(1, 1), a1 + hstep, voffA);
            PG8_WAIT_L(8); PG8_BAR; PG8_WAIT_L(0); PG8_MMA(0, 0, At, B0); PG8_BAR; PG8_SCHED;
            PG8_LDB(B1, 0, 1); PG8_STAGE(PG8_SB(0, 0), b2, voffB);
            PG8_BAR; PG8_WAIT_L(0); PG8_MMA(0, 1, At, B1); PG8_BAR;
            PG8_LDA(At, 0, 1); PG8_STAGE(PG8_SA(0, 0), a2, voffA);
            PG8_BAR; PG8_WAIT_L(0); PG8_MMA(1, 0, At, B0); PG8_BAR; PG8_SCHED;
            PG8_STAGE(PG8_SB(0, 1), b2 + hstep, voffB);
            PG8_WAIT_V(6); PG8_BAR; PG8_MMA(1, 1, At, B1); PG8_BAR;
            PG8_LDB(B0, 1, 0); PG8_SCHED; PG8_LDA(At, 1, 0); PG8_STAGE(PG8_SA(0, 1), a2 + hstep, voffA);
            PG8_WAIT_L(8); PG8_BAR; PG8_WAIT_L(0); PG8_MMA(0, 0, At, B0); PG8_BAR; PG8_SCHED;
            PG8_LDB(B1, 1, 1); PG8_STAGE(PG8_SB(1, 0), b3, voffB);
            PG8_BAR; PG8_WAIT_L(0); PG8_MMA(0, 1, At, B1); PG8_BAR;
            PG8_LDA(At, 1, 1); PG8_STAGE(PG8_SA(1, 0), a3, voffA);
            PG8_BAR; PG8_WAIT_L(0); PG8_MMA(1, 0, At, B0); PG8_BAR; PG8_SCHED;
            PG8_STAGE(PG8_SB(1, 1), b3 + hstep, voffB);
            PG8_WAIT_V(6); PG8_BAR; PG8_MMA(1, 1, At, B1); PG8_BAR;
            }
        }
        if constexpr (ALIGN_EPI) { if (wr == 0) PG8_BAR; }
        if constexpr (!Epi::AFTER_DRAIN) { E(acc, cur, wr, wc, fr, fq); S.done(cur); }
        if (!has_next) break;
#pragma unroll
        for (int a = 0; a < 2; ++a)
#pragma unroll
            for (int b = 0; b < 2; ++b)
#pragma unroll
                for (int m = 0; m < 4; ++m)
#pragma unroll
                    for (int n = 0; n < 2; ++n) acc[a][b][m][n] = (f32x4){0.f, 0.f, 0.f, 0.f};
        cur = nxt; cA = nA; cB = nB; ++ui;
        if constexpr (ALIGN_EPI) { if (wr == 1) PG8_BAR; }
    }
    PG8_WAIT_V(0);
    if constexpr (!ALIGN_EPI) { if (wr == 0) PG8_BAR; }
    PG8_BAR;
    if constexpr (Epi::AFTER_DRAIN) { E.fused(acc, cur, wr, wc, fr, fq, lds, wid, lane); S.done(cur); }
#undef PG8_SA
#undef PG8_SB
#undef PG8_STAGE
#undef PG8_LDA
#undef PG8_LDB
#undef PG8_MMA
#undef PG8_WAIT_V
#undef PG8_WAIT_L
#undef PG8_BAR
#undef PG8_SCHED
}
}
namespace att {
typedef unsigned short bf16;
using bf16x8 = __attribute__((ext_vector_type(8))) short;
using s16x4  = __attribute__((ext_vector_type(4))) short;
using f32x16 = __attribute__((ext_vector_type(16))) float;
using u32x4  = __attribute__((ext_vector_type(4))) unsigned;
constexpr int   D = 128, NW = 8, QBLK = 32, KVBLK = 64;
constexpr float SCALE = 0.088388347648318440f;
constexpr float LOG2E = 1.4426950408889634f;
constexpr float C2 = SCALE * LOG2E;
constexpr float THR = 8.f;
constexpr int SHM_V = KVBLK * D * 2, SHM_K = KVBLK * D * 2;
constexpr int LDS_WS = 2 * SHM_V + 2 * SHM_K, LDS_TB = LDS_WS + NW * 64 * 4, LDS_ATT_BYTES = LDS_TB + 4096;
#define KSWZ(row, colB) ((row) * 256 + ((colB) ^ (((row) & 7) << 4)))
#define SBAR() __builtin_amdgcn_sched_barrier(0)
__device__ __forceinline__ int crow(int r, int hi) { return (r & 3) + 8 * (r >> 2) + 4 * hi; }
typedef float f32x2_ __attribute__((ext_vector_type(2)));
typedef __bf16 bf16x2_ __attribute__((ext_vector_type(2)));
__device__ __forceinline__ unsigned cvtpk(float lo, float hi) { const f32x2_ v = {lo, hi}; const bf16x2_ r = __builtin_convertvector(v, bf16x2_); return *reinterpret_cast<const unsigned*>(&r); }
#define SGB(mask, n) __builtin_amdgcn_sched_group_barrier(mask, n, 0)
#define SG_QK() do { SGB(0x100, 2); _Pragma("unroll") for (int i_ = 0; i_ < 16; ++i_) { SGB(0x008, 1); if (i_ < 14) SGB(0x100, 1); SGB(0x400, 1); SGB(0x002, 4); } } while (0)
__device__ __forceinline__ bf16x8 ld8(const bf16* p) { return *reinterpret_cast<const bf16x8*>(p); }

struct MaskCtx { int a, v, d; const float* tbl; };
constexpr int LDS_WS_FAST = 131072 + 2048;
constexpr int TB_ORG = 256;

__device__ __forceinline__ void partialSM(f32x16& p0, f32x16& p1, float& m_reg, float& mn, float& alpha) {
  float pmax = p0[0];
#pragma unroll
  for (int r = 1; r < 16; ++r) pmax = fmaxf(pmax, p0[r]);
#pragma unroll
  for (int r = 0; r < 16; ++r) pmax = fmaxf(pmax, p1[r]);
  { auto rr = __builtin_amdgcn_permlane32_swap(__float_as_uint(pmax), __float_as_uint(pmax), false, false);
    pmax = fmaxf(__uint_as_float(rr[0]), __uint_as_float(rr[1])); }
  if (__builtin_expect(__all(pmax - m_reg <= THR / SCALE), 1)) { mn = m_reg; alpha = 1.f; }
  else { mn = fmaxf(m_reg, pmax); alpha = __builtin_amdgcn_exp2f((m_reg - mn) * C2); m_reg = mn; }
  float mnC = -mn * C2;
#pragma unroll
  for (int r = 0; r < 16; ++r) p0[r] = fmaf(p0[r], C2, mnC);
#pragma unroll
  for (int r = 0; r < 16; ++r) p1[r] = fmaf(p1[r], C2, mnC);
#pragma unroll
  for (int r = 0; r < 16; ++r) p0[r] = __builtin_amdgcn_exp2f(p0[r]);
}
template <int KIND>
__device__ __forceinline__ void partialSM_m(f32x16& p0, f32x16& p1, float& m_reg, float& mn, float& alpha, int jt, const MaskCtx& mc) {
  const float* tp = (KIND == 1) ? mc.tbl + (jt - mc.a + 7) * 31 : mc.tbl + jt * 64;
  float b0[16], b1[16];
#pragma unroll
  for (int r = 0; r < 16; ++r) { const int kc = (r & 3) + 8 * (r >> 2); b0[r] = tp[kc]; b1[r] = tp[kc + 32]; }
#pragma unroll
  for (int r = 0; r < 16; ++r) asm volatile("" : "+v"(b0[r]), "+v"(b1[r]));
  if (KIND == 1) {
    const bool rowok = (unsigned)(jt - min(max(mc.a - 4, 0), 120)) <= 7u;
#pragma unroll
    for (int r = 0; r < 16; ++r) { const int kc = (r & 3) + 8 * (r >> 2);
      { const bool ok = rowok && (unsigned)(kc - mc.v) <= 15u; const float t = fmaf(p0[r], C2, b0[r]); p0[r] = ok ? t : -1e30f; }
      { const bool ok = rowok && (unsigned)(kc + 32 - mc.v) <= 15u; const float t = fmaf(p1[r], C2, b1[r]); p1[r] = ok ? t : -1e30f; } }
  } else {
    const bool tok = (unsigned)jt < (unsigned)mc.d;
    const int db = jt * 64 + mc.v;
#pragma unroll
    for (int r = 0; r < 16; ++r) { const int kc = (r & 3) + 8 * (r >> 2);
      { const bool ok = tok && (unsigned)(db + kc) <= 128u; const float t = fmaf(p0[r], C2, b0[r]); p0[r] = ok ? t : -1e30f; }
      { const bool ok = tok && (unsigned)(db + kc + 32) <= 128u; const float t = fmaf(p1[r], C2, b1[r]); p1[r] = ok ? t : -1e30f; } }
  }
  float pmax = p0[0];
#pragma unroll
  for (int r = 1; r < 16; ++r) pmax = fmaxf(pmax, p0[r]);
#pragma unroll
  for (int r = 0; r < 16; ++r) pmax = fmaxf(pmax, p1[r]);
  { auto rr = __builtin_amdgcn_permlane32_swap(__float_as_uint(pmax), __float_as_uint(pmax), false, false);
    pmax = fmaxf(__uint_as_float(rr[0]), __uint_as_float(rr[1])); }
  if (__builtin_expect(__all(pmax - m_reg <= THR * LOG2E), 1)) { mn = m_reg; alpha = 1.f; }
  else { mn = fmaxf(m_reg, pmax); alpha = __builtin_amdgcn_exp2f(m_reg - mn); m_reg = mn; }
#pragma unroll
  for (int r = 0; r < 16; ++r) p0[r] -= mn;
#pragma unroll
  for (int r = 0; r < 16; ++r) p1[r] -= mn;
#pragma unroll
  for (int r = 0; r < 16; ++r) p0[r] = __builtin_amdgcn_exp2f(p0[r]);
}
template <bool FAST = false>
__device__ __forceinline__ void finishSM(f32x16& p0, f32x16& p1, float alpha, float& l_reg, bf16x8& pa0, bf16x8& pa1, bf16x8& pa2, bf16x8& pa3) {
#pragma unroll
  for (int r = 0; r < 16; ++r) p1[r] = __builtin_amdgcn_exp2f(p1[r]);
  float ps = 0;
#pragma unroll
  for (int r = 0; r < 16; ++r) ps += p0[r];
#pragma unroll
  for (int r = 0; r < 16; ++r) ps += p1[r];
  if (FAST) l_reg += ps;
  else { auto rr = __builtin_amdgcn_permlane32_swap(__float_as_uint(ps), __float_as_uint(ps), false, false);
    ps = __uint_as_float(rr[0]) + __uint_as_float(rr[1]); l_reg = l_reg * alpha + ps; }
#define PK4(P, BASE, OUT) do { unsigned a0 = cvtpk(P[BASE + 0], P[BASE + 1]), a1 = cvtpk(P[BASE + 2], P[BASE + 3]);   \
    unsigned b0 = cvtpk(P[BASE + 4], P[BASE + 5]), b1 = cvtpk(P[BASE + 6], P[BASE + 7]);                              \
    auto r0 = __builtin_amdgcn_permlane32_swap(a0, b0, false, false); auto r1 = __builtin_amdgcn_permlane32_swap(a1, b1, false, false); \
    u32x4 w = {r0[0], r1[0], r0[1], r1[1]}; OUT = *reinterpret_cast<bf16x8*>(&w); } while (0)
  PK4(p0, 0, pa0); PK4(p0, 8, pa1); PK4(p1, 0, pa2); PK4(p1, 8, pa3);
#undef PK4
}
__device__ __forceinline__ void qkt(f32x16& p0, f32x16& p1, const bf16* Ks, const bf16x8* qr, int r32, int hi) {
  p0 = f32x16{}; p1 = f32x16{};
#pragma unroll
  for (int d0 = 0; d0 < 8; ++d0) { int cb = (d0 * 16 + hi * 8) * 2;
    bf16x8 b0 = *reinterpret_cast<const bf16x8*>((const char*)Ks + KSWZ(r32, cb));
    bf16x8 b1 = *reinterpret_cast<const bf16x8*>((const char*)Ks + KSWZ(32 + r32, cb));
    p0 = __builtin_amdgcn_mfma_f32_32x32x16_bf16(b0, qr[d0], p0, 0, 0, 0);
    p1 = __builtin_amdgcn_mfma_f32_32x32x16_bf16(b1, qr[d0], p1, 0, 0, 0); }
}
__device__ __forceinline__ int v_st(int k, int c) { const int kk = (k & ~0xC) | ((k & 4) << 1) | ((k & 8) >> 1); return ((kk >> 3) * 4 + (c >> 5)) * 512 + ((kk & 7) * 32 + (c & 31)) * 2; }
__device__ __forceinline__ int v_rd_base(int lane) { return ((lane & 3) << 3) | (((lane >> 2) & 3) << 6) | (((lane >> 4) & 1) << 5) | (((lane >> 5) & 1) << 8); }
constexpr int v_rd_off(int d0, int ks, int half) { return d0 * 512 + ks * 4096 + half * 2048; }
template <int OFF> __device__ __forceinline__ s16x4 tr_read(int vb) {
  s16x4 r; asm volatile("ds_read_b64_tr_b16 %0, %1 offset:%2" : "=&v"(r) : "v"(vb), "i"(OFF) : "memory"); return r;
}
template <int D0> __device__ __forceinline__ void pv_one(f32x16& od, int vb, bf16x8 pa0, bf16x8 pa1, bf16x8 pa2, bf16x8 pa3) {
  const s16x4 l0 = tr_read<v_rd_off(D0, 0, 0)>(vb), h0 = tr_read<v_rd_off(D0, 0, 1)>(vb), l1 = tr_read<v_rd_off(D0, 1, 0)>(vb), h1 = tr_read<v_rd_off(D0, 1, 1)>(vb);
  const s16x4 l2 = tr_read<v_rd_off(D0, 2, 0)>(vb), h2 = tr_read<v_rd_off(D0, 2, 1)>(vb), l3 = tr_read<v_rd_off(D0, 3, 0)>(vb), h3 = tr_read<v_rd_off(D0, 3, 1)>(vb);
  asm volatile("s_waitcnt lgkmcnt(0)" ::: "memory"); SBAR();
#define PK(L, H) (bf16x8){L[0], L[1], L[2], L[3], H[0], H[1], H[2], H[3]}
  od = __builtin_amdgcn_mfma_f32_32x32x16_bf16(pa0, PK(l0, h0), od, 0, 0, 0);
  od = __builtin_amdgcn_mfma_f32_32x32x16_bf16(pa1, PK(l1, h1), od, 0, 0, 0);
  od = __builtin_amdgcn_mfma_f32_32x32x16_bf16(pa2, PK(l2, h2), od, 0, 0, 0);
  od = __builtin_amdgcn_mfma_f32_32x32x16_bf16(pa3, PK(l3, h3), od, 0, 0, 0);
#undef PK
}
__device__ __forceinline__ void pv_d0(f32x16* o, int vb, bf16x8 pa0, bf16x8 pa1, bf16x8 pa2, bf16x8 pa3) {
  pv_one<0>(o[0], vb, pa0, pa1, pa2, pa3); pv_one<1>(o[1], vb, pa0, pa1, pa2, pa3); pv_one<2>(o[2], vb, pa0, pa1, pa2, pa3); pv_one<3>(o[3], vb, pa0, pa1, pa2, pa3);
}
#define PKS(C, B, OUT) do { auto r0_ = __builtin_amdgcn_permlane32_swap(C[(B)], C[(B) + 2], false, false); auto r1_ = __builtin_amdgcn_permlane32_swap(C[(B) + 1], C[(B) + 3], false, false); \
    u32x4 w_ = {r0_[0], r1_[0], r0_[1], r1_[1]}; OUT = *reinterpret_cast<bf16x8*>(&w_); } while (0)
#ifndef KDEP
#define KDEP 1
#endif
#define KRD1(g_, X) do { const int cb_ = (((g_) >> 1) * 16 + hi * 8) * 2; X = *reinterpret_cast<const bf16x8*>((const char*)Ks + KSWZ(((g_) & 1) * 32 + r32, cb_)); } while (0)
template <bool FAST>
__device__ __forceinline__ void qk_fsm(f32x16& n0, f32x16& n1, const bf16* Ks, const bf16x8* qr, int r32, int hi,
                                       f32x16& p0, f32x16& p1, float alpha, float& l_reg, bf16x8& pa0, bf16x8& pa1, bf16x8& pa2, bf16x8& pa3) {
  n0 = f32x16{}; n1 = f32x16{};
  bf16x8 kf[KDEP + 1]; unsigned c[16]; float s0 = 0.f, s1 = 0.f, ps = 0.f;
#pragma unroll
  for (int g = 0; g < KDEP; ++g) KRD1(g, kf[g]);
#pragma unroll
  for (int g = 0; g < 16; ++g) { const int d0 = g >> 1;
    if (g + KDEP < 16) KRD1(g + KDEP, kf[(g + KDEP) % (KDEP + 1)]);
    if ((g & 1) == 0) n0 = __builtin_amdgcn_mfma_f32_32x32x16_bf16(kf[g % (KDEP + 1)], qr[d0], n0, 0, 0, 0);
    else              n1 = __builtin_amdgcn_mfma_f32_32x32x16_bf16(kf[g % (KDEP + 1)], qr[d0], n1, 0, 0, 0);
    if (g < 4) { p1[2 * g] = __builtin_amdgcn_exp2f(p1[2 * g]); p1[2 * g + 1] = __builtin_amdgcn_exp2f(p1[2 * g + 1]); }
    else if (g < 12) p1[g + 4] = __builtin_amdgcn_exp2f(p1[g + 4]);
    if (g < 8) { s0 += p0[2 * g]; s1 += p0[2 * g + 1]; c[g] = cvtpk(p0[2 * g], p0[2 * g + 1]); }
    if (g >= 5 && g <= 12) { const int k = g - 5; s0 += p1[2 * k]; s1 += p1[2 * k + 1]; c[8 + k] = cvtpk(p1[2 * k], p1[2 * k + 1]); }
    if (g <= 12) asm volatile("" : "+v"(s0), "+v"(s1));
    if (g == 4) PKS(c, 0, pa0);
    if (g == 8) PKS(c, 4, pa1);
    if (g == 9) PKS(c, 8, pa2);
    if (g == 13) { PKS(c, 12, pa3); ps = s0 + s1; }
    if (g == 14 && !FAST) { auto rr = __builtin_amdgcn_permlane32_swap(__float_as_uint(ps), __float_as_uint(ps), false, false); ps = __uint_as_float(rr[0]) + __uint_as_float(rr[1]); }
    if (g == 15) l_reg = FAST ? l_reg + ps : l_reg * alpha + ps;
    SBAR();
  }
}
#undef KRD1
template <bool FAST>
__device__ __forceinline__ void pv_psm(f32x16* o, int vb, bf16x8 pa0, bf16x8 pa1, bf16x8 pa2, bf16x8 pa3, f32x16& p0, f32x16& p1, float& m_reg, float& mn, float& alpha) {
  if constexpr (FAST) {
    pv_one<0>(o[0], vb, pa0, pa1, pa2, pa3);
#pragma unroll
    for (int r = 0; r < 4; ++r) p0[r] = __builtin_amdgcn_exp2f(p0[r]);
    pv_one<1>(o[1], vb, pa0, pa1, pa2, pa3);
#pragma unroll
    for (int r = 4; r < 8; ++r) p0[r] = __builtin_amdgcn_exp2f(p0[r]);
    pv_one<2>(o[2], vb, pa0, pa1, pa2, pa3);
#pragma unroll
    for (int r = 8; r < 12; ++r) p0[r] = __builtin_amdgcn_exp2f(p0[r]);
    pv_one<3>(o[3], vb, pa0, pa1, pa2, pa3);
#pragma unroll
    for (int r = 12; r < 16; ++r) p0[r] = __builtin_amdgcn_exp2f(p0[r]);
    asm volatile("" : "+v"(p0), "+v"(p1));
    return;
  }
  pv_one<0>(o[0], vb, pa0, pa1, pa2, pa3);
  float pmax = p0[0];
#pragma unroll
  for (int r = 1; r < 16; ++r) pmax = fmaxf(pmax, p0[r]);
  pv_one<1>(o[1], vb, pa0, pa1, pa2, pa3);
#pragma unroll
  for (int r = 0; r < 16; ++r) pmax = fmaxf(pmax, p1[r]);
  { auto rr = __builtin_amdgcn_permlane32_swap(__float_as_uint(pmax), __float_as_uint(pmax), false, false);
    pmax = fmaxf(__uint_as_float(rr[0]), __uint_as_float(rr[1])); }
  if (__builtin_expect(__all(pmax - m_reg <= THR / SCALE), 1)) { mn = m_reg; alpha = 1.f; }
  else { mn = fmaxf(m_reg, pmax); alpha = __builtin_amdgcn_exp2f((m_reg - mn) * C2); m_reg = mn; }
  const float mnC = -mn * C2;
  pv_one<2>(o[2], vb, pa0, pa1, pa2, pa3);
#pragma unroll
  for (int r = 0; r < 16; ++r) p0[r] = fmaf(p0[r], C2, mnC);
#pragma unroll
  for (int r = 0; r < 16; ++r) p1[r] = fmaf(p1[r], C2, mnC);
  pv_one<3>(o[3], vb, pa0, pa1, pa2, pa3);
#pragma unroll
  for (int r = 0; r < 16; ++r) p0[r] = __builtin_amdgcn_exp2f(p0[r]);
  asm volatile("" : "+v"(p0), "+v"(p1));
}

template <int KIND, bool FAST = false>
__device__ __forceinline__ void attn_unit(const bf16* __restrict__ Qb, long qs, const bf16* __restrict__ Kh, const bf16* __restrict__ Vh, long ks,
                                          int kt0, int NT, int ktmax, bf16* __restrict__ Ob, long os, float* __restrict__ stp, long sts,
                                          int mq0, const float* __restrict__ tbsrc, int tbn, char* lds,
                                          const float* __restrict__ qg = nullptr, const float* __restrict__ rope = nullptr, int t0 = 0) {
  int tid_ = threadIdx.x; asm volatile("" : "+v"(tid_));
  const int tid = tid_, wid = __builtin_amdgcn_readfirstlane(tid >> 6), lane = tid & 63, r32 = lane & 31, hi = lane >> 5;
  bf16* V_lds = (bf16*)lds; bf16* K_lds = (bf16*)(lds + 2 * SHM_V);
  float* ws = (float*)(lds + (FAST ? LDS_WS_FAST : LDS_WS)) + wid * 64; float* li_l = ws; float* al_l = ws + 32;
  float* tb = (float*)(lds + LDS_TB);
  MaskCtx mc; mc.a = 0; mc.v = 0; mc.d = 0; mc.tbl = tb;
  if (KIND == 1) { const int r = mq0 + (wid >> 1), c = (wid & 1) * 32 + r32; mc.a = r; mc.v = min(max(c - 8, 0), 48) - 4 * hi; mc.tbl = tb + TB_ORG + 15 - c + 4 * hi; }
  if (KIND == 2) { mc.v = 64 - (mq0 + wid * 32 + r32) + 4 * hi; mc.d = ktmax; mc.tbl = tb + TB_ORG + mc.v; }
  if (KIND != 0) { __syncthreads();
    for (int i = tid; i < tbn; i += 64 * NW) tb[TB_ORG + i] = tbsrc[i] * LOG2E; }
  float m_reg = -1e30f, l_reg = 0; f32x16 o[4] = {}; bf16x8 qr[8];
  const bf16* Qw = Qb + (long)(wid * QBLK + r32) * qs + hi * 8;
#pragma unroll
  for (int d0 = 0; d0 < 8; ++d0) qr[d0] = ld8(Qw + d0 * 16);
  if (KIND == 0 && qg != nullptr) {
#define UNPK(X, W) do { X[0] = __uint_as_float(W[0] << 16); X[1] = __uint_as_float(W[0] & 0xffff0000u); X[2] = __uint_as_float(W[1] << 16); X[3] = __uint_as_float(W[1] & 0xffff0000u); \
      X[4] = __uint_as_float(W[2] << 16); X[5] = __uint_as_float(W[2] & 0xffff0000u); X[6] = __uint_as_float(W[3] << 16); X[7] = __uint_as_float(W[3] & 0xffff0000u); } while (0)
    float ss = 0.f;
#pragma unroll
    for (int d0 = 0; d0 < 8; ++d0) { const u32x4 w = *reinterpret_cast<const u32x4*>(&qr[d0]); float x[8]; UNPK(x, w);
#pragma unroll
      for (int i = 0; i < 8; ++i) ss += x[i] * x[i]; }
    { auto rr = __builtin_amdgcn_permlane32_swap(__float_as_uint(ss), __float_as_uint(ss), false, false); ss = __uint_as_float(rr[0]) + __uint_as_float(rr[1]); }
    const float rstd = (FAST ? C2 : 1.0f) / sqrtf(ss * (1.0f / 128.0f) + 1e-6f);
    const int t = t0 + wid * QBLK + r32;
#pragma unroll
    for (int d0 = 0; d0 < 8; ++d0) asm volatile("" : "+v"(qr[d0]));
#pragma unroll
    for (int half = 0; half < 2; ++half) { const int pos = half ? (t & 63) : (t >> 6);
#pragma unroll
      for (int dd = 0; dd < 2; ++dd) { const int d1 = half * 4 + dd, d2 = d1 + 2; const float* rp = rope + pos * 32 + dd * 16 + hi * 8;
        const float4 c0 = *reinterpret_cast<const float4*>(rp), c1 = *reinterpret_cast<const float4*>(rp + 4), s0 = *reinterpret_cast<const float4*>(rp + 4096), s1 = *reinterpret_cast<const float4*>(rp + 4100);
        const float cs[8] = {c0.x, c0.y, c0.z, c0.w, c1.x, c1.y, c1.z, c1.w}, sn[8] = {s0.x, s0.y, s0.z, s0.w, s1.x, s1.y, s1.z, s1.w};
        const float* gp1 = qg + d1 * 16 + hi * 8; const float* gp2 = qg + d2 * 16 + hi * 8;
        const float4 ga = *reinterpret_cast<const float4*>(gp1), gb = *reinterpret_cast<const float4*>(gp1 + 4), gc = *reinterpret_cast<const float4*>(gp2), gd = *reinterpret_cast<const float4*>(gp2 + 4);
        const float g1[8] = {ga.x, ga.y, ga.z, ga.w, gb.x, gb.y, gb.z, gb.w}, g2[8] = {gc.x, gc.y, gc.z, gc.w, gd.x, gd.y, gd.z, gd.w};
        const u32x4 w1 = *reinterpret_cast<const u32x4*>(&qr[d1]), w2 = *reinterpret_cast<const u32x4*>(&qr[d2]); float x1[8], x2[8], y1[8], y2[8]; UNPK(x1, w1); UNPK(x2, w2);
#pragma unroll
        for (int i = 0; i < 8; ++i) { const float a1 = x1[i] * (rstd * g1[i]), a2 = x2[i] * (rstd * g2[i]); y1[i] = a1 * cs[i] - a2 * sn[i]; y2[i] = a1 * sn[i] + a2 * cs[i]; }
        { u32x4 w = {cvtpk(y1[0], y1[1]), cvtpk(y1[2], y1[3]), cvtpk(y1[4], y1[5]), cvtpk(y1[6], y1[7])}; qr[d1] = *reinterpret_cast<bf16x8*>(&w); }
        { u32x4 w = {cvtpk(y2[0], y2[1]), cvtpk(y2[2], y2[3]), cvtpk(y2[4], y2[5]), cvtpk(y2[6], y2[7])}; qr[d2] = *reinterpret_cast<bf16x8*>(&w); } } }
#undef UNPK
  }
  const int sr = tid >> 4, sc = (tid & 15) * 8, vst0 = v_st(sr, sc), vst1 = v_st(32 + sr, sc);
  const int vb0 = (int)(uintptr_t)V_lds + v_rd_base(lane);
  const bf16* Kp = Kh + (long)sr * ks + sc; const bf16* Vp = Vh + (long)sr * ks + sc; const long o32 = 32 * ks, tstep = 64 * ks;
  struct { bf16x8 vs0, vs1, ks0, ks1; } sr_[2];
#define TCL(j) ((long)min(max(kt0 + (j), 0), ktmax - 1))
#define SLOAD(i, j) do { const long off_ = TCL(j) * tstep; sr_[i].vs0 = ld8(Vp + off_); sr_[i].vs1 = ld8(Vp + off_ + o32); sr_[i].ks0 = ld8(Kp + off_); sr_[i].ks1 = ld8(Kp + off_ + o32); } while (0)
#define SWRITE(b, i) do { *(bf16x8*)((char*)V_lds + (b) * SHM_V + vst0) = sr_[i].vs0;          \
    *(bf16x8*)((char*)V_lds + (b) * SHM_V + vst1) = sr_[i].vs1; int kc = sc * 2;               \
    *(bf16x8*)((char*)K_lds + (b) * SHM_K + KSWZ(sr, kc)) = sr_[i].ks0;                       \
    *(bf16x8*)((char*)K_lds + (b) * SHM_K + KSWZ(32 + sr, kc)) = sr_[i].ks1; } while (0)
#define SWAIT() asm volatile("s_waitcnt vmcnt(4)" ::: "memory")
#define RESC(a) do { if (__any((a) < 1.f)) { if (hi == 0) al_l[r32] = (a); asm volatile("s_waitcnt lgkmcnt(0)" ::: "memory"); \
    _Pragma("unroll") for (int d = 0; d < 4; ++d) _Pragma("unroll") for (int r = 0; r < 16; ++r) o[d][r] *= al_l[crow(r, hi)]; } } while (0)
  if constexpr (KIND == 0 && FAST) {
    typedef __attribute__((address_space(3))) unsigned* ldsp_t;
    char* Vr = lds; char* Kr = lds + 4 * SHM_V;
    unsigned kof[2], vof[2];
#pragma unroll
    for (int i = 0; i < 2; ++i) { const int I = 2 * wid + i;
      const int r = 4 * I + (lane >> 4), sl = lane & 15; kof[i] = (unsigned)(r * (int)ks * 2 + ((sl ^ (r & 7)) << 4));
      const int G = I * 64 + lane, S = G >> 5, kk = ((S >> 2) << 3) | ((G >> 2) & 7), c = ((S & 3) << 5) | ((G & 3) << 3);
      const int k = (kk & ~0xC) | ((kk & 4) << 1) | ((kk & 8) >> 1); vof[i] = (unsigned)(k * (int)ks * 2 + c * 2); }
    const long tstep_ = 64 * ks;
#define DMA(b, j) do { const long tb_ = (long)min(max(kt0 + (j), 0), ktmax - 1) * tstep_; const char* kg_ = (const char*)(Kh + tb_); const char* vg_ = (const char*)(Vh + tb_);          \
      _Pragma("unroll") for (int i_ = 0; i_ < 2; ++i_) {                                                                                                                                    \
        __builtin_amdgcn_global_load_lds((const unsigned*)(kg_ + kof[i_]), (ldsp_t)(Kr + (b) * SHM_K + (2 * wid + i_) * 1024), 16, 0, 0);                                                 \
        __builtin_amdgcn_global_load_lds((const unsigned*)(vg_ + vof[i_]), (ldsp_t)(Vr + (b) * SHM_V + (2 * wid + i_) * 1024), 16, 0, 0); } } while (0)
#define KB(b) ((const bf16*)(Kr + (b) * SHM_K))
#define VB(b) ((int)(uintptr_t)Vr + v_rd_base(lane) + (b) * (int)SHM_V)
    f32x16 pA0, pA1, pB0, pB1; float mnD = 0.f, alD = 1.f; bf16x8 pa0, pa1, pa2, pa3;
    DMA(0, 0); DMA(1, 1); DMA(2, 2);
    asm volatile("s_waitcnt vmcnt(8)" ::: "memory"); __syncthreads();
    qkt(pA0, pA1, KB(0), qr, r32, hi);
#pragma unroll
    for (int r = 0; r < 16; ++r) pA0[r] = __builtin_amdgcn_exp2f(pA0[r]);
#define IT(N0, N1, O0, O1, BK, BV, BW, J) do {                                                                                                      \
      asm volatile("s_waitcnt vmcnt(4)" ::: "memory"); __syncthreads();              \
      if ((J) + 2 < NT) DMA(BW, (J) + 2); SBAR();                                                                                                                     \
      qk_fsm<false>(N0, N1, KB(BK), qr, r32, hi, O0, O1, 1.f, l_reg, pa0, pa1, pa2, pa3);                                                           \
      pv_psm<true>(o, VB(BV), pa0, pa1, pa2, pa3, N0, N1, m_reg, mnD, alD); } while (0)
    int sk = 1, sv = 0, sw = 3;
#define ROT() do { sv = sk; sk = (sk + 1) & 3; sw = (sw + 1) & 3; } while (0)
    for (int j = 1; j + 1 < NT; j += 2) {
      IT(pB0, pB1, pA0, pA1, sk, sv, sw, j); ROT();
      IT(pA0, pA1, pB0, pB1, sk, sv, sw, j + 1); ROT();
    }
    asm volatile("s_waitcnt vmcnt(0)" ::: "memory"); __syncthreads();
    SBAR(); qk_fsm<false>(pB0, pB1, KB(sk), qr, r32, hi, pA0, pA1, 1.f, l_reg, pa0, pa1, pa2, pa3);
    pv_psm<true>(o, VB(sv), pa0, pa1, pa2, pa3, pB0, pB1, m_reg, mnD, alD);
    finishSM(pB0, pB1, 1.f, l_reg, pa0, pa1, pa2, pa3); SBAR();
    pv_d0(o, VB(sk), pa0, pa1, pa2, pa3);
#undef ROT
#undef IT
#undef DMA
#undef KB
#undef VB
  } else
  {
  bf16x8 pa0, pa1, pa2, pa3;
  {
    const int nd_lo = (KIND == 1) ? min(max(mq0 + (wid >> 1) - 4, 0), 120) : (mq0 + 32 * wid - 127);
    const int nd_hi = mq0 + 32 * wid + 95;
#define NEED(jt) ((KIND == 0) ? true : (KIND == 1) ? ((unsigned)((jt) - nd_lo) <= 7u) : ((unsigned)(jt) < (unsigned)ktmax && 64 * (jt) >= nd_lo && 64 * (jt) <= nd_hi))
    f32x16 p0, p1; float mn, al;
    SLOAD(0, 0); SLOAD(1, 1);
#define STEP(J, B) do { SWRITE(B, B); if ((J) + 2 < NT) SLOAD(B, (J) + 2); __syncthreads();                                     \
      if (NEED(kt0 + (J))) { qkt(p0, p1, (bf16*)((char*)K_lds + (B) * SHM_K), qr, r32, hi); if constexpr (KIND == 0) partialSM(p0, p1, m_reg, mn, al); else partialSM_m<KIND>(p0, p1, m_reg, mn, al, kt0 + (J), mc); RESC(al); \
        finishSM(p0, p1, al, l_reg, pa0, pa1, pa2, pa3); SBAR(); pv_d0(o, vb0 + (B) * (int)SHM_V, pa0, pa1, pa2, pa3); } } while (0)
    for (int j = 0; j < NT; j += 2) { STEP(j, 0); STEP(j + 1, 1); }
#undef STEP
#undef NEED
  }
  }
  if (hi == 0) li_l[r32] = l_reg; asm volatile("s_waitcnt lgkmcnt(0)" ::: "memory");
  if (KIND == 2) { if (hi == 0) { float* sp = stp + (long)(wid * QBLK + r32) * sts; sp[0] = m_reg; sp[1] = l_reg; } }
  float rli[16];
#pragma unroll
  for (int r = 0; r < 16; ++r) rli[r] = __builtin_amdgcn_rcpf(li_l[crow(r, hi)]);
  bf16* Ow = Ob + (long)(wid * QBLK) * os;
#pragma unroll
  for (int r = 0; r < 16; ++r) { const int orow = crow(r, hi);
#pragma unroll
    for (int d0 = 0; d0 < 4; ++d0) { const float v = o[d0][r] * rli[r]; Ow[(long)orow * os + d0 * 32 + r32] = (bf16)(cvtpk(v, v) & 0xffffu); } }
#undef TCL
#undef SLOAD
#undef SWRITE
#undef SWAIT
#undef RESC
}
}
#define GAS __attribute__((address_space(1)))
#define LAS __attribute__((address_space(3)))
typedef unsigned short bf16;
typedef unsigned v4u __attribute__((ext_vector_type(4)));
typedef float f32x4 __attribute__((ext_vector_type(4)));
typedef short bf16x8 __attribute__((ext_vector_type(8)));
typedef GAS unsigned gu32;
typedef GAS unsigned long long gu64;
#define RLX_AGENT __ATOMIC_RELAXED, __HIP_MEMORY_SCOPE_AGENT
#define LDS_WAIT() asm volatile("s_waitcnt lgkmcnt(0)" ::: "memory")
#define VM_WAIT() asm volatile("s_waitcnt vmcnt(0)" ::: "memory")
__device__ __forceinline__ unsigned long long rt() { return __builtin_amdgcn_s_memrealtime(); }
__device__ __forceinline__ unsigned f2bf(float f) { unsigned u = __builtin_bit_cast(unsigned, f); return (u + 0x7fffu + ((u >> 16) & 1u)) >> 16; }
__device__ __forceinline__ unsigned pk2(float lo, float hi) { return f2bf(lo) | (f2bf(hi) << 16); }

#define XB_TMO      128
#define XB_XCNT(j)  (256  + 64 * (j))
#define XB_XSUB(j)  (1280 + 64 * (j))
#define XB_XGEN(j)  (2304 + 64 * (j))
#define XB_TOP      3328
#define XB_TOPGEN   3392
#define XCD_BAR_WORDS 3456
#define XB_SPIN_CAP (1u << 18)

__device__ __forceinline__ unsigned xb_ld(unsigned* p)              { return __hip_atomic_load(p, __ATOMIC_RELAXED, __HIP_MEMORY_SCOPE_AGENT); }
__device__ __forceinline__ unsigned xb_add(unsigned* p, unsigned v) { return __hip_atomic_fetch_add(p, v, __ATOMIC_RELAXED, __HIP_MEMORY_SCOPE_AGENT); }
__device__ __forceinline__ unsigned xb_xcc_id() { return (unsigned)__builtin_amdgcn_s_getreg((3 << 11) | 20) & 0xFu; }
#define XB_SPIN(cond, bar) do { unsigned _sp = 0; while (cond) { __builtin_amdgcn_s_sleep(1); \
    if ((++_sp & 255u) == 0u) { if (xb_ld(&(bar)[XB_TMO])) break; if (_sp > XB_SPIN_CAP) { atomicAdd(&(bar)[XB_TMO], 1u); break; } } } } while (0)

struct XcdBarrier {
    unsigned* bar; unsigned x;
    volatile LAS unsigned* st;
};

__device__ __forceinline__ XcdBarrier xcd_barrier_post(unsigned* bar, volatile LAS unsigned* st) {
    XcdBarrier b; b.bar = bar; b.x = xb_xcc_id(); b.st = st;
    if (threadIdx.x == 0) (void)xb_add(&bar[XB_XCNT(b.x)], 1u);
    return b;
}
__device__ __forceinline__ void xcd_barrier_complete(unsigned* bar, unsigned x, unsigned& nloc, unsigned& nx) {
    const unsigned G = gridDim.x * gridDim.y * gridDim.z;
    unsigned sum, cnt, mine, sp = 0u;
    for (;;) {
        sum = 0u; cnt = 0u; mine = 0u;
#pragma unroll
        for (unsigned j = 0; j < 16; ++j) { const unsigned c = xb_ld(&bar[XB_XCNT(j)]); sum += c; cnt += (c > 0u) ? 1u : 0u; mine = (j == x) ? c : mine; }
        if (sum == G) break;
        __builtin_amdgcn_s_sleep(1);
        if ((++sp & 255u) == 0u) { if (xb_ld(&bar[XB_TMO])) break; if (sp > XB_SPIN_CAP) { atomicAdd(&bar[XB_TMO], 1u); break; } }
    }
    nloc = mine > 0u ? mine : 1u; nx = cnt > 0u ? cnt : 1u;
}

__device__ __forceinline__ void xcd_barrier(const XcdBarrier& b) {
    asm volatile("s_waitcnt vmcnt(0)" ::: "memory");
    __syncthreads();
    if (threadIdx.x == 0) {
        unsigned* bar = b.bar;
        __builtin_amdgcn_s_waitcnt(0);
        unsigned nloc = b.st[0], nx = b.st[1];
        if (nloc == 0u) { xcd_barrier_complete(bar, b.x, nloc, nx); b.st[0] = nloc; b.st[1] = nx; }
        const unsigned old = xb_add(&bar[XB_XSUB(b.x)], 1u);
        const unsigned gen = old / nloc;
        if (old + 1u == (gen + 1u) * nloc) {
            __builtin_amdgcn_fence(__ATOMIC_RELEASE, "agent");
            asm volatile("s_waitcnt vmcnt(0)" ::: "memory");
            const unsigned og = xb_add(&bar[XB_TOP], 1u);
            const unsigned tg = og / nx;
            if (og + 1u == (tg + 1u) * nx) xb_add(&bar[XB_TOPGEN], 1u);
            else XB_SPIN(xb_ld(&bar[XB_TOPGEN]) == tg, bar);
            __builtin_amdgcn_fence(__ATOMIC_ACQUIRE, "agent");
            xb_add(&bar[XB_XGEN(b.x)], 1u);
            asm volatile("s_waitcnt vmcnt(0)" ::: "memory");
        } else {
            XB_SPIN(xb_ld(&bar[XB_XGEN(b.x)]) == gen, bar);
            __builtin_amdgcn_fence(__ATOMIC_ACQUIRE, "agent");
            asm volatile("s_waitcnt vmcnt(0)" ::: "memory");
        }
    }
    __syncthreads();
}
constexpr int BATCH = 2, SEQ = 8192, DM = 4096, DEPTH = 4, HDIM = 128, H_NA = 8, H_DIL = 12, H_GQA = 12, KV_GQA = 4;
constexpr int NQKV = 10240, DFF = 16384, M = BATCH * SEQ, NMOD = 6;
constexpr int Q_NA = 0, Q_DIL = 1024, Q_GQA = 2560, K_NA = 4096, K_DIL = 5120, K_GQA = 6656, V_NA = 7168, V_DIL = 8192, V_GQA = 9728;
constexpr int O_NA = 0, O_DIL = 1024, O_GQA = 2560, DILW = H_DIL * HDIM;
constexpr float EPS = 1e-6f;
constexpr size_t MiB = 1u << 20;
constexpr size_t WS_CTL = 0, CTL_ZERO_BYTES = 1 * MiB;
constexpr size_t WS_MODP = 1 * MiB;
constexpr size_t WS_MODV = 4 * MiB;
constexpr size_t WS_ROPE = 5 * MiB;
constexpr size_t WS_DILTB = 5 * MiB + 64 * 1024;
constexpr size_t WS_DILST = 6 * MiB;
constexpr size_t WS_WIN = 16 * MiB, WS_WOUT = 336 * MiB, WS_W1 = 464 * MiB, WS_W2 = 976 * MiB;
constexpr size_t WS_H = 1488 * MiB, WS_QKV = 1616 * MiB, WS_O = 1936 * MiB, WS_Y = 2064 * MiB, WS_U = 2320 * MiB, WS_DILP = 2832 * MiB, WS_XB = 2976 * MiB, WS_END = 3104 * MiB;
static_assert(WS_DILST + (size_t)3 * M * 12 * 2 * 4 <= WS_WIN, "ws map");
constexpr int CW_BAR = 4096, CW_QUEUE = 16384;
constexpr int RING_OFF = 0, RING_BYTES = 131072, LDSCTL_OFF = RING_BYTES, MISC_OFF = LDSCTL_OFF + 320, LDS_BYTES = 147456;
constexpr int NWAVES = 8;

struct Frame {
    LAS unsigned char* lds; volatile LAS unsigned* MISC;
    int G;
};
__device__ __forceinline__ float wave_sum(float v) {
#pragma unroll
    for (int o = 1; o < 64; o <<= 1) v += __shfl_xor(v, o);
    return v;
}
__device__ __forceinline__ float bf2f(unsigned short b) { return __uint_as_float(((unsigned)b) << 16); }
struct XItem { const float* src; bf16* dst; int K, N; };
__device__ __forceinline__ void xitem_load(const XItem& it, f32x4 (&wv)[8], int lane) {
    const int lr = lane >> 3, lc = (lane & 7) * 4;
#pragma unroll
    for (int i = 0; i < 8; ++i) wv[i] = __builtin_nontemporal_load((const f32x4*)(it.src + (size_t)(16 * (i >> 1) + 2 * lr + (i & 1)) * it.N + lc));
}
__device__ __forceinline__ void xitem_finish(const XItem& it, const f32x4 (&wv)[8], LAS float* scr, int lane) {
    LAS unsigned* T = (LAS unsigned*)scr; const int lr = lane >> 3, lc = (lane & 7) * 4;
#pragma unroll
    for (int m = 0; m < 4; ++m) { const f32x4 a = wv[2 * m], b = wv[2 * m + 1]; const int kw = 8 * m + lr;
        T[(lc + 0) * 36 + kw] = pg8::cvt_pk_bf16(a.x, b.x); T[(lc + 1) * 36 + kw] = pg8::cvt_pk_bf16(a.y, b.y); T[(lc + 2) * 36 + kw] = pg8::cvt_pk_bf16(a.z, b.z); T[(lc + 3) * 36 + kw] = pg8::cvt_pk_bf16(a.w, b.w); }
    LDS_WAIT(); asm volatile("" ::: "memory");
    const int kq = lane & 7;
#pragma unroll
    for (int j = 0; j < 4; ++j) { const int n = (lane >> 3) + 8 * j; const v4u o = *(const LAS v4u*)(T + n * 36 + kq * 4);
        __builtin_nontemporal_store(o, (GAS v4u*)(it.dst + (size_t)n * it.K + 8 * kq)); }
    LDS_WAIT(); asm volatile("" ::: "memory");
}
__device__ __forceinline__ int t5_bucket_dev(int rel) {
    const int n = rel < 0 ? -rel : rel; int b;
    if (n < 8) b = n; else b = 8 + (n >= 15) + (n >= 27) + (n >= 50) + (n >= 91) + (n >= 166) + (n >= 305) + (n >= 559);
    return (rel > 0 ? 16 : 0) + b;
}

#ifndef PH_MASK
#define PH_MASK 0xFFF
#endif
#define ON(k) (((PH_MASK) >> (k)) & 1)
#define QKVH(head, row) (QKV + ((size_t)(head) * M + (size_t)(row)) * HDIM)
constexpr int I_IN = (DM / 64) * (NQKV / 32), I_OUT = (DM / 64) * (DM / 32), I_1 = (DM / 64) * (DFF / 32), I_2 = (DFF / 64) * (DM / 32), I_LAYER = I_IN + I_OUT + I_1 + I_2;
#ifndef CONV_IN_QUEUE
#define CONV_IN_QUEUE 1
#endif
constexpr int NCONV = 128, CONV_ITEMS = I_LAYER / NCONV;
static_assert(I_LAYER % NCONV == 0 && CONV_ITEMS % 16 == 0 && (I_LAYER - I_IN) % NCONV == 0 && ((I_LAYER - I_IN) / NCONV) % 16 == 0, "conversion chunking: whole chunks, an even item count per wave");
__device__ __forceinline__ XItem conv_item(int l, int r, const float* w_in, const float* w_out, const float* w_mlp_in, const float* w_mlp_out, bf16* WIN, bf16* WOUT, bf16* W1, bf16* W2) {
    const float* W; bf16* WT; int K, N;
    if (r < I_IN) { W = w_in + (size_t)l * DM * NQKV; WT = WIN + (size_t)l * NQKV * DM; K = DM; N = NQKV; }
    else if (r < I_IN + I_OUT) { r -= I_IN; W = w_out + (size_t)l * DM * DM; WT = WOUT + (size_t)l * DM * DM; K = DM; N = DM; }
    else if (r < I_IN + I_OUT + I_1) { r -= I_IN + I_OUT; W = w_mlp_in + (size_t)l * DM * DFF; WT = W1 + (size_t)l * DFF * DM; K = DM; N = DFF; }
    else { r -= I_IN + I_OUT + I_1; W = w_mlp_out + (size_t)l * DFF * DM; WT = W2 + (size_t)l * DM * DFF; K = DFF; N = DM; }
    const int nblk = N / 32, k0 = 64 * (r / nblk), n0 = 32 * (r % nblk);
    XItem it; it.src = W + (size_t)k0 * N + n0; it.dst = WT + (size_t)n0 * K + k0; it.K = K; it.N = N; return it;
}
__device__ __forceinline__ XItem conv_qitem(int l, int q, const float* w_in, const float* w_out, const float* w_mlp_in, const float* w_mlp_out, bf16* WIN, bf16* WOUT, bf16* W1, bf16* W2) {
    return (q < I_LAYER - I_IN) ? conv_item(l, q + I_IN, w_in, w_out, w_mlp_in, w_mlp_out, WIN, WOUT, W1, W2) : conv_item(l + 1, q - (I_LAYER - I_IN), w_in, w_out, w_mlp_in, w_mlp_out, WIN, WOUT, W1, W2);
}
template <bool QMAP> __device__ __forceinline__ void conv_run_t(int l, int first, int step, int end, const float* w_in, const float* w_out, const float* w_mlp_in, const float* w_mlp_out, bf16* WIN, bf16* WOUT, bf16* W1, bf16* W2, LAS float* scr, int lane) {
#define CI_(r) (QMAP ? conv_qitem(l, (r), w_in, w_out, w_mlp_in, w_mlp_out, WIN, WOUT, W1, W2) : conv_item(l, (r), w_in, w_out, w_mlp_in, w_mlp_out, WIN, WOUT, W1, W2))
    if (first >= end) return;
    f32x4 wa[8], wb[8], wc[8], wd[8];
    if ((((end - first) + step - 1) / step) & 1) { const XItem s = CI_(first); xitem_load(s, wa, lane); xitem_finish(s, wa, scr, lane); first += step; if (first >= end) return; }
    XItem a = CI_(first), b = CI_(first + step);
    xitem_load(a, wa, lane); xitem_load(b, wb, lane);
    for (int r = first; r < end; r += 4 * step) {
        const bool more = r + 2 * step < end;
        XItem c = a, d = b; if (more) { c = CI_(r + 2 * step); d = CI_(r + 3 * step); xitem_load(c, wc, lane); xitem_load(d, wd, lane); }
        xitem_finish(a, wa, scr, lane); xitem_finish(b, wb, scr, lane);
        if (!more) break;
        const bool more2 = r + 4 * step < end;
        if (more2) { a = CI_(r + 4 * step); b = CI_(r + 5 * step); xitem_load(a, wa, lane); xitem_load(b, wb, lane); }
        xitem_finish(c, wc, scr, lane); xitem_finish(d, wd, scr, lane);
        if (!more2) break;
    }
#undef CI_
}
struct Args { const float* in[14]; float* out; unsigned char* ws; };

__device__ __forceinline__ f32x4 ld_row4(const void* base, size_t row, int idx, bool is_bf) {
    if (is_bf) { const unsigned long long w = ((const unsigned long long*)((const bf16*)base + row * DM))[idx]; const unsigned lo = (unsigned)w, hi = (unsigned)(w >> 32);
        return (f32x4){__uint_as_float(lo << 16), __uint_as_float(lo & 0xffff0000u), __uint_as_float(hi << 16), __uint_as_float(hi & 0xffff0000u)}; }
    return ((const f32x4*)((const float*)base + row * DM))[idx];
}
template <bool HAS_Y>
__device__ __forceinline__ void norm_phase(Frame& F, const void* xin, bool xin_bf, const bf16* y, void* xout, bool xout_bf, bf16* h, const float* Gv, const float* Av, const float* Bv, int bstride) {
    int tid_ = threadIdx.x; asm volatile("" : "+v"(tid_)); const int tid = tid_, lane = tid & 63, wave = __builtin_amdgcn_readfirstlane(tid >> 6);
    LAS f32x4* Gs = (LAS f32x4*)(F.lds); LAS f32x4* As = (LAS f32x4*)(F.lds + 16384); LAS f32x4* Bs = (LAS f32x4*)(F.lds + 32768);
    for (int chunk = blockIdx.x; chunk < M / 64; chunk += F.G) {
        const int b = chunk / (SEQ / 64);
        __syncthreads();
        for (int i = tid; i < 1024; i += NWAVES * 64) { if (HAS_Y) Gs[i] = ((const f32x4*)(Gv + (size_t)b * bstride))[i]; if (h) { As[i] = ((const f32x4*)(Av + (size_t)b * bstride))[i]; Bs[i] = ((const f32x4*)(Bv + (size_t)b * bstride))[i]; } }
        __syncthreads();
        for (int rr = wave; rr < 64; rr += NWAVES) {
            const size_t row = (size_t)chunk * 64 + rr;
            f32x4 xv[16];
            if (HAS_Y) {
                f32x4 yv[16]; float ss = 0.f;
#pragma unroll
                for (int j = 0; j < 16; ++j) yv[j] = ld_row4(y, row, lane + 64 * j, true);
#pragma unroll
                for (int j = 0; j < 16; ++j) xv[j] = ld_row4(xin, row, lane + 64 * j, xin_bf);
#pragma unroll
                for (int j = 0; j < 16; ++j) { asm volatile("" : "+v"(xv[j]));
                    ss += (yv[j].x * yv[j].x + yv[j].y * yv[j].y) + (yv[j].z * yv[j].z + yv[j].w * yv[j].w); }
                const float ry = 1.0f / sqrtf(wave_sum(ss) * (1.0f / DM) + EPS);
#pragma unroll
                for (int j = 0; j < 16; ++j) { const f32x4 g = Gs[lane + 64 * j]; xv[j] = xv[j] + g * (yv[j] * ry); }
                if (xout_bf) { unsigned long long* xo = (unsigned long long*)((bf16*)xout + row * DM) + lane;
#pragma unroll
                    for (int j = 0; j < 16; ++j) xo[64 * j] = (unsigned long long)pg8::cvt_pk_bf16(xv[j].x, xv[j].y) | ((unsigned long long)pg8::cvt_pk_bf16(xv[j].z, xv[j].w) << 32);
                } else { f32x4* xo = (f32x4*)((float*)xout + row * DM) + lane;
#pragma unroll
                    for (int j = 0; j < 16; ++j) xo[64 * j] = xv[j]; }
            } else {
#pragma unroll
                for (int j = 0; j < 16; ++j) xv[j] = ld_row4(xin, row, lane + 64 * j, xin_bf);
            }
            if (h) {
                float ss = 0.f;
#pragma unroll
                for (int j = 0; j < 16; ++j) ss += (xv[j].x * xv[j].x + xv[j].y * xv[j].y) + (xv[j].z * xv[j].z + xv[j].w * xv[j].w);
                const float rx = 1.0f / sqrtf(wave_sum(ss) * (1.0f / DM) + EPS);
                unsigned long long* ho = (unsigned long long*)(h + row * DM) + lane;
#pragma unroll
                for (int j = 0; j < 16; ++j) { const f32x4 a = As[lane + 64 * j], bb = Bs[lane + 64 * j]; const f32x4 v = a * (xv[j] * rx) + bb;
                    ho[64 * j] = (unsigned long long)pg8::cvt_pk_bf16(v.x, v.y) | ((unsigned long long)pg8::cvt_pk_bf16(v.z, v.w) << 32); }
            }
        }
    }
}

__device__ __forceinline__ void norm_phase_bf(Frame& F, const bf16* xin, const bf16* y, void* xout, bool xout_bf, bf16* h, const float* Gv, const float* Av, const float* Bv, int bstride) {
    int tid_ = threadIdx.x; asm volatile("" : "+v"(tid_)); const int tid = tid_, lane = tid & 63, wave = __builtin_amdgcn_readfirstlane(tid >> 6);
    LAS f32x4* Gs = (LAS f32x4*)(F.lds); LAS f32x4* As = (LAS f32x4*)(F.lds + 16384); LAS f32x4* Bs = (LAS f32x4*)(F.lds + 32768);
    typedef unsigned long long u64;
#define NB_CVT(W) ((f32x4){__uint_as_float((unsigned)(W) << 16), __uint_as_float((unsigned)(W) & 0xffff0000u), __uint_as_float((unsigned)((W) >> 32) << 16), __uint_as_float((unsigned)((W) >> 32) & 0xffff0000u)})
#define NB_LOAD(YR, XR, ROW) do { _Pragma("unroll") for (int j = 0; j < 16; ++j) { YR[j] = ((const u64*)(y + (ROW) * DM))[lane + 64 * j]; XR[j] = ((const u64*)(xin + (ROW) * DM))[lane + 64 * j]; } } while (0)
#define NB_PIN(YR, XR) do { _Pragma("unroll") for (int j = 0; j < 16; ++j) { asm volatile("" : "+v"(YR[j])); asm volatile("" : "+v"(XR[j])); } } while (0)
#define NB_ROW(YR, XR, ROW) do { int lq = lane; asm volatile("" : "+v"(lq)); float ss = 0.f; f32x4 xv[16]; \
        _Pragma("unroll") for (int j = 0; j < 16; ++j) { const f32x4 yv = NB_CVT(YR[j]); ss += (yv.x * yv.x + yv.y * yv.y) + (yv.z * yv.z + yv.w * yv.w); } \
        const float ry = 1.0f / sqrtf(wave_sum(ss) * (1.0f / DM) + EPS); \
        _Pragma("unroll") for (int j = 0; j < 16; ++j) { const f32x4 g = Gs[lq + 64 * j]; xv[j] = NB_CVT(XR[j]) + g * (NB_CVT(YR[j]) * ry); } \
        if (xout_bf) { u64* xo = (u64*)((bf16*)xout + (ROW) * DM) + lane; \
            _Pragma("unroll") for (int j = 0; j < 16; ++j) xo[64 * j] = (u64)pg8::cvt_pk_bf16(xv[j].x, xv[j].y) | ((u64)pg8::cvt_pk_bf16(xv[j].z, xv[j].w) << 32); \
        } else { f32x4* xo = (f32x4*)((float*)xout + (ROW) * DM) + lane; \
            _Pragma("unroll") for (int j = 0; j < 16; ++j) xo[64 * j] = xv[j]; } \
        if (h) { float s2 = 0.f; \
            _Pragma("unroll") for (int j = 0; j < 16; ++j) s2 += (xv[j].x * xv[j].x + xv[j].y * xv[j].y) + (xv[j].z * xv[j].z + xv[j].w * xv[j].w); \
            const float rx = 1.0f / sqrtf(wave_sum(s2) * (1.0f / DM) + EPS); \
            u64* ho = (u64*)(h + (ROW) * DM) + lane; \
            _Pragma("unroll") for (int j = 0; j < 16; ++j) { const f32x4 a = As[lq + 64 * j], bb = Bs[lq + 64 * j]; const f32x4 v = a * (xv[j] * rx) + bb; \
                ho[64 * j] = (u64)pg8::cvt_pk_bf16(v.x, v.y) | ((u64)pg8::cvt_pk_bf16(v.z, v.w) << 32); } } } while (0)
    for (int chunk = blockIdx.x; chunk < M / 64; chunk += F.G) {
        const int b = chunk / (SEQ / 64);
        const size_t row0 = (size_t)chunk * 64 + wave;
        u64 yA[16], xA[16], yB[16], xB[16];
        NB_LOAD(yA, xA, row0);
        __syncthreads();
        for (int i = tid; i < 1024; i += NWAVES * 64) { Gs[i] = ((const f32x4*)(Gv + (size_t)b * bstride))[i]; if (h) { As[i] = ((const f32x4*)(Av + (size_t)b * bstride))[i]; Bs[i] = ((const f32x4*)(Bv + (size_t)b * bstride))[i]; } }
        __syncthreads();
#pragma unroll 1
        for (int it = 0; it < 4; ++it) {
            const size_t ra = row0 + 16 * it, rb = ra + 8;
            NB_LOAD(yB, xB, rb); NB_PIN(yA, xA);
            NB_ROW(yA, xA, ra);
            if (it < 3) { NB_LOAD(yA, xA, rb + 8); }
            NB_PIN(yB, xB);
            NB_ROW(yB, xB, rb);
        }
    }
#undef NB_CVT
#undef NB_LOAD
#undef NB_PIN
#undef NB_ROW
}

typedef __attribute__((address_space(4))) const unsigned char ckb_t;
__device__ __forceinline__ const void* karg(int i) { ckb_t* kp = (ckb_t*)__builtin_amdgcn_kernarg_segment_ptr(); asm volatile("" : "+s"(kp)); return *(const void* const __attribute__((address_space(4)))*)(kp + 8 * i); }
#define KIN(i) ((const float*)karg(i))
#define KOUT() ((float*)karg(14))
#define KWS() ((unsigned char*)karg(15))
__global__ void __launch_bounds__(NWAVES * 64, 2) mega_fwd(Args args_unused) {
    extern __shared__ __attribute__((aligned(16))) unsigned char lds[];
    Frame F;
    F.lds = (LAS unsigned char*)lds; F.MISC = (volatile LAS unsigned*)(F.lds + MISC_OFF); F.G = gridDim.x;
    for (int u = threadIdx.x; u < (LDS_BYTES - LDSCTL_OFF) / 4; u += NWAVES * 64) ((LAS unsigned*)(F.lds + LDSCTL_OFF))[u] = 0u;
    __syncthreads();
    (void)xcd_barrier_post((unsigned*)((gu32*)(KWS() + WS_CTL) + CW_BAR), F.MISC + 8);
#define GRID_BAR() do { XcdBarrier bar_; bar_.bar = (unsigned*)((gu32*)(KWS() + WS_CTL) + CW_BAR); bar_.x = xb_xcc_id(); bar_.st = (volatile LAS unsigned*)(F.lds + MISC_OFF) + 8; xcd_barrier(bar_); } while (0)
#define FRESH_IDS() int tid_ = threadIdx.x; asm volatile("" : "+v"(tid_)); const int ftid = tid_, flane = ftid & 63, fwave = __builtin_amdgcn_readfirstlane(ftid >> 6); \
    const int gw = blockIdx.x * NWAVES + fwave, NGW = F.G * NWAVES, gtid = blockIdx.x * (NWAVES * 64) + ftid, NGT = F.G * NWAVES * 64; (void)flane; (void)gw; (void)NGW; (void)gtid; (void)NGT
#define WSP(T, off) ((T*)(ws + (off)))
#ifndef DUP_GEMM
#define DUP_GEMM 0
#endif
#ifndef XBF16
#define XBF16 1
#endif
#ifndef DUP_NORM
#define DUP_NORM 0
#endif
#ifndef DUP_P0C
#define DUP_P0C 0
#endif
#ifndef XBAR
#define XBAR 0
#endif
#ifndef DUP_G0
#define DUP_G0 0
#endif
#ifndef DUP_G1
#define DUP_G1 0
#endif
#ifndef DUP_G2
#define DUP_G2 0
#endif
#ifndef DUP_G3
#define DUP_G3 0
#endif
#ifndef DUP_NA
#define DUP_NA 0
#endif
#ifndef DUP_DIL
#define DUP_DIL 0
#endif
#ifndef DUP_GQA
#define DUP_GQA 0
#endif
#ifndef DUP_ATT
#define DUP_ATT 0
#endif
#ifndef DUP_P0A
#define DUP_P0A 0
#endif
#ifndef DUPBAR
#define DUPBAR 0
#endif
#define REPBAR() do { if (DUPBAR && rep_ > 0) GRID_BAR(); } while (0)
#define REPEAT(n) for (int rep_ = 0, nrep_ = __builtin_amdgcn_readfirstlane(1 + (n)); rep_ < nrep_; ++rep_)

    if (ON(0)) REPEAT(DUP_P0A)
    {
        FRESH_IDS(); unsigned char* ws = KWS(); const float* in_c = KIN(1); const float* ada_w = KIN(2); float* MODP = WSP(float, WS_MODP);
        for (int task = gw; task < 96 * 16; task += NGW) {
            const int cg = task % 96, kc = task / 96; const int col = cg * 256 + flane * 4;
            f32x4 a0 = {0.f, 0.f, 0.f, 0.f}, a1 = {0.f, 0.f, 0.f, 0.f};
            const float* wp = ada_w + (size_t)(kc * 256) * (NMOD * DM) + col;
#pragma unroll 8
            for (int k = 0; k < 256; ++k) {
                const f32x4 w = *(const f32x4*)(wp + (size_t)k * (NMOD * DM));
                const float c0 = in_c[kc * 256 + k], c1 = in_c[DM + kc * 256 + k];
                const float s0 = c0 / (1.0f + __expf(-c0)), s1 = c1 / (1.0f + __expf(-c1));
                a0 = a0 + w * s0; a1 = a1 + w * s1;
            }
            *(f32x4*)(MODP + ((size_t)(kc * 2 + 0) * (NMOD * DM)) + col) = a0;
            *(f32x4*)(MODP + ((size_t)(kc * 2 + 1) * (NMOD * DM)) + col) = a1;
        }
        LAS float* scr = (LAS float*)(F.lds + RING_OFF + fwave * 16384);
        const float* w_in = KIN(6); const float* w_out = KIN(7); const float* w_mlp_in = KIN(12); const float* w_mlp_out = KIN(13);
        bf16* WIN = WSP(bf16, WS_WIN); bf16* WOUT = WSP(bf16, WS_WOUT); bf16* W1 = WSP(bf16, WS_W1); bf16* W2 = WSP(bf16, WS_W2);
        if (CONV_IN_QUEUE) conv_run_t<false>(0, gw, NGW, I_IN, w_in, w_out, w_mlp_in, w_mlp_out, WIN, WOUT, W1, W2, scr, flane);
        else for (int cl_ = 0; cl_ < DEPTH; ++cl_) conv_run_t<false>(cl_, gw, NGW, I_LAYER, w_in, w_out, w_mlp_in, w_mlp_out, WIN, WOUT, W1, W2, scr, flane);
    }
    GRID_BAR();
    if (ON(1))
    {
        FRESH_IDS(); unsigned char* ws = KWS(); const float* ada_b = KIN(3); const float* ada_emb = KIN(4); const float* gains = KIN(5); const float* t5_table = KIN(11);
        float* MODP = WSP(float, WS_MODP); float* MODV = WSP(float, WS_MODV); float* ROPE = WSP(float, WS_ROPE); float* DILTB = WSP(float, WS_DILTB);
        for (int i = gtid; i < DEPTH * 2 * NMOD * DM; i += NGT) {
            const int col = i % DM, j = (i / DM) % NMOD, b = (i / (DM * NMOD)) % 2, l = i / (DM * NMOD * 2);
            float m = ada_b[j * DM + col];
#pragma unroll
            for (int kc = 0; kc < 16; ++kc) m += MODP[(size_t)(kc * 2 + b) * (NMOD * DM) + j * DM + col];
            m += ada_emb[((size_t)l * NMOD + j) * DM + col];
            const float* gl = gains + (size_t)l * 4 * DM;
            float v;
            if (j == 0) v = m; else if (j == 1) v = gl[0 * DM + col] * (1.0f + m); else if (j == 2) v = m * gl[1 * DM + col];
            else if (j == 3) v = m; else if (j == 4) v = gl[2 * DM + col] * (1.0f + m); else v = m * gl[3 * DM + col];
            MODV[i] = v;
        }
        if (blockIdx.x == 0 && ftid < 32) {
            const int f = ftid; const double th = (double)__builtin_amdgcn_exp2f(-(float)f * 0.41524101186092029f);
            double c1 = 1.0, s1 = th, tc = 1.0, ts = th; const double x2 = th * th;
            for (int n = 1; n <= 12; ++n) { tc *= -x2 / (double)((2 * n - 1) * (2 * n)); ts *= -x2 / (double)((2 * n) * (2 * n + 1)); c1 += tc; s1 += ts; }
            double c = 1.0, s = 0.0;
            for (int pos = 0; pos < 128; ++pos) { ROPE[pos * 32 + f] = (float)c; ROPE[4096 + pos * 32 + f] = (float)s; const double cn = c * c1 - s * s1; s = s * c1 + c * s1; c = cn; }
        }
        if (blockIdx.x == 1 || F.G == 1) {
            for (int i = ftid; i < 3 * H_DIL * 129; i += NWAVES * 64) { const int p = i / (H_DIL * 129), hh = (i / 129) % H_DIL, jj = i % 129 - 64; const int d = p == 0 ? 1 : (p == 1 ? 4 : 16);
                DILTB[i] = t5_table[t5_bucket_dev(jj * d) * H_DIL + hh]; }
        }
    }
    GRID_BAR();
    if (ON(2))
    REPEAT(DUP_P0C) { unsigned char* ws = KWS(); float* MODV = WSP(float, WS_MODV);
      norm_phase<false>(F, KIN(0), false, nullptr, nullptr, false, WSP(bf16, WS_H), nullptr, MODV + 1 * DM, MODV + 0 * DM, NMOD * DM); }
    GRID_BAR();

    for (int l = 0; l < DEPTH; ++l) {
        for (int xb_ = 0; xb_ < XBAR; ++xb_) GRID_BAR();
    if (ON(3)) REPEAT(DUP_GEMM + DUP_G0)
        {
            REPBAR();
            unsigned char* ws = KWS();
            pg8::Gemm g{WSP(bf16, WS_H), WSP(bf16, WS_WIN) + (size_t)l * NQKV * DM, M, NQKV, DM}; pg8::StaticOrder S; S.init(M, NQKV, F.G, (int)blockIdx.x);
            pg8::EpiQKV E{WSP(bf16, WS_QKV), M};
            pg8::gemm_phase<pg8::EpiQKV, pg8::StaticOrder, true, true>(F.lds + RING_OFF, g, S, E);
        }
        GRID_BAR();
    if (ON(4))
        {
            FRESH_IDS(); const int i16 = ftid & 15; const int g16 = gtid >> 4, NG16 = NGT >> 4;
            unsigned char* ws = KWS(); bf16* QKV = WSP(bf16, WS_QKV); const float* ROPE = WSP(float, WS_ROPE); const float* q_gain = KIN(8); const float* k_gain = KIN(9);
            for (int task = g16; task < KV_GQA * (M / 8); task += NG16) {
                const int hh = task >> 11, row0 = (task & (M / 8 - 1)) * 8;
                const int head = K_GQA / HDIM + hh;
                const float* gp = k_gain + l * HDIM + 8 * i16;
                bf16* p = QKVH(head, row0) + 8 * i16;
                const int jj = i16 & 7, fb = 8 * (jj & 3);
                v4u raw[8]; f32x4 c0[8], c1[8], s0[8], s1[8];
#pragma unroll
                for (int k = 0; k < 8; ++k) raw[k] = *(const v4u*)(p + (size_t)k * HDIM);
                const f32x4 g0 = *(const f32x4*)gp, g1 = *(const f32x4*)(gp + 4);
#pragma unroll
                for (int k = 0; k < 8; ++k) { const int t = (row0 + k) & (SEQ - 1); const int pos = (i16 < 8) ? (t >> 6) : (t & 63); const float* rp = ROPE + pos * 32 + fb;
                    c0[k] = *(const f32x4*)rp; c1[k] = *(const f32x4*)(rp + 4); s0[k] = *(const f32x4*)(rp + 4096); s1[k] = *(const f32x4*)(rp + 4100); }
#pragma unroll
                for (int k = 0; k < 8; ++k) {
                    float x[8];
                    x[0] = __uint_as_float(raw[k].x << 16); x[1] = __uint_as_float(raw[k].x & 0xffff0000u); x[2] = __uint_as_float(raw[k].y << 16); x[3] = __uint_as_float(raw[k].y & 0xffff0000u);
                    x[4] = __uint_as_float(raw[k].z << 16); x[5] = __uint_as_float(raw[k].z & 0xffff0000u); x[6] = __uint_as_float(raw[k].w << 16); x[7] = __uint_as_float(raw[k].w & 0xffff0000u);
                    float ss = 0.f;
#pragma unroll
                    for (int e = 0; e < 8; ++e) ss += x[e] * x[e];
                    ss += __shfl_xor(ss, 1); ss += __shfl_xor(ss, 2); ss += __shfl_xor(ss, 4); ss += __shfl_xor(ss, 8);
                    const float rstd = 1.0f / sqrtf(ss * (1.0f / HDIM) + EPS);
                    x[0] *= rstd * g0.x; x[1] *= rstd * g0.y; x[2] *= rstd * g0.z; x[3] *= rstd * g0.w; x[4] *= rstd * g1.x; x[5] *= rstd * g1.y; x[6] *= rstd * g1.z; x[7] *= rstd * g1.w;
                    const float cs[8] = {c0[k].x, c0[k].y, c0[k].z, c0[k].w, c1[k].x, c1[k].y, c1[k].z, c1[k].w}; const float sn[8] = {s0[k].x, s0[k].y, s0[k].z, s0[k].w, s1[k].x, s1[k].y, s1[k].z, s1[k].w};
                    float o[8];
#pragma unroll
                    for (int e = 0; e < 8; ++e) { const float pv = __shfl_xor(x[e], 4); o[e] = (jj < 4) ? (x[e] * cs[e] - pv * sn[e]) : (pv * sn[e] + x[e] * cs[e]); }
                    v4u w; w.x = pg8::cvt_pk_bf16(o[0], o[1]); w.y = pg8::cvt_pk_bf16(o[2], o[3]); w.z = pg8::cvt_pk_bf16(o[4], o[5]); w.w = pg8::cvt_pk_bf16(o[6], o[7]);
                    *(v4u*)(p + (size_t)k * HDIM) = w;
                }
            }
        }
    if (ON(5))
        {
            char* alds = (char*)lds + RING_OFF;
            (void)alds;
        }
        GRID_BAR();
    if (ON(5)) REPEAT(DUP_ATT)
        {
            char* alds = (char*)lds + RING_OFF;
            { unsigned char* ws = KWS(); bf16* QKV = WSP(bf16, WS_QKV); bf16* O = WSP(bf16, WS_O); const float* na_rpb = KIN(10);
              bf16* DILP = WSP(bf16, WS_DILP); float* DILST = WSP(float, WS_DILST); const float* DILTB = WSP(float, WS_DILTB);
              gu32* qhead = (gu32*)(ws + WS_CTL) + CW_QUEUE + 64 * l; volatile LAS unsigned* qslot = (volatile LAS unsigned*)(F.lds + MISC_OFF) + 16;
              const int nconv = CONV_IN_QUEUE ? NCONV : 0;
              bool gqa_fast;
              { int tid_ = threadIdx.x; asm volatile("" : "+v"(tid_)); const int gl = tid_ & 63; const float* qgp = KIN(8) + l * HDIM; const float* kgp = KIN(9) + l * HDIM;
                const bool small = fabsf(qgp[gl]) <= 1.96f && fabsf(qgp[gl + 64]) <= 1.96f && fabsf(kgp[gl]) <= 1.96f && fabsf(kgp[gl + 64]) <= 1.96f;
                gqa_fast = __all(small) != 0; }
              unsigned nx_ = 0u; if (threadIdx.x == 0) nx_ = __hip_atomic_fetch_add(qhead, 1u, RLX_AGENT);
              for (int guard_ = 0; guard_ < 4096; ++guard_) {
                __syncthreads();
                if (threadIdx.x == 0) qslot[0] = nx_;
                __syncthreads();
                const int uq = (int)__builtin_amdgcn_readfirstlane(qslot[0]);
                if (uq >= 768 + nconv + 2816) break;
                if (threadIdx.x == 0) nx_ = __hip_atomic_fetch_add(qhead, 1u, RLX_AGENT);
                int u;
                if (uq < 768 + nconv) {
                    if (nconv && uq % 7 == 6) {
                        int tid_ = threadIdx.x; asm volatile("" : "+v"(tid_)); const int cl = tid_ & 63, cw = __builtin_amdgcn_readfirstlane(tid_ >> 6);
                        LAS float* scr = (LAS float*)(F.lds + RING_OFF + cw * 16384); const int citems = (l + 1 < DEPTH) ? CONV_ITEMS : (I_LAYER - I_IN) / NCONV, c0 = (uq / 7) * citems;
                        const float* w_in = KIN(6); const float* w_out = KIN(7); const float* w_mlp_in = KIN(12); const float* w_mlp_out = KIN(13);
                        conv_run_t<true>(l, c0 + cw, NWAVES, c0 + citems, w_in, w_out, w_mlp_in, w_mlp_out, WSP(bf16, WS_WIN), WSP(bf16, WS_WOUT), WSP(bf16, WS_W1), WSP(bf16, WS_W2), scr, cl);
                        continue;
                    }
                    u = nconv ? uq - uq / 7 : uq;
                } else u = uq - nconv;
                if (u < 768) {
                    const int grp = u / 96, within = u % 96; const int b = grp >> 2, kvh = grp & 3, hq = kvh * 3 + within / 32, qb = within % 32;
                    const size_t r0 = (size_t)b * SEQ + (size_t)qb * 256;
                    if (gqa_fast) att::attn_unit<0, true>(QKVH(Q_GQA / HDIM + hq, r0), HDIM, QKVH(K_GQA / HDIM + kvh, (size_t)b * SEQ), QKVH(V_GQA / HDIM + kvh, (size_t)b * SEQ), HDIM,
                                      0, SEQ / 64, SEQ / 64, O + r0 * DM + O_GQA + hq * HDIM, DM, nullptr, 0, 0, nullptr, 0, alds, KIN(8) + l * HDIM, WSP(float, WS_ROPE), qb * 256);
                    else att::attn_unit<0, false>(QKVH(Q_GQA / HDIM + hq, r0), HDIM, QKVH(K_GQA / HDIM + kvh, (size_t)b * SEQ), QKVH(V_GQA / HDIM + kvh, (size_t)b * SEQ), HDIM,
                                      0, SEQ / 64, SEQ / 64, O + r0 * DM + O_GQA + hq * HDIM, DM, nullptr, 0, 0, nullptr, 0, alds, KIN(8) + l * HDIM, WSP(float, WS_ROPE), qb * 256);
                    continue;
                }
                if (u < 768 + 512) {
                    const int un = u - 768; const int b = un >> 8, hh = (un >> 5) & 7, qb = un & 31; const size_t r0 = (size_t)b * SEQ + (size_t)qb * 256;
                    att::attn_unit<1>(QKVH(Q_NA / HDIM + hh, r0), HDIM, QKVH(K_NA / HDIM + hh, (size_t)b * SEQ), QKVH(V_NA / HDIM + hh, (size_t)b * SEQ), HDIM,
                                      qb * 4 - 4, 12, SEQ / 64, O + r0 * DM + O_NA + hh * HDIM, DM, nullptr, 0, qb * 4, na_rpb + ((size_t)l * H_NA + hh) * 465, 465, alds);
                } else {
                    const int v = u - 768 - 512, p = v / 768, w = v % 768, pair = w >> 5, b = pair / H_DIL, hh = pair % H_DIL, blk = w & 31;
                    const int d = p == 0 ? 1 : (p == 1 ? 4 : 16), nub = 32 / d, res = blk / nub, ub = blk % nub, u0 = ub * 256, L = SEQ / d;
                    const size_t rq = (size_t)b * SEQ + (size_t)u0 * d + res, rk = (size_t)b * SEQ + res;
                    att::attn_unit<2>(QKVH(Q_DIL / HDIM + hh, rq), (long)d * HDIM, QKVH(K_DIL / HDIM + hh, rk), QKVH(V_DIL / HDIM + hh, rk), (long)d * HDIM,
                                      u0 / 64 - 1, 6, L / 64, DILP + (size_t)p * M * DILW + rq * DILW + hh * HDIM, (long)d * DILW,
                                      DILST + (((size_t)p * M + rq) * H_DIL + hh) * 2, (long)d * H_DIL * 2, u0, DILTB + (p * H_DIL + hh) * 129, 129, alds);
                }
              } }
        }
        GRID_BAR();
    if (ON(6))
        {
            FRESH_IDS(); const int i16 = ftid & 15; const int g16 = gtid >> 4, NG16 = NGT >> 4;
            unsigned char* ws = KWS(); bf16* O = WSP(bf16, WS_O); const bf16* DILP = WSP(bf16, WS_DILP); const float* DILST = WSP(float, WS_DILST);
            typedef float f32x2v __attribute__((ext_vector_type(2)));
            for (int task0 = g16; task0 < M * H_DIL; task0 += 8 * NG16) {
                f32x2v st[8][3]; v4u raw[8][3];
#pragma unroll
                for (int k = 0; k < 8; ++k) { const int task = task0 + k * NG16; const bool on = task < M * H_DIL; const int tt = on ? task : task0; const int row = tt / H_DIL, hh = tt % H_DIL;
#pragma unroll
                    for (int p = 0; p < 3; ++p) { st[k][p] = *(const f32x2v*)(DILST + (((size_t)p * M + row) * H_DIL + hh) * 2); raw[k][p] = *(const v4u*)(DILP + (size_t)p * M * DILW + (size_t)row * DILW + hh * HDIM + 8 * i16); } }
#pragma unroll
                for (int k = 0; k < 8; ++k) { const int task = task0 + k * NG16; if (task < M * H_DIL) { const int row = task / H_DIL, hh = task % H_DIL;
                    const float mx = fmaxf(st[k][0].x, fmaxf(st[k][1].x, st[k][2].x));
                    float wv[3]; float wsum = 0.f;
#pragma unroll
                    for (int p = 0; p < 3; ++p) { wv[p] = st[k][p].y * __builtin_amdgcn_exp2f(st[k][p].x - mx); wsum += wv[p]; }
                    const float inv = 1.0f / wsum;
                    float acc[8] = {0.f, 0.f, 0.f, 0.f, 0.f, 0.f, 0.f, 0.f};
#pragma unroll
                    for (int p = 0; p < 3; ++p) { const v4u r = raw[k][p]; const float wp = wv[p] * inv;
                        acc[0] += wp * __uint_as_float(r.x << 16); acc[1] += wp * __uint_as_float(r.x & 0xffff0000u); acc[2] += wp * __uint_as_float(r.y << 16); acc[3] += wp * __uint_as_float(r.y & 0xffff0000u);
                        acc[4] += wp * __uint_as_float(r.z << 16); acc[5] += wp * __uint_as_float(r.z & 0xffff0000u); acc[6] += wp * __uint_as_float(r.w << 16); acc[7] += wp * __uint_as_float(r.w & 0xffff0000u); }
                    v4u w; w.x = pg8::cvt_pk_bf16(acc[0], acc[1]); w.y = pg8::cvt_pk_bf16(acc[2], acc[3]); w.z = pg8::cvt_pk_bf16(acc[4], acc[5]); w.w = pg8::cvt_pk_bf16(acc[6], acc[7]);
                    *(v4u*)(O + (size_t)row * DM + O_DIL + hh * HDIM + 8 * i16) = w; } }
            }
        }
        GRID_BAR();
    if (ON(7)) REPEAT(DUP_GEMM + DUP_G1)
        {
            REPBAR();
            unsigned char* ws = KWS();
            pg8::Gemm g{WSP(bf16, WS_O), WSP(bf16, WS_WOUT) + (size_t)l * DM * DM, M, DM, DM}; pg8::StaticOrder S; S.init(M, DM, F.G, (int)blockIdx.x);
            pg8::EpiBf16<0> E{WSP(bf16, WS_Y), DM};
            pg8::gemm_phase<pg8::EpiBf16<0>, pg8::StaticOrder, true, true>(F.lds + RING_OFF, g, S, E);
        }
        GRID_BAR();
    if (ON(8))
        { unsigned char* ws = KWS(); const float* mv = WSP(float, WS_MODV) + (size_t)l * 2 * NMOD * DM;
#if DUP_NORM
          norm_phase<true>(F, l == 0 ? (const void*)KIN(0) : (const void*)KOUT(), false, WSP(bf16, WS_Y), WSP(float, WS_U), false, WSP(bf16, WS_U + 256 * MiB), mv + 2 * DM, mv + 4 * DM, mv + 3 * DM, NMOD * DM);
#endif
#if XBF16
          if (l == 0) norm_phase<true>(F, (const void*)KIN(0), false, WSP(bf16, WS_Y), WSP(bf16, WS_XB), true, WSP(bf16, WS_H), mv + 2 * DM, mv + 4 * DM, mv + 3 * DM, NMOD * DM);
          else norm_phase_bf(F, WSP(bf16, WS_XB), WSP(bf16, WS_Y), WSP(bf16, WS_XB), true, WSP(bf16, WS_H), mv + 2 * DM, mv + 4 * DM, mv + 3 * DM, NMOD * DM); }
#else
          norm_phase<true>(F, l == 0 ? (const void*)KIN(0) : (const void*)KOUT(), false, WSP(bf16, WS_Y), KOUT(), false, WSP(bf16, WS_H), mv + 2 * DM, mv + 4 * DM, mv + 3 * DM, NMOD * DM); }
#endif
        GRID_BAR();
    if (ON(9)) REPEAT(DUP_GEMM + DUP_G2)
        {
            REPBAR();
            unsigned char* ws = KWS();
            pg8::Gemm g{WSP(bf16, WS_H), WSP(bf16, WS_W1) + (size_t)l * DFF * DM, M, DFF, DM}; pg8::StaticOrder S; S.init(M, DFF, F.G, (int)blockIdx.x);
            pg8::EpiBf16<3> E{WSP(bf16, WS_U), DFF};
            pg8::gemm_phase<pg8::EpiBf16<3>, pg8::StaticOrder, true, true>(F.lds + RING_OFF, g, S, E);
        }
        GRID_BAR();
    if (ON(10)) REPEAT(DUP_GEMM + DUP_G3)
        {
            REPBAR();
            unsigned char* ws = KWS();
            pg8::Gemm g{WSP(bf16, WS_U), WSP(bf16, WS_W2) + (size_t)l * DM * DFF, M, DM, DFF}; pg8::StaticOrder S; S.init(M, DM, F.G, (int)blockIdx.x);
            pg8::EpiBf16<0> E{WSP(bf16, WS_Y), DM};
            pg8::gemm_phase<pg8::EpiBf16<0>, pg8::StaticOrder, true, true>(F.lds + RING_OFF, g, S, E);
        }
        GRID_BAR();
    if (ON(11))
        {
            unsigned char* ws = KWS(); const float* mv = WSP(float, WS_MODV) + (size_t)l * 2 * NMOD * DM; float* out = KOUT();
            const float* mvn = WSP(float, WS_MODV) + (size_t)(l + 1 < DEPTH ? l + 1 : l) * 2 * NMOD * DM;
#if XBF16
            norm_phase_bf(F, WSP(bf16, WS_XB), WSP(bf16, WS_Y), (l + 1 < DEPTH) ? (void*)WSP(bf16, WS_XB) : (void*)out, l + 1 < DEPTH, (l + 1 < DEPTH) ? WSP(bf16, WS_H) : (bf16*)nullptr, mv + 5 * DM, mvn + 1 * DM, mvn + 0 * DM, NMOD * DM);
#else
            norm_phase<true>(F, out, false, WSP(bf16, WS_Y), out, false, (l + 1 < DEPTH) ? WSP(bf16, WS_H) : (bf16*)nullptr, mv + 5 * DM, mvn + 1 * DM, mvn + 0 * DM, NMOD * DM);
#endif
        }
        if (l + 1 < DEPTH) GRID_BAR();
    }
    __syncthreads();
    if (__hip_atomic_load((gu32*)(KWS() + WS_CTL) + CW_BAR + XB_TMO, RLX_AGENT) != 0u) {
        const float q = __builtin_nanf(""); float* out = KOUT();
        for (int chunk = blockIdx.x; chunk < M / 64; chunk += F.G) for (int i = threadIdx.x; i < 64 * DM / 4; i += NWAVES * 64) ((f32x4*)(out + (size_t)chunk * 64 * DM))[i] = (f32x4){q, q, q, q};
    }
}

extern "C" void kernel_launch(void* const* d_in, const int* in_sizes, int n_in, void* d_out, int out_size, void* d_ws, size_t ws_size, hipStream_t stream) {
    static int grid = 0;
    if (grid == 0) {
        if (n_in != 14 || in_sizes[0] != M * DM || out_size != M * DM || ws_size < WS_END) { fprintf(stderr, "kernel_launch: shape/workspace mismatch (n_in %d, in0 %d, out %d, ws %zu, need %zu)\n", n_in, n_in > 0 ? in_sizes[0] : -1, out_size, ws_size, (size_t)WS_END); grid = -1; return; }
        int dev = 0, cus = 0, per_cu = 0;
        if (hipGetDevice(&dev) != hipSuccess || hipDeviceGetAttribute(&cus, hipDeviceAttributeMultiprocessorCount, dev) != hipSuccess) { grid = -1; return; }
        if (hipFuncSetAttribute((const void*)mega_fwd, hipFuncAttributeMaxDynamicSharedMemorySize, LDS_BYTES) != hipSuccess) { fprintf(stderr, "kernel_launch: hipFuncSetAttribute failed\n"); grid = -1; return; }
        if (hipOccupancyMaxActiveBlocksPerMultiprocessor(&per_cu, (const void*)mega_fwd, NWAVES * 64, LDS_BYTES) != hipSuccess || per_cu < 1) { fprintf(stderr, "kernel_launch: occupancy query reports %d blocks per CU\n", per_cu); }
        (void)hipGetLastError();
        grid = cus;
    }
    if (grid < 0) return;
    if (hipMemsetAsync((char*)d_ws + WS_CTL, 0, CTL_ZERO_BYTES, stream) != hipSuccess) return;
    Args a{};
    for (int i = 0; i < 14; ++i) a.in[i] = (const float*)d_in[i];
    a.out = (float*)d_out; a.ws = (unsigned char*)d_ws;
    hipLaunchKernelGGL(mega_fwd, dim3(grid), dim3(NWAVES * 64), LDS_BYTES, stream, a);
    const hipError_t le = hipPeekAtLastError();
    if (le != hipSuccess) fprintf(stderr, "kernel_launch: launch failed: %s\n", hipGetErrorName(le));
}
```

```cpp
#include <hip/hip_runtime.h>
#include <cstdio>
#include <cstdint>
namespace pg8 {
#define PG8_LAS __attribute__((address_space(3)))
typedef unsigned short bf16_t;
typedef short bf16x8 __attribute__((ext_vector_type(8)));
typedef float f32x4 __attribute__((ext_vector_type(4)));
typedef unsigned u32x4 __attribute__((ext_vector_type(4)));
constexpr int BM = 256, BK = 64, HALF = 128, HTB = HALF * BK * 2  , STAGE_BYTES = 8 * HTB, NXCD = 8, WGM = 8;

__host__ __device__ __forceinline__ int lds_byte(int r, int c) { const int st = (r >> 4) * 2 + (c >> 5), rr = r & 15, cc = c & 31, ob = rr * 64 + cc * 2; return st * 1024 + (ob ^ (((ob >> 9) & 1) << 5)); }
__host__ __device__ __forceinline__ void stage_rc(int b, int& R, int& C) { const int st = b / 1024, sb = b % 1024, swz = sb ^ (((sb >> 9) & 1) << 5); R = (st >> 1) * 16 + swz / 64; C = (st & 1) * 32 + (swz % 64) / 2; }
__host__ __device__ __forceinline__ int perm32(int rho) { const int n = rho >> 4, i = rho & 15; return 8 * (i >> 2) + 4 * n + (i & 3); }

struct Unit { int pm, pn; };
struct Gemm { const bf16_t* A; const bf16_t* Bt; int M, N, K; };

struct StaticOrder {
    int nM, nN, nwg, G, c;
    __host__ __device__ void init(int M, int N, int G_, int c_) { nM = M / BM; nN = N / BM; nwg = nM * nN; G = G_; c = c_; }
    __host__ __device__ bool next(int i, Unit& u) const {
        const long L = (long)i * G + c; if (L >= nwg) return false;
        int wgid = (int)L; { const int q = nwg / NXCD, r = nwg % NXCD, xcd = wgid % NXCD, off = wgid / NXCD; wgid = (xcd < r ? xcd * (q + 1) : r * (q + 1) + (xcd - r) * q) + off; }
        const int nig = WGM * nN, gid = wgid / nig, fm = gid * WGM, gsz = (nM - fm) < WGM ? (nM - fm) : WGM;
        u.pm = fm + ((wgid % nig) % gsz); u.pn = (wgid % nig) / gsz; return true;
    }
    __device__ __forceinline__ void a_ready(const Unit&) const {}
    __device__ __forceinline__ void done(const Unit&) const {}
};

__device__ __forceinline__ unsigned cvt_pk_bf16(float lo, float hi) { unsigned r; asm volatile("v_cvt_pk_bf16_f32 %0, %1, %2" : "=v"(r) : "v"(lo), "v"(hi)); return r; }
typedef float f32x2 __attribute__((ext_vector_type(2)));
struct EpiF32 {
    static constexpr bool PERM = false, AFTER_DRAIN = false;
    float* C; int ldc;
    __device__ __forceinline__ void operator()(const f32x4 (&acc)[2][2][4][2], const Unit& u, int wr, int wc, int fr, int fq) const {
        const int row0 = u.pm * BM + wr * 64 + fr, col0 = u.pn * BM + wc * 32 + 4 * fq;
#pragma unroll
        for (int ai = 0; ai < 2; ++ai)
#pragma unroll
            for (int m = 0; m < 4; ++m) { float* rowp = C + (size_t)(row0 + ai * HALF + m * 16) * ldc + col0;
#pragma unroll
                for (int bj = 0; bj < 2; ++bj)
#pragma unroll
                    for (int n = 0; n < 2; ++n) *(f32x4*)(rowp + bj * HALF + n * 16) = acc[ai][bj][m][n]; }
    }
};
template <int ACT  > struct EpiBf16 {
    static constexpr bool PERM = true, AFTER_DRAIN = false;
    bf16_t* O; int ldc;
    __device__ __forceinline__ void operator()(const f32x4 (&acc)[2][2][4][2], const Unit& u, int wr, int wc, int fr, int fq) const {
        const int row0 = u.pm * BM + wr * 64 + fr; const int col0 = u.pn * BM + wc * 32 + 8 * fq;
#pragma unroll
        for (int ai = 0; ai < 2; ++ai)
#pragma unroll
            for (int m = 0; m < 4; ++m) { bf16_t* rowp = O + (size_t)(row0 + ai * HALF + m * 16) * ldc + col0;
#pragma unroll
                for (int bj = 0; bj < 2; ++bj) { f32x4 v0 = acc[ai][bj][m][0], v1 = acc[ai][bj][m][1];
                    if (ACT == 3) {
#pragma unroll
                        for (int j = 0; j < 4; ++j) { const float a = fmaxf(v0[j], 0.f), b = fmaxf(v1[j], 0.f); v0[j] = a * a; v1[j] = b * b; } }
                    u32x4 w; w.x = cvt_pk_bf16(v0[0], v0[1]); w.y = cvt_pk_bf16(v0[2], v0[3]); w.z = cvt_pk_bf16(v1[0], v1[1]); w.w = cvt_pk_bf16(v1[2], v1[3]);
                    *(u32x4*)(rowp + bj * HALF) = w; } }
    }
};
struct EpiQKV {
    static constexpr bool PERM = true, AFTER_DRAIN = false;
    bf16_t* O; int Mrows;
    __device__ __forceinline__ void operator()(const f32x4 (&acc)[2][2][4][2], const Unit& u, int wr, int wc, int fr, int fq) const {
        const int row0 = u.pm * BM + wr * 64 + fr;
#pragma unroll
        for (int bj = 0; bj < 2; ++bj) { bf16_t* hb = O + (size_t)(u.pn * 2 + bj) * Mrows * 128 + wc * 32 + 8 * fq;
#pragma unroll
            for (int ai = 0; ai < 2; ++ai)
#pragma unroll
                for (int m = 0; m < 4; ++m) { const f32x4 v0 = acc[ai][bj][m][0], v1 = acc[ai][bj][m][1];
                    u32x4 w; w.x = cvt_pk_bf16(v0[0], v0[1]); w.y = cvt_pk_bf16(v0[2], v0[3]); w.z = cvt_pk_bf16(v1[0], v1[1]); w.w = cvt_pk_bf16(v1[2], v1[3]);
                    *(u32x4*)(hb + (size_t)(row0 + ai * HALF + m * 16) * 128) = w; } }
    }
};
template <class Epi, class Sched, bool ALIGN_EPI = false, bool SP2 = false>
__device__ __forceinline__ void gemm_phase(PG8_LAS unsigned char* lds, const Gemm g, const Sched& S, const Epi& E) {
    int tid_ = threadIdx.x; asm volatile("" : "+v"(tid_));
    const int tid = tid_, wid = __builtin_amdgcn_readfirstlane(tid >> 6), lane = tid & 63, wr = wid >> 2, wc = wid & 3, fr = lane & 15, fq = lane >> 4;
    const int K = g.K, nt = K / BK;
    unsigned voffA[2], voffB[2];
#pragma unroll
    for (int i = 0; i < 2; ++i) { int R, C; stage_rc(tid * 16 + i * 8192, R, C); const int Rb = Epi::PERM ? ((R & ~31) + perm32(R & 31)) : R;
        voffA[i] = (unsigned)(R * K + C) * 2u; voffB[i] = (unsigned)(Rb * K + C) * 2u; }
    const size_t kstep = (size_t)(BK * 2);
    const size_t hstep = (size_t)HALF * K * 2;
    const size_t tstep = 2 * hstep;
    const unsigned ldsw = (unsigned)wid * 1024u;
    const int aoff = lds_byte(wr * 64 + fr, fq * 8), boff = lds_byte(wc * 32 + fr, fq * 8);
#define PG8_SA(b, h) (((b) * 2 + (h)) * HTB)
#define PG8_SB(b, h) ((4 + (b) * 2 + (h)) * HTB)
#define PG8_STAGE(bufoff, gbase, voff) do { _Pragma("unroll") for (int _i = 0; _i < 2; ++_i) \
        __builtin_amdgcn_global_load_lds((const unsigned*)((const char*)(gbase) + (voff)[_i]), (PG8_LAS unsigned*)(lds + (bufoff) + ldsw + _i * 8192), 16, 0, 0); } while (0)
#define PG8_LDA(dst, b, h) do { _Pragma("unroll") for (int m = 0; m < 4; ++m) _Pragma("unroll") for (int k = 0; k < 2; ++k) dst[m][k] = *(const PG8_LAS bf16x8*)(lds + PG8_SA(b, h) + aoff + m * 2048 + k * 1024); } while (0)
#define PG8_LDB(dst, b, h) do { _Pragma("unroll") for (int n = 0; n < 2; ++n) _Pragma("unroll") for (int k = 0; k < 2; ++k) dst[n][k] = *(const PG8_LAS bf16x8*)(lds + PG8_SB(b, h) + boff + n * 2048 + k * 1024); } while (0)
#define PG8_MMA(ai, bj, At, Bt) do { __builtin_amdgcn_s_setprio(1); _Pragma("unroll") for (int m = 0; m < 4; ++m) _Pragma("unroll") for (int n = 0; n < 2; ++n) _Pragma("unroll") for (int k = 0; k < 2; ++k) \
        acc[ai][bj][m][n] = __builtin_amdgcn_mfma_f32_16x16x32_bf16(Bt[n][k], At[m][k], acc[ai][bj][m][n], 0, 0, 0); __builtin_amdgcn_s_setprio(0); } while (0)
#define PG8_WAIT_V(n) asm volatile("s_waitcnt vmcnt(" #n ")" ::: "memory")
#define PG8_WAIT_L(n) asm volatile("s_waitcnt lgkmcnt(" #n ")" ::: "memory")
#define PG8_BAR __builtin_amdgcn_s_barrier()
#define PG8_SCHED __builtin_amdgcn_sched_barrier(0)
    Unit cur, nxt; int ui = 0;
    if (!S.next(0, cur)) return;
    f32x4 acc[2][2][4][2];
#pragma unroll
    for (int a = 0; a < 2; ++a)
#pragma unroll
        for (int b = 0; b < 2; ++b)
#pragma unroll
            for (int m = 0; m < 4; ++m)
#pragma unroll
                for (int n = 0; n < 2; ++n) acc[a][b][m][n] = (f32x4){0.f, 0.f, 0.f, 0.f};
    bf16x8 At[4][2], B0[2][2], B1[2][2];
    const char* cA = (const char*)g.A + (size_t)cur.pm * tstep; const char* cB = (const char*)g.Bt + (size_t)cur.pn * tstep;
    S.a_ready(cur);
    if constexpr (SP2) {
        PG8_STAGE(PG8_SB(0, 0), cB, voffB); PG8_STAGE(PG8_SB(0, 1), cB + hstep, voffB); PG8_STAGE(PG8_SA(0, 0), cA, voffA); PG8_STAGE(PG8_SA(0, 1), cA + hstep, voffA);
        if (wr == 1) PG8_BAR;
        PG8_WAIT_V(2); PG8_BAR;
        PG8_STAGE(PG8_SB(1, 0), cB + kstep, voffB); PG8_STAGE(PG8_SA(1, 0), cA + kstep, voffA); PG8_STAGE(PG8_SB(1, 1), cB + hstep + kstep, voffB);
        PG8_WAIT_V(6); PG8_BAR;
    } else {
        PG8_STAGE(PG8_SB(0, 0), cB, voffB); PG8_STAGE(PG8_SA(0, 0), cA, voffA); PG8_STAGE(PG8_SB(0, 1), cB + hstep, voffB); PG8_STAGE(PG8_SA(0, 1), cA + hstep, voffA);
        if (wr == 1) PG8_BAR;
        PG8_WAIT_V(4); PG8_BAR;
        PG8_STAGE(PG8_SB(1, 0), cB + kstep, voffB); PG8_STAGE(PG8_SA(1, 0), cA + kstep, voffA); PG8_STAGE(PG8_SB(1, 1), cB + hstep + kstep, voffB);
        PG8_WAIT_V(6); PG8_BAR;
    }
    for (;;) {
        const bool has_next = S.next(ui + 1, nxt);
        const char* nA = has_next ? (const char*)g.A + (size_t)nxt.pm * tstep : cA; const char* nB = has_next ? (const char*)g.Bt + (size_t)nxt.pn * tstep : cB;
        for (int t = 0; t < nt; t += 2) {
            const bool last = (t == nt - 2);
            const char* a1 = cA + (size_t)(t + 1) * kstep;
            const char* a2 = last ? nA : cA + (size_t)(t + 2) * kstep; const char* b2 = last ? nB : cB + (size_t)(t + 2) * kstep;
            const char* a3 = a2 + kstep; const char* b3 = b2 + kstep;
            if (last && has_next) S.a_ready(nxt);
            if constexpr (SP2) {
            PG8_LDB(B0, 0, 0); PG8_LDB(B1, 0, 1); PG8_SCHED; PG8_LDA(At, 0, 0); PG8_STAGE(PG8_SA(1, 1), a1 + hstep, voffA);
            PG8_WAIT_V(8); PG8_WAIT_L(0); PG8_BAR; PG8_MMA(0, 0, At, B0); PG8_MMA(0, 1, At, B1); PG8_BAR; PG8_SCHED;
            PG8_LDA(At, 0, 1); PG8_STAGE(PG8_SB(0, 0), b2, voffB); PG8_STAGE(PG8_SB(0, 1), b2 + hstep, voffB); PG8_STAGE(PG8_SA(0, 0), a2, voffA);
            PG8_WAIT_V(8); PG8_WAIT_L(0); PG8_BAR; PG8_MMA(1, 0, At, B0); PG8_MMA(1, 1, At, B1); PG8_BAR; PG8_SCHED;
            PG8_LDB(B0, 1, 0); PG8_LDB(B1, 1, 1); PG8_SCHED; PG8_LDA(At, 1, 0); PG8_STAGE(PG8_SA(0, 1), a2 + hstep, voffA);
            PG8_WAIT_V(8); PG8_WAIT_L(0); PG8_BAR; PG8_MMA(0, 0, At, B0); PG8_MMA(0, 1, At, B1); PG8_BAR; PG8_SCHED;
            PG8_LDA(At, 1, 1); PG8_STAGE(PG8_SB(1, 0), b3, voffB); PG8_STAGE(PG8_SB(1, 1), b3 + hstep, voffB); PG8_STAGE(PG8_SA(1, 0), a3, voffA);
            PG8_WAIT_V(8); PG8_WAIT_L(0); PG8_BAR; PG8_MMA(1, 0, At, B0); PG8_MMA(1, 1, At, B1); PG8_BAR; PG8_SCHED;
            } else {
            PG8_LDB(B0, 0, 0); PG8_SCHED; PG8_LDA(At, 0, 0); PG8_STAGE(PG8_SA(1, 1), a1 + hstep, voffA);
            PG8_WAIT_L(8); PG8_BAR; PG8_WAIT_L(0); PG8_MMA(0, 0, At, B0); PG8_BAR; PG8_SCHED;
            PG8_LDB(B1, 0, 1); PG8_STAGE(PG8_SB(0, 0), b2, voffB);
            PG8_BAR; PG8_WAIT_L(0); PG8_MMA(0, 1, At, B1); PG8_BAR;
            PG8_LDA(At, 0, 1); PG8_STAGE(PG8_SA(0, 0), a2, voffA);
            PG8_BAR; PG8_WAIT_L(0); PG8_MMA(1, 0, At, B0); PG8_BAR; PG8_SCHED;
            PG8_STAGE(PG8_SB(0, 1), b2 + hstep, voffB);
            PG8_WAIT_V(6); PG8_BAR; PG8_MMA(1, 1, At, B1); PG8_BAR;
            PG8_LDB(B0, 1, 0); PG8_SCHED; PG8_LDA(At, 1, 0); PG8_STAGE(PG8_SA(0, 1), a2 + hstep, voffA);
            PG8_WAIT_L(8); PG8_BAR; PG8_WAIT_L(0); PG8_MMA(0, 0, At, B0); PG8_BAR; PG8_SCHED;
            PG8_LDB(B1, 1, 1); PG8_STAGE(PG8_SB(1, 0), b3, voffB);
            PG8_BAR; PG8_WAIT_L(0); PG8_MMA(0, 1, At, B1); PG8_BAR;
            PG8_LDA(At, 1, 1); PG8_STAGE(PG8_SA(1, 0), a3, voffA);
            PG8_BAR; PG8_WAIT_L(0); PG8_MMA(1, 0, At, B0); PG8_BAR; PG8_SCHED;
            PG8_STAGE(PG8_SB(1, 1), b3 + hstep, voffB);
            PG8_WAIT_V(6); PG8_BAR; PG8_MMA(1, 1, At, B1); PG8_BAR;
            }
        }
        if constexpr (ALIGN_EPI) { if (wr == 0) PG8_BAR; }
        if constexpr (!Epi::AFTER_DRAIN) { E(acc, cur, wr, wc, fr, fq); S.done(cur); }
        if (!has_next) break;
#pragma unroll
        for (int a = 0; a < 2; ++a)
#pragma unroll
            for (int b = 0; b < 2; ++b)
#pragma unroll
                for (int m = 0; m < 4; ++m)
#pragma unroll
                    for (int n = 0; n < 2; ++n) acc[a][b][m][n] = (f32x4){0.f, 0.f, 0.f, 0.f};
        cur = nxt; cA = nA; cB = nB; ++ui;
        if constexpr (ALIGN_EPI) { if (wr == 1) PG8_BAR; }
    }
    PG8_WAIT_V(0);
    if constexpr (!ALIGN_EPI) { if (wr == 0) PG8_BAR; }
    PG8_BAR;
    if constexpr (Epi::AFTER_DRAIN) { E.fused(acc, cur, wr, wc, fr, fq, lds, wid, lane); S.done(cur); }
#undef PG8_SA
#undef PG8_SB
#undef PG8_STAGE
#undef PG8_LDA
#undef PG8_LDB
#undef PG8_MMA
#undef PG8_WAIT_V
#undef PG8_WAIT_L
#undef PG8_BAR
#undef PG8_SCHED
}
}
namespace att {
typedef unsigned short bf16;
using bf16x8 = __attribute__((ext_vector_type(8))) short;
using s16x4  = __attribute__((ext_vector_type(4))) short;
using f32x16 = __attribute__((ext_vector_type(16))) float;
using u32x4  = __attribute__((ext_vector_type(4))) unsigned;
constexpr int   D = 128, NW = 8, QBLK = 32, KVBLK = 64;
constexpr float SCALE = 0.088388347648318440f;
constexpr float LOG2E = 1.4426950408889634f;
constexpr float C2 = SCALE * LOG2E;
constexpr float THR = 8.f;
constexpr int SHM_V = KVBLK * D * 2, SHM_K = KVBLK * D * 2;
constexpr int LDS_WS = 2 * SHM_V + 2 * SHM_K, LDS_TB = LDS_WS + NW * 64 * 4, LDS_ATT_BYTES = LDS_TB + 4096;
#define KSWZ(row, colB) ((row) * 256 + ((colB) ^ (((row) & 7) << 4)))
#define SBAR() __builtin_amdgcn_sched_barrier(0)
__device__ __forceinline__ int crow(int r, int hi) { return (r & 3) + 8 * (r >> 2) + 4 * hi; }
typedef float f32x2_ __attribute__((ext_vector_type(2)));
typedef __bf16 bf16x2_ __attribute__((ext_vector_type(2)));
__device__ __forceinline__ unsigned cvtpk(float lo, float hi) { const f32x2_ v = {lo, hi}; const bf16x2_ r = __builtin_convertvector(v, bf16x2_); return *reinterpret_cast<const unsigned*>(&r); }
#define SGB(mask, n) __builtin_amdgcn_sched_group_barrier(mask, n, 0)
#define SG_QK() do { SGB(0x100, 2); _Pragma("unroll") for (int i_ = 0; i_ < 16; ++i_) { SGB(0x008, 1); if (i_ < 14) SGB(0x100, 1); SGB(0x400, 1); SGB(0x002, 4); } } while (0)
__device__ __forceinline__ bf16x8 ld8(const bf16* p) { return *reinterpret_cast<const bf16x8*>(p); }

struct MaskCtx { int a, v, d; const float* tbl; };
constexpr int LDS_WS_FAST = 131072 + 2048;
constexpr int TB_ORG = 256;

__device__ __forceinline__ void partialSM(f32x16& p0, f32x16& p1, float& m_reg, float& mn, float& alpha) {
  float pmax = p0[0];
#pragma unroll
  for (int r = 1; r < 16; ++r) pmax = fmaxf(pmax, p0[r]);
#pragma unroll
  for (int r = 0; r < 16; ++r) pmax = fmaxf(pmax, p1[r]);
  { auto rr = __builtin_amdgcn_permlane32_swap(__float_as_uint(pmax), __float_as_uint(pmax), false, false);
    pmax = fmaxf(__uint_as_float(rr[0]), __uint_as_float(rr[1])); }
  if (__builtin_expect(__all(pmax - m_reg <= THR / SCALE), 1)) { mn = m_reg; alpha = 1.f; }
  else { mn = fmaxf(m_reg, pmax); alpha = __builtin_amdgcn_exp2f((m_reg - mn) * C2); m_reg = mn; }
  float mnC = -mn * C2;
#pragma unroll
  for (int r = 0; r < 16; ++r) p0[r] = fmaf(p0[r], C2, mnC);
#pragma unroll
  for (int r = 0; r < 16; ++r) p1[r] = fmaf(p1[r], C2, mnC);
#pragma unroll
  for (int r = 0; r < 16; ++r) p0[r] = __builtin_amdgcn_exp2f(p0[r]);
}
template <int KIND>
__device__ __forceinline__ void partialSM_m(f32x16& p0, f32x16& p1, float& m_reg, float& mn, float& alpha, int jt, const MaskCtx& mc) {
  const float* tp = (KIND == 1) ? mc.tbl + (jt - mc.a + 7) * 31 : mc.tbl + jt * 64;
  float b0[16], b1[16];
#pragma unroll
  for (int r = 0; r < 16; ++r) { const int kc = (r & 3) + 8 * (r >> 2); b0[r] = tp[kc]; b1[r] = tp[kc + 32]; }
#pragma unroll
  for (int r = 0; r < 16; ++r) asm volatile("" : "+v"(b0[r]), "+v"(b1[r]));
  if (KIND == 1) {
    const bool rowok = (unsigned)(jt - min(max(mc.a - 4, 0), 120)) <= 7u;
#pragma unroll
    for (int r = 0; r < 16; ++r) { const int kc = (r & 3) + 8 * (r >> 2);
      { const bool ok = rowok && (unsigned)(kc - mc.v) <= 15u; const float t = fmaf(p0[r], C2, b0[r]); p0[r] = ok ? t : -1e30f; }
      { const bool ok = rowok && (unsigned)(kc + 32 - mc.v) <= 15u; const float t = fmaf(p1[r], C2, b1[r]); p1[r] = ok ? t : -1e30f; } }
  } else {
    const bool tok = (unsigned)jt < (unsigned)mc.d;
    const int db = jt * 64 + mc.v;
#pragma unroll
    for (int r = 0; r < 16; ++r) { const int kc = (r & 3) + 8 * (r >> 2);
      { const bool ok = tok && (unsigned)(db + kc) <= 128u; const float t = fmaf(p0[r], C2, b0[r]); p0[r] = ok ? t : -1e30f; }
      { const bool ok = tok && (unsigned)(db + kc + 32) <= 128u; const float t = fmaf(p1[r], C2, b1[r]); p1[r] = ok ? t : -1e30f; } }
  }
  float pmax = p0[0];
#pragma unroll
  for (int r = 1; r < 16; ++r) pmax = fmaxf(pmax, p0[r]);
#pragma unroll
  for (int r = 0; r < 16; ++r) pmax = fmaxf(pmax, p1[r]);
  { auto rr = __builtin_amdgcn_permlane32_swap(__float_as_uint(pmax), __float_as_uint(pmax), false, false);
    pmax = fmaxf(__uint_as_float(rr[0]), __uint_as_float(rr[1])); }
  if (__builtin_expect(__all(pmax - m_reg <= THR * LOG2E), 1)) { mn = m_reg; alpha = 1.f; }
  else { mn = fmaxf(m_reg, pmax); alpha = __builtin_amdgcn_exp2f(m_reg - mn); m_reg = mn; }
#pragma unroll
  for (int r = 0; r < 16; ++r) p0[r] -= mn;
#pragma unroll
  for (int r = 0; r < 16; ++r) p1[r] -= mn;
#pragma unroll
  for (int r = 0; r < 16; ++r) p0[r] = __builtin_amdgcn_exp2f(p0[r]);
}
template <bool FAST = false>
__device__ __forceinline__ void finishSM(f32x16& p0, f32x16& p1, float alpha, float& l_reg, bf16x8& pa0, bf16x8& pa1, bf16x8& pa2, bf16x8& pa3) {
#pragma unroll
  for (int r = 0; r < 16; ++r) p1[r] = __builtin_amdgcn_exp2f(p1[r]);
  float ps = 0;
#pragma unroll
  for (int r = 0; r < 16; ++r) ps += p0[r];
#pragma unroll
  for (int r = 0; r < 16; ++r) ps += p1[r];
  if (FAST) l_reg += ps;
  else { auto rr = __builtin_amdgcn_permlane32_swap(__float_as_uint(ps), __float_as_uint(ps), false, false);
    ps = __uint_as_float(rr[0]) + __uint_as_float(rr[1]); l_reg = l_reg * alpha + ps; }
#define PK4(P, BASE, OUT) do { unsigned a0 = cvtpk(P[BASE + 0], P[BASE + 1]), a1 = cvtpk(P[BASE + 2], P[BASE + 3]);   \
    unsigned b0 = cvtpk(P[BASE + 4], P[BASE + 5]), b1 = cvtpk(P[BASE + 6], P[BASE + 7]);                              \
    auto r0 = __builtin_amdgcn_permlane32_swap(a0, b0, false, false); auto r1 = __builtin_amdgcn_permlane32_swap(a1, b1, false, false); \
    u32x4 w = {r0[0], r1[0], r0[1], r1[1]}; OUT = *reinterpret_cast<bf16x8*>(&w); } while (0)
  PK4(p0, 0, pa0); PK4(p0, 8, pa1); PK4(p1, 0, pa2); PK4(p1, 8, pa3);
#undef PK4
}
__device__ __forceinline__ void qkt(f32x16& p0, f32x16& p1, const bf16* Ks, const bf16x8* qr, int r32, int hi) {
  p0 = f32x16{}; p1 = f32x16{};
#pragma unroll
  for (int d0 = 0; d0 < 8; ++d0) { int cb = (d0 * 16 + hi * 8) * 2;
    bf16x8 b0 = *reinterpret_cast<const bf16x8*>((const char*)Ks + KSWZ(r32, cb));
    bf16x8 b1 = *reinterpret_cast<const bf16x8*>((const char*)Ks + KSWZ(32 + r32, cb));
    p0 = __builtin_amdgcn_mfma_f32_32x32x16_bf16(b0, qr[d0], p0, 0, 0, 0);
    p1 = __builtin_amdgcn_mfma_f32_32x32x16_bf16(b1, qr[d0], p1, 0, 0, 0); }
}
__device__ __forceinline__ int v_st(int k, int c) { const int kk = (k & ~0xC) | ((k & 4) << 1) | ((k & 8) >> 1); return ((kk >> 3) * 4 + (c >> 5)) * 512 + ((kk & 7) * 32 + (c & 31)) * 2; }
__device__ __forceinline__ int v_rd_base(int lane) { return ((lane & 3) << 3) | (((lane >> 2) & 3) << 6) | (((lane >> 4) & 1) << 5) | (((lane >> 5) & 1) << 8); }
constexpr int v_rd_off(int d0, int ks, int half) { return d0 * 512 + ks * 4096 + half * 2048; }
template <int OFF> __device__ __forceinline__ s16x4 tr_read(int vb) {
  s16x4 r; asm volatile("ds_read_b64_tr_b16 %0, %1 offset:%2" : "=&v"(r) : "v"(vb), "i"(OFF) : "memory"); return r;
}
template <int D0> __device__ __forceinline__ void pv_one(f32x16& od, int vb, bf16x8 pa0, bf16x8 pa1, bf16x8 pa2, bf16x8 pa3) {
  const s16x4 l0 = tr_read<v_rd_off(D0, 0, 0)>(vb), h0 = tr_read<v_rd_off(D0, 0, 1)>(vb), l1 = tr_read<v_rd_off(D0, 1, 0)>(vb), h1 = tr_read<v_rd_off(D0, 1, 1)>(vb);
  const s16x4 l2 = tr_read<v_rd_off(D0, 2, 0)>(vb), h2 = tr_read<v_rd_off(D0, 2, 1)>(vb), l3 = tr_read<v_rd_off(D0, 3, 0)>(vb), h3 = tr_read<v_rd_off(D0, 3, 1)>(vb);
  asm volatile("s_waitcnt lgkmcnt(0)" ::: "memory"); SBAR();
#define PK(L, H) (bf16x8){L[0], L[1], L[2], L[3], H[0], H[1], H[2], H[3]}
  od = __builtin_amdgcn_mfma_f32_32x32x16_bf16(pa0, PK(l0, h0), od, 0, 0, 0);
  od = __builtin_amdgcn_mfma_f32_32x32x16_bf16(pa1, PK(l1, h1), od, 0, 0, 0);
  od = __builtin_amdgcn_mfma_f32_32x32x16_bf16(pa2, PK(l2, h2), od, 0, 0, 0);
  od = __builtin_amdgcn_mfma_f32_32x32x16_bf16(pa3, PK(l3, h3), od, 0, 0, 0);
#undef PK
}
__device__ __forceinline__ void pv_d0(f32x16* o, int vb, bf16x8 pa0, bf16x8 pa1, bf16x8 pa2, bf16x8 pa3) {
  pv_one<0>(o[0], vb, pa0, pa1, pa2, pa3); pv_one<1>(o[1], vb, pa0, pa1, pa2, pa3); pv_one<2>(o[2], vb, pa0, pa1, pa2, pa3); pv_one<3>(o[3], vb, pa0, pa1, pa2, pa3);
}
#define PKS(C, B, OUT) do { auto r0_ = __builtin_amdgcn_permlane32_swap(C[(B)], C[(B) + 2], false, false); auto r1_ = __builtin_amdgcn_permlane32_swap(C[(B) + 1], C[(B) + 3], false, false); \
    u32x4 w_ = {r0_[0], r1_[0], r0_[1], r1_[1]}; OUT = *reinterpret_cast<bf16x8*>(&w_); } while (0)
#ifndef KDEP
#define KDEP 1
#endif
#define KRD1(g_, X) do { const int cb_ = (((g_) >> 1) * 16 + hi * 8) * 2; X = *reinterpret_cast<const bf16x8*>((const char*)Ks + KSWZ(((g_) & 1) * 32 + r32, cb_)); } while (0)
struct VPre { s16x4 l0, h0, l1, h1, l2, h2, l3, h3; };
template <bool FAST, bool VPRE = false>
__device__ __forceinline__ void qk_fsm(f32x16& n0, f32x16& n1, const bf16* Ks, const bf16x8* qr, int r32, int hi,
                                       f32x16& p0, f32x16& p1, float alpha, float& l_reg, bf16x8& pa0, bf16x8& pa1, bf16x8& pa2, bf16x8& pa3, int vbn, VPre& vp) {
  n0 = f32x16{}; n1 = f32x16{};
  bf16x8 kf[KDEP + 1]; unsigned c[16]; float s0 = 0.f, s1 = 0.f, ps = 0.f;
#pragma unroll
  for (int g = 0; g < KDEP; ++g) KRD1(g, kf[g]);
#pragma unroll
  for (int g = 0; g < 16; ++g) { const int d0 = g >> 1;
    if (g + KDEP < 16) KRD1(g + KDEP, kf[(g + KDEP) % (KDEP + 1)]);
    if ((g & 1) == 0) n0 = __builtin_amdgcn_mfma_f32_32x32x16_bf16(kf[g % (KDEP + 1)], qr[d0], n0, 0, 0, 0);
    else              n1 = __builtin_amdgcn_mfma_f32_32x32x16_bf16(kf[g % (KDEP + 1)], qr[d0], n1, 0, 0, 0);
    if (g < 4) { p1[2 * g] = __builtin_amdgcn_exp2f(p1[2 * g]); p1[2 * g + 1] = __builtin_amdgcn_exp2f(p1[2 * g + 1]); }
    else if (g < 12) p1[g + 4] = __builtin_amdgcn_exp2f(p1[g + 4]);
    if (g < 8) { s0 += p0[2 * g]; s1 += p0[2 * g + 1]; c[g] = cvtpk(p0[2 * g], p0[2 * g + 1]); }
    if (g >= 5 && g <= 12) { const int k = g - 5; s0 += p1[2 * k]; s1 += p1[2 * k + 1]; c[8 + k] = cvtpk(p1[2 * k], p1[2 * k + 1]); }
    if (g <= 12) asm volatile("" : "+v"(s0), "+v"(s1));
    if (g == 4) PKS(c, 0, pa0);
    if (g == 8) PKS(c, 4, pa1);
    if (g == 9) PKS(c, 8, pa2);
    if (g == 13) { PKS(c, 12, pa3); ps = s0 + s1; }
    if (g == 14 && !FAST) { auto rr = __builtin_amdgcn_permlane32_swap(__float_as_uint(ps), __float_as_uint(ps), false, false); ps = __uint_as_float(rr[0]) + __uint_as_float(rr[1]); }
    if (g == 15) l_reg = FAST ? l_reg + ps : l_reg * alpha + ps;
    if constexpr (VPRE) {
      if (g == 8) { vp.l0 = tr_read<v_rd_off(0, 0, 0)>(vbn); vp.h0 = tr_read<v_rd_off(0, 0, 1)>(vbn); }
      if (g == 9) { vp.l1 = tr_read<v_rd_off(0, 1, 0)>(vbn); vp.h1 = tr_read<v_rd_off(0, 1, 1)>(vbn); }
      if (g == 10) { vp.l2 = tr_read<v_rd_off(0, 2, 0)>(vbn); vp.h2 = tr_read<v_rd_off(0, 2, 1)>(vbn); }
      if (g == 11) { vp.l3 = tr_read<v_rd_off(0, 3, 0)>(vbn); vp.h3 = tr_read<v_rd_off(0, 3, 1)>(vbn); } }
    SBAR();
  }
}
#undef KRD1
template <bool FAST>
__device__ __forceinline__ void pv_psm(f32x16* o, int vb, bf16x8 pa0, bf16x8 pa1, bf16x8 pa2, bf16x8 pa3, f32x16& p0, f32x16& p1, float& m_reg, float& mn, float& alpha, const VPre& vp) {
  if constexpr (FAST) {
    {
      asm volatile("s_waitcnt lgkmcnt(0)" ::: "memory"); SBAR();
#define PK(L, H) (bf16x8){L[0], L[1], L[2], L[3], H[0], H[1], H[2], H[3]}
      o[0] = __builtin_amdgcn_mfma_f32_32x32x16_bf16(pa0, PK(vp.l0, vp.h0), o[0], 0, 0, 0);
      o[0] = __builtin_amdgcn_mfma_f32_32x32x16_bf16(pa1, PK(vp.l1, vp.h1), o[0], 0, 0, 0);
      o[0] = __builtin_amdgcn_mfma_f32_32x32x16_bf16(pa2, PK(vp.l2, vp.h2), o[0], 0, 0, 0);
      o[0] = __builtin_amdgcn_mfma_f32_32x32x16_bf16(pa3, PK(vp.l3, vp.h3), o[0], 0, 0, 0);
#undef PK
    }
#pragma unroll
    for (int r = 0; r < 4; ++r) p0[r] = __builtin_amdgcn_exp2f(p0[r]);
    pv_one<1>(o[1], vb, pa0, pa1, pa2, pa3);
#pragma unroll
    for (int r = 4; r < 8; ++r) p0[r] = __builtin_amdgcn_exp2f(p0[r]);
    pv_one<2>(o[2], vb, pa0, pa1, pa2, pa3);
#pragma unroll
    for (int r = 8; r < 12; ++r) p0[r] = __builtin_amdgcn_exp2f(p0[r]);
    pv_one<3>(o[3], vb, pa0, pa1, pa2, pa3);
#pragma unroll
    for (int r = 12; r < 16; ++r) p0[r] = __builtin_amdgcn_exp2f(p0[r]);
    asm volatile("" : "+v"(p0), "+v"(p1));
    return;
  }
  pv_one<0>(o[0], vb, pa0, pa1, pa2, pa3);
  float pmax = p0[0];
#pragma unroll
  for (int r = 1; r < 16; ++r) pmax = fmaxf(pmax, p0[r]);
  pv_one<1>(o[1], vb, pa0, pa1, pa2, pa3);
#pragma unroll
  for (int r = 0; r < 16; ++r) pmax = fmaxf(pmax, p1[r]);
  { auto rr = __builtin_amdgcn_permlane32_swap(__float_as_uint(pmax), __float_as_uint(pmax), false, false);
    pmax = fmaxf(__uint_as_float(rr[0]), __uint_as_float(rr[1])); }
  if (__builtin_expect(__all(pmax - m_reg <= THR / SCALE), 1)) { mn = m_reg; alpha = 1.f; }
  else { mn = fmaxf(m_reg, pmax); alpha = __builtin_amdgcn_exp2f((m_reg - mn) * C2); m_reg = mn; }
  const float mnC = -mn * C2;
  pv_one<2>(o[2], vb, pa0, pa1, pa2, pa3);
#pragma unroll
  for (int r = 0; r < 16; ++r) p0[r] = fmaf(p0[r], C2, mnC);
#pragma unroll
  for (int r = 0; r < 16; ++r) p1[r] = fmaf(p1[r], C2, mnC);
  pv_one<3>(o[3], vb, pa0, pa1, pa2, pa3);
#pragma unroll
  for (int r = 0; r < 16; ++r) p0[r] = __builtin_amdgcn_exp2f(p0[r]);
  asm volatile("" : "+v"(p0), "+v"(p1));
}

template <int KIND, bool FAST = false>
__device__ __forceinline__ void attn_unit(const bf16* __restrict__ Qb, long qs, const bf16* __restrict__ Kh, const bf16* __restrict__ Vh, long ks,
                                          int kt0, int NT, int ktmax, bf16* __restrict__ Ob, long os, float* __restrict__ stp, long sts,
                                          int mq0, const float* __restrict__ tbsrc, int tbn, char* lds,
                                          const float* __restrict__ qg = nullptr, const float* __restrict__ rope = nullptr, int t0 = 0) {
  int tid_ = threadIdx.x; asm volatile("" : "+v"(tid_));
  const int tid = tid_, wid = __builtin_amdgcn_readfirstlane(tid >> 6), lane = tid & 63, r32 = lane & 31, hi = lane >> 5;
  bf16* V_lds = (bf16*)lds; bf16* K_lds = (bf16*)(lds + 2 * SHM_V);
  float* ws = (float*)(lds + (FAST ? LDS_WS_FAST : LDS_WS)) + wid * 64; float* li_l = ws; float* al_l = ws + 32;
  float* tb = (float*)(lds + LDS_TB);
  MaskCtx mc; mc.a = 0; mc.v = 0; mc.d = 0; mc.tbl = tb;
  if (KIND == 1) { const int r = mq0 + (wid >> 1), c = (wid & 1) * 32 + r32; mc.a = r; mc.v = min(max(c - 8, 0), 48) - 4 * hi; mc.tbl = tb + TB_ORG + 15 - c + 4 * hi; }
  if (KIND == 2) { mc.v = 64 - (mq0 + wid * 32 + r32) + 4 * hi; mc.d = ktmax; mc.tbl = tb + TB_ORG + mc.v; }
  if (KIND != 0) { __syncthreads();
    for (int i = tid; i < tbn; i += 64 * NW) tb[TB_ORG + i] = tbsrc[i] * LOG2E; }
  float m_reg = -1e30f, l_reg = 0; f32x16 o[4] = {}; bf16x8 qr[8];
  const bf16* Qw = Qb + (long)(wid * QBLK + r32) * qs + hi * 8;
#pragma unroll
  for (int d0 = 0; d0 < 8; ++d0) qr[d0] = ld8(Qw + d0 * 16);
  if (KIND == 0 && qg != nullptr) {
#define UNPK(X, W) do { X[0] = __uint_as_float(W[0] << 16); X[1] = __uint_as_float(W[0] & 0xffff0000u); X[2] = __uint_as_float(W[1] << 16); X[3] = __uint_as_float(W[1] & 0xffff0000u); \
      X[4] = __uint_as_float(W[2] << 16); X[5] = __uint_as_float(W[2] & 0xffff0000u); X[6] = __uint_as_float(W[3] << 16); X[7] = __uint_as_float(W[3] & 0xffff0000u); } while (0)
    float ss = 0.f;
#pragma unroll
    for (int d0 = 0; d0 < 8; ++d0) { const u32x4 w = *reinterpret_cast<const u32x4*>(&qr[d0]); float x[8]; UNPK(x, w);
#pragma unroll
      for (int i = 0; i < 8; ++i) ss += x[i] * x[i]; }
    { auto rr = __builtin_amdgcn_permlane32_swap(__float_as_uint(ss), __float_as_uint(ss), false, false); ss = __uint_as_float(rr[0]) + __uint_as_float(rr[1]); }
    const float rstd = (FAST ? C2 : 1.0f) / sqrtf(ss * (1.0f / 128.0f) + 1e-6f);
    const int t = t0 + wid * QBLK + r32;
#pragma unroll
    for (int d0 = 0; d0 < 8; ++d0) asm volatile("" : "+v"(qr[d0]));
#pragma unroll
    for (int half = 0; half < 2; ++half) { const int pos = half ? (t & 63) : (t >> 6);
#pragma unroll
      for (int dd = 0; dd < 2; ++dd) { const int d1 = half * 4 + dd, d2 = d1 + 2; const float* rp = rope + pos * 32 + dd * 16 + hi * 8;
        const float4 c0 = *reinterpret_cast<const float4*>(rp), c1 = *reinterpret_cast<const float4*>(rp + 4), s0 = *reinterpret_cast<const float4*>(rp + 4096), s1 = *reinterpret_cast<const float4*>(rp + 4100);
        const float cs[8] = {c0.x, c0.y, c0.z, c0.w, c1.x, c1.y, c1.z, c1.w}, sn[8] = {s0.x, s0.y, s0.z, s0.w, s1.x, s1.y, s1.z, s1.w};
        const float* gp1 = qg + d1 * 16 + hi * 8; const float* gp2 = qg + d2 * 16 + hi * 8;
        const float4 ga = *reinterpret_cast<const float4*>(gp1), gb = *reinterpret_cast<const float4*>(gp1 + 4), gc = *reinterpret_cast<const float4*>(gp2), gd = *reinterpret_cast<const float4*>(gp2 + 4);
        const float g1[8] = {ga.x, ga.y, ga.z, ga.w, gb.x, gb.y, gb.z, gb.w}, g2[8] = {gc.x, gc.y, gc.z, gc.w, gd.x, gd.y, gd.z, gd.w};
        const u32x4 w1 = *reinterpret_cast<const u32x4*>(&qr[d1]), w2 = *reinterpret_cast<const u32x4*>(&qr[d2]); float x1[8], x2[8], y1[8], y2[8]; UNPK(x1, w1); UNPK(x2, w2);
#pragma unroll
        for (int i = 0; i < 8; ++i) { const float a1 = x1[i] * (rstd * g1[i]), a2 = x2[i] * (rstd * g2[i]); y1[i] = a1 * cs[i] - a2 * sn[i]; y2[i] = a1 * sn[i] + a2 * cs[i]; }
        { u32x4 w = {cvtpk(y1[0], y1[1]), cvtpk(y1[2], y1[3]), cvtpk(y1[4], y1[5]), cvtpk(y1[6], y1[7])}; qr[d1] = *reinterpret_cast<bf16x8*>(&w); }
        { u32x4 w = {cvtpk(y2[0], y2[1]), cvtpk(y2[2], y2[3]), cvtpk(y2[4], y2[5]), cvtpk(y2[6], y2[7])}; qr[d2] = *reinterpret_cast<bf16x8*>(&w); } } }
#undef UNPK
  }
  const int sr = tid >> 4, sc = (tid & 15) * 8, vst0 = v_st(sr, sc), vst1 = v_st(32 + sr, sc);
  const int vb0 = (int)(uintptr_t)V_lds + v_rd_base(lane);
  const bf16* Kp = Kh + (long)sr * ks + sc; const bf16* Vp = Vh + (long)sr * ks + sc; const long o32 = 32 * ks, tstep = 64 * ks;
  struct { bf16x8 vs0, vs1, ks0, ks1; } sr_[2];
#define TCL(j) ((long)min(max(kt0 + (j), 0), ktmax - 1))
#define SLOAD(i, j) do { const long off_ = TCL(j) * tstep; sr_[i].vs0 = ld8(Vp + off_); sr_[i].vs1 = ld8(Vp + off_ + o32); sr_[i].ks0 = ld8(Kp + off_); sr_[i].ks1 = ld8(Kp + off_ + o32); } while (0)
#define SWRITE(b, i) do { *(bf16x8*)((char*)V_lds + (b) * SHM_V + vst0) = sr_[i].vs0;          \
    *(bf16x8*)((char*)V_lds + (b) * SHM_V + vst1) = sr_[i].vs1; int kc = sc * 2;               \
    *(bf16x8*)((char*)K_lds + (b) * SHM_K + KSWZ(sr, kc)) = sr_[i].ks0;                       \
    *(bf16x8*)((char*)K_lds + (b) * SHM_K + KSWZ(32 + sr, kc)) = sr_[i].ks1; } while (0)
#define SWAIT() asm volatile("s_waitcnt vmcnt(4)" ::: "memory")
#define RESC(a) do { if (__any((a) < 1.f)) { if (hi == 0) al_l[r32] = (a); asm volatile("s_waitcnt lgkmcnt(0)" ::: "memory"); \
    _Pragma("unroll") for (int d = 0; d < 4; ++d) _Pragma("unroll") for (int r = 0; r < 16; ++r) o[d][r] *= al_l[crow(r, hi)]; } } while (0)
  if constexpr (KIND == 0 && FAST) {
    char* Kr = lds; char* Vr = lds + 4 * SHM_K;
    unsigned kof[2], vof[2];
#pragma unroll
    for (int i = 0; i < 2; ++i) { const int I = 2 * wid + i;
      const int r = 4 * I + (lane >> 4), sl = lane & 15; kof[i] = (unsigned)(r * (int)ks * 2 + ((sl ^ (r & 7)) << 4));
      const int G = I * 64 + lane, S = G >> 5, kk = ((S >> 2) << 3) | ((G >> 2) & 7), c = ((S & 3) << 5) | ((G & 3) << 3);
      const int k = (kk & ~0xC) | ((kk & 4) << 1) | ((kk & 8) >> 1); vof[i] = (unsigned)(k * (int)ks * 2 + c * 2); }
    const long tstep_ = 64 * ks;
    const int kl0 = __builtin_amdgcn_readfirstlane((int)(uintptr_t)Kr + 2 * wid * 1024), vl0 = __builtin_amdgcn_readfirstlane((int)(uintptr_t)Vr + 2 * wid * 1024);
#define DMA1(ldsa, voff, gp) asm volatile("s_mov_b32 m0, %0\n\ts_nop 0\n\tglobal_load_lds_dwordx4 %1, %2" :: "s"(ldsa), "v"(voff), "s"(gp) : "memory")
#define DMA(b, j) do { const long tb_ = (long)min(max(kt0 + (j), 0), ktmax - 1) * tstep_; const char* kg_ = (const char*)(Kh + tb_); const char* vg_ = (const char*)(Vh + tb_);          \
      _Pragma("unroll") for (int i_ = 0; i_ < 2; ++i_) { DMA1(kl0 + (b) * SHM_K + i_ * 1024, kof[i_], kg_); DMA1(vl0 + (b) * SHM_V + i_ * 1024, vof[i_], vg_); } } while (0)
#define KB(b) ((const bf16*)(Kr + (b) * SHM_K))
#define VB(b) ((int)(uintptr_t)Vr + v_rd_base(lane) + (b) * (int)SHM_V)
    f32x16 pA0, pA1, pB0, pB1; float mnD = 0.f, alD = 1.f; bf16x8 pa0, pa1, pa2, pa3; VPre vpre;
    DMA(0, 0); DMA(1, 1); DMA(2, 2);
    asm volatile("s_waitcnt vmcnt(8)" ::: "memory"); __syncthreads();
    qkt(pA0, pA1, KB(0), qr, r32, hi);
#pragma unroll
    for (int r = 0; r < 16; ++r) pA0[r] = __builtin_amdgcn_exp2f(pA0[r]);
#define IT(N0, N1, O0, O1, BK, BV, BW, J) do {                                                                                                      \
      asm volatile("s_waitcnt vmcnt(4)" ::: "memory"); __syncthreads();              \
      if ((J) + 2 < NT) DMA(BW, (J) + 2); SBAR();                                                                                                                     \
      qk_fsm<false, true>(N0, N1, KB(BK), qr, r32, hi, O0, O1, 1.f, l_reg, pa0, pa1, pa2, pa3, VB(BV), vpre);                                       \
      pv_psm<true>(o, VB(BV), pa0, pa1, pa2, pa3, N0, N1, m_reg, mnD, alD, vpre); } while (0)
    int j = 1;
    for (; j + 3 < NT; j += 4) {
      IT(pB0, pB1, pA0, pA1, 1, 0, 3, j); IT(pA0, pA1, pB0, pB1, 2, 1, 0, j + 1); IT(pB0, pB1, pA0, pA1, 3, 2, 1, j + 2); IT(pA0, pA1, pB0, pB1, 0, 3, 2, j + 3);
    }
    IT(pB0, pB1, pA0, pA1, 1, 0, 3, j); IT(pA0, pA1, pB0, pB1, 2, 1, 0, j + 1);
    constexpr int sk = 3, sv = 2;
    asm volatile("s_waitcnt vmcnt(0)" ::: "memory"); __syncthreads();
    SBAR(); qk_fsm<false, true>(pB0, pB1, KB(sk), qr, r32, hi, pA0, pA1, 1.f, l_reg, pa0, pa1, pa2, pa3, VB(sv), vpre);
    pv_psm<true>(o, VB(sv), pa0, pa1, pa2, pa3, pB0, pB1, m_reg, mnD, alD, vpre);
    finishSM(pB0, pB1, 1.f, l_reg, pa0, pa1, pa2, pa3); SBAR();
    pv_d0(o, VB(sk), pa0, pa1, pa2, pa3);
#undef IT
#undef DMA
#undef DMA1
#undef KB
#undef VB
  } else
  {
  bf16x8 pa0, pa1, pa2, pa3;
  {
    const int nd_lo = (KIND == 1) ? min(max(mq0 + (wid >> 1) - 4, 0), 120) : (mq0 + 32 * wid - 127);
    const int nd_hi = mq0 + 32 * wid + 95;
#define NEED(jt) ((KIND == 0) ? true : (KIND == 1) ? ((unsigned)((jt) - nd_lo) <= 7u) : ((unsigned)(jt) < (unsigned)ktmax && 64 * (jt) >= nd_lo && 64 * (jt) <= nd_hi))
    f32x16 p0, p1; float mn, al;
    SLOAD(0, 0); SLOAD(1, 1);
#define STEP(J, B) do { SWRITE(B, B); if ((J) + 2 < NT) SLOAD(B, (J) + 2); __syncthreads();                                     \
      if (NEED(kt0 + (J))) { qkt(p0, p1, (bf16*)((char*)K_lds + (B) * SHM_K), qr, r32, hi); if constexpr (KIND == 0) partialSM(p0, p1, m_reg, mn, al); else partialSM_m<KIND>(p0, p1, m_reg, mn, al, kt0 + (J), mc); RESC(al); \
        finishSM(p0, p1, al, l_reg, pa0, pa1, pa2, pa3); SBAR(); pv_d0(o, vb0 + (B) * (int)SHM_V, pa0, pa1, pa2, pa3); } } while (0)
    for (int j = 0; j < NT; j += 2) { STEP(j, 0); STEP(j + 1, 1); }
#undef STEP
#undef NEED
  }
  }
  if (hi == 0) li_l[r32] = l_reg; asm volatile("s_waitcnt lgkmcnt(0)" ::: "memory");
  if (KIND == 2) { if (hi == 0) { float* sp = stp + (long)(wid * QBLK + r32) * sts; sp[0] = m_reg; sp[1] = l_reg; } }
  float rli[16];
#pragma unroll
  for (int r = 0; r < 16; ++r) rli[r] = __builtin_amdgcn_rcpf(li_l[crow(r, hi)]);
  bf16* Ow = Ob + (long)(wid * QBLK) * os;
#pragma unroll
  for (int r = 0; r < 16; ++r) { const int orow = crow(r, hi);
#pragma unroll
    for (int d0 = 0; d0 < 4; ++d0) { const float v = o[d0][r] * rli[r]; Ow[(long)orow * os + d0 * 32 + r32] = (bf16)(cvtpk(v, v) & 0xffffu); } }
#undef TCL
#undef SLOAD
#undef SWRITE
#undef SWAIT
#undef RESC
}
}
#define GAS __attribute__((address_space(1)))
#define LAS __attribute__((address_space(3)))
typedef unsigned short bf16;
typedef unsigned v4u __attribute__((ext_vector_type(4)));
typedef float f32x4 __attribute__((ext_vector_type(4)));
typedef short bf16x8 __attribute__((ext_vector_type(8)));
typedef GAS unsigned gu32;
typedef GAS unsigned long long gu64;
#define RLX_AGENT __ATOMIC_RELAXED, __HIP_MEMORY_SCOPE_AGENT
#define LDS_WAIT() asm volatile("s_waitcnt lgkmcnt(0)" ::: "memory")
#define VM_WAIT() asm volatile("s_waitcnt vmcnt(0)" ::: "memory")
__device__ __forceinline__ unsigned long long rt() { return __builtin_amdgcn_s_memrealtime(); }
__device__ __forceinline__ unsigned f2bf(float f) { unsigned u = __builtin_bit_cast(unsigned, f); return (u + 0x7fffu + ((u >> 16) & 1u)) >> 16; }
__device__ __forceinline__ unsigned pk2(float lo, float hi) { return f2bf(lo) | (f2bf(hi) << 16); }

#define XB_TMO      128
#define XB_XCNT(j)  (256  + 64 * (j))
#define XB_XSUB(j)  (1280 + 64 * (j))
#define XB_XGEN(j)  (2304 + 64 * (j))
#define XB_TOP      3328
#define XB_TOPGEN   3392
#define XCD_BAR_WORDS 3456
#define XB_SPIN_CAP (1u << 18)

__device__ __forceinline__ unsigned xb_ld(unsigned* p)              { return __hip_atomic_load(p, __ATOMIC_RELAXED, __HIP_MEMORY_SCOPE_AGENT); }
__device__ __forceinline__ unsigned xb_add(unsigned* p, unsigned v) { return __hip_atomic_fetch_add(p, v, __ATOMIC_RELAXED, __HIP_MEMORY_SCOPE_AGENT); }
__device__ __forceinline__ unsigned xb_xcc_id() { return (unsigned)__builtin_amdgcn_s_getreg((3 << 11) | 20) & 0xFu; }
#define XB_SPIN(cond, bar) do { unsigned _sp = 0; while (cond) { __builtin_amdgcn_s_sleep(1); \
    if ((++_sp & 255u) == 0u) { if (xb_ld(&(bar)[XB_TMO])) break; if (_sp > XB_SPIN_CAP) { atomicAdd(&(bar)[XB_TMO], 1u); break; } } } } while (0)

struct XcdBarrier {
    unsigned* bar; unsigned x;
    volatile LAS unsigned* st;
};

__device__ __forceinline__ XcdBarrier xcd_barrier_post(unsigned* bar, volatile LAS unsigned* st) {
    XcdBarrier b; b.bar = bar; b.x = xb_xcc_id(); b.st = st;
    if (threadIdx.x == 0) (void)xb_add(&bar[XB_XCNT(b.x)], 1u);
    return b;
}
__device__ __forceinline__ void xcd_barrier_complete(unsigned* bar, unsigned x, unsigned& nloc, unsigned& nx) {
    const unsigned G = gridDim.x * gridDim.y * gridDim.z;
    unsigned sum, cnt, mine, sp = 0u;
    for (;;) {
        sum = 0u; cnt = 0u; mine = 0u;
#pragma unroll
        for (unsigned j = 0; j < 16; ++j) { const unsigned c = xb_ld(&bar[XB_XCNT(j)]); sum += c; cnt += (c > 0u) ? 1u : 0u; mine = (j == x) ? c : mine; }
        if (sum == G) break;
        __builtin_amdgcn_s_sleep(1);
        if ((++sp & 255u) == 0u) { if (xb_ld(&bar[XB_TMO])) break; if (sp > XB_SPIN_CAP) { atomicAdd(&bar[XB_TMO], 1u); break; } }
    }
    nloc = mine > 0u ? mine : 1u; nx = cnt > 0u ? cnt : 1u;
}

__device__ __forceinline__ void xcd_barrier(const XcdBarrier& b) {
    asm volatile("s_waitcnt vmcnt(0)" ::: "memory");
    __syncthreads();
    if (threadIdx.x == 0) {
        unsigned* bar = b.bar;
        __builtin_amdgcn_s_waitcnt(0);
        unsigned nloc = b.st[0], nx = b.st[1];
        if (nloc == 0u) { xcd_barrier_complete(bar, b.x, nloc, nx); b.st[0] = nloc; b.st[1] = nx; }
        const unsigned old = xb_add(&bar[XB_XSUB(b.x)], 1u);
        const unsigned gen = old / nloc;
        if (old + 1u == (gen + 1u) * nloc) {
            __builtin_amdgcn_fence(__ATOMIC_RELEASE, "agent");
            asm volatile("s_waitcnt vmcnt(0)" ::: "memory");
            const unsigned og = xb_add(&bar[XB_TOP], 1u);
            const unsigned tg = og / nx;
            if (og + 1u == (tg + 1u) * nx) xb_add(&bar[XB_TOPGEN], 1u);
            else XB_SPIN(xb_ld(&bar[XB_TOPGEN]) == tg, bar);
            __builtin_amdgcn_fence(__ATOMIC_ACQUIRE, "agent");
            xb_add(&bar[XB_XGEN(b.x)], 1u);
            asm volatile("s_waitcnt vmcnt(0)" ::: "memory");
        } else {
            XB_SPIN(xb_ld(&bar[XB_XGEN(b.x)]) == gen, bar);
            __builtin_amdgcn_fence(__ATOMIC_ACQUIRE, "agent");
            asm volatile("s_waitcnt vmcnt(0)" ::: "memory");
        }
    }
    __syncthreads();
}
constexpr int BATCH = 2, SEQ = 8192, DM = 4096, DEPTH = 4, HDIM = 128, H_NA = 8, H_DIL = 12, H_GQA = 12, KV_GQA = 4;
constexpr int NQKV = 10240, DFF = 16384, M = BATCH * SEQ, NMOD = 6;
constexpr int Q_NA = 0, Q_DIL = 1024, Q_GQA = 2560, K_NA = 4096, K_DIL = 5120, K_GQA = 6656, V_NA = 7168, V_DIL = 8192, V_GQA = 9728;
constexpr int O_NA = 0, O_DIL = 1024, O_GQA = 2560, DILW = H_DIL * HDIM;
constexpr float EPS = 1e-6f;
constexpr size_t MiB = 1u << 20;
constexpr size_t WS_CTL = 0, CTL_ZERO_BYTES = 1 * MiB;
constexpr size_t WS_MODP = 1 * MiB;
constexpr size_t WS_MODV = 4 * MiB;
constexpr size_t WS_ROPE = 5 * MiB;
constexpr size_t WS_DILTB = 5 * MiB + 64 * 1024;
constexpr size_t WS_DILST = 6 * MiB;
constexpr size_t WS_WIN = 16 * MiB, WS_WOUT = 336 * MiB, WS_W1 = 464 * MiB, WS_W2 = 976 * MiB;
constexpr size_t WS_H = 1488 * MiB, WS_QKV = 1616 * MiB, WS_O = 1936 * MiB, WS_Y = 2064 * MiB, WS_U = 2320 * MiB, WS_DILP = 2832 * MiB, WS_XB = 2976 * MiB, WS_END = 3104 * MiB;
static_assert(WS_DILST + (size_t)3 * M * 12 * 2 * 4 <= WS_WIN, "ws map");
constexpr int CW_BAR = 4096, CW_QUEUE = 16384;
constexpr int RING_OFF = 0, RING_BYTES = 131072, LDSCTL_OFF = RING_BYTES, MISC_OFF = LDSCTL_OFF + 320, LDS_BYTES = 147456;
constexpr int NWAVES = 8;

struct Frame {
    LAS unsigned char* lds; volatile LAS unsigned* MISC;
    int G;
};
__device__ __forceinline__ float wave_sum(float v) {
#pragma unroll
    for (int o = 1; o < 64; o <<= 1) v += __shfl_xor(v, o);
    return v;
}
__device__ __forceinline__ float bf2f(unsigned short b) { return __uint_as_float(((unsigned)b) << 16); }
struct XItem { const float* src; bf16* dst; int K, N; };
__device__ __forceinline__ void xitem_load(const XItem& it, f32x4 (&wv)[8], int lane) {
    const int lr = lane >> 3, lc = (lane & 7) * 4;
#pragma unroll
    for (int i = 0; i < 8; ++i) wv[i] = __builtin_nontemporal_load((const f32x4*)(it.src + (size_t)(16 * (i >> 1) + 2 * lr + (i & 1)) * it.N + lc));
}
__device__ __forceinline__ void xitem_finish(const XItem& it, const f32x4 (&wv)[8], LAS float* scr, int lane) {
    LAS unsigned* T = (LAS unsigned*)scr; const int lr = lane >> 3, lc = (lane & 7) * 4;
#pragma unroll
    for (int m = 0; m < 4; ++m) { const f32x4 a = wv[2 * m], b = wv[2 * m + 1]; const int kw = 8 * m + lr;
        T[(lc + 0) * 36 + kw] = pg8::cvt_pk_bf16(a.x, b.x); T[(lc + 1) * 36 + kw] = pg8::cvt_pk_bf16(a.y, b.y); T[(lc + 2) * 36 + kw] = pg8::cvt_pk_bf16(a.z, b.z); T[(lc + 3) * 36 + kw] = pg8::cvt_pk_bf16(a.w, b.w); }
    LDS_WAIT(); asm volatile("" ::: "memory");
    const int kq = lane & 7;
#pragma unroll
    for (int j = 0; j < 4; ++j) { const int n = (lane >> 3) + 8 * j; const v4u o = *(const LAS v4u*)(T + n * 36 + kq * 4);
        __builtin_nontemporal_store(o, (GAS v4u*)(it.dst + (size_t)n * it.K + 8 * kq)); }
    LDS_WAIT(); asm volatile("" ::: "memory");
}
__device__ __forceinline__ int t5_bucket_dev(int rel) {
    const int n = rel < 0 ? -rel : rel; int b;
    if (n < 8) b = n; else b = 8 + (n >= 15) + (n >= 27) + (n >= 50) + (n >= 91) + (n >= 166) + (n >= 305) + (n >= 559);
    return (rel > 0 ? 16 : 0) + b;
}

#ifndef PH_MASK
#define PH_MASK 0xFFF
#endif
#define ON(k) (((PH_MASK) >> (k)) & 1)
#define QKVH(head, row) (QKV + ((size_t)(head) * M + (size_t)(row)) * HDIM)
constexpr int I_IN = (DM / 64) * (NQKV / 32), I_OUT = (DM / 64) * (DM / 32), I_1 = (DM / 64) * (DFF / 32), I_2 = (DFF / 64) * (DM / 32), I_LAYER = I_IN + I_OUT + I_1 + I_2;
#ifndef CONV_IN_QUEUE
#define CONV_IN_QUEUE 1
#endif
constexpr int NCONV = 128, CONV_ITEMS = I_LAYER / NCONV;
static_assert(I_LAYER % NCONV == 0 && CONV_ITEMS % 16 == 0 && (I_LAYER - I_IN) % NCONV == 0 && ((I_LAYER - I_IN) / NCONV) % 16 == 0, "conversion chunking: whole chunks, an even item count per wave");
__device__ __forceinline__ XItem conv_item(int l, int r, const float* w_in, const float* w_out, const float* w_mlp_in, const float* w_mlp_out, bf16* WIN, bf16* WOUT, bf16* W1, bf16* W2) {
    const float* W; bf16* WT; int K, N;
    if (r < I_IN) { W = w_in + (size_t)l * DM * NQKV; WT = WIN + (size_t)l * NQKV * DM; K = DM; N = NQKV; }
    else if (r < I_IN + I_OUT) { r -= I_IN; W = w_out + (size_t)l * DM * DM; WT = WOUT + (size_t)l * DM * DM; K = DM; N = DM; }
    else if (r < I_IN + I_OUT + I_1) { r -= I_IN + I_OUT; W = w_mlp_in + (size_t)l * DM * DFF; WT = W1 + (size_t)l * DFF * DM; K = DM; N = DFF; }
    else { r -= I_IN + I_OUT + I_1; W = w_mlp_out + (size_t)l * DFF * DM; WT = W2 + (size_t)l * DM * DFF; K = DFF; N = DM; }
    const int nblk = N / 32, k0 = 64 * (r / nblk), n0 = 32 * (r % nblk);
    XItem it; it.src = W + (size_t)k0 * N + n0; it.dst = WT + (size_t)n0 * K + k0; it.K = K; it.N = N; return it;
}
__device__ __forceinline__ XItem conv_qitem(int l, int q, const float* w_in, const float* w_out, const float* w_mlp_in, const float* w_mlp_out, bf16* WIN, bf16* WOUT, bf16* W1, bf16* W2) {
    return (q < I_LAYER - I_IN) ? conv_item(l, q + I_IN, w_in, w_out, w_mlp_in, w_mlp_out, WIN, WOUT, W1, W2) : conv_item(l + 1, q - (I_LAYER - I_IN), w_in, w_out, w_mlp_in, w_mlp_out, WIN, WOUT, W1, W2);
}
template <bool QMAP> __device__ __forceinline__ void conv_run_t(int l, int first, int step, int end, const float* w_in, const float* w_out, const float* w_mlp_in, const float* w_mlp_out, bf16* WIN, bf16* WOUT, bf16* W1, bf16* W2, LAS float* scr, int lane) {
#define CI_(r) (QMAP ? conv_qitem(l, (r), w_in, w_out, w_mlp_in, w_mlp_out, WIN, WOUT, W1, W2) : conv_item(l, (r), w_in, w_out, w_mlp_in, w_mlp_out, WIN, WOUT, W1, W2))
    if (first >= end) return;
    f32x4 wa[8], wb[8], wc[8], wd[8];
    if ((((end - first) + step - 1) / step) & 1) { const XItem s = CI_(first); xitem_load(s, wa, lane); xitem_finish(s, wa, scr, lane); first += step; if (first >= end) return; }
    XItem a = CI_(first), b = CI_(first + step);
    xitem_load(a, wa, lane); xitem_load(b, wb, lane);
    for (int r = first; r < end; r += 4 * step) {
        const bool more = r + 2 * step < end;
        XItem c = a, d = b; if (more) { c = CI_(r + 2 * step); d = CI_(r + 3 * step); xitem_load(c, wc, lane); xitem_load(d, wd, lane); }
        xitem_finish(a, wa, scr, lane); xitem_finish(b, wb, scr, lane);
        if (!more) break;
        const bool more2 = r + 4 * step < end;
        if (more2) { a = CI_(r + 4 * step); b = CI_(r + 5 * step); xitem_load(a, wa, lane); xitem_load(b, wb, lane); }
        xitem_finish(c, wc, scr, lane); xitem_finish(d, wd, scr, lane);
        if (!more2) break;
    }
#undef CI_
}
struct Args { const float* in[14]; float* out; unsigned char* ws; };

__device__ __forceinline__ f32x4 ld_row4(const void* base, size_t row, int idx, bool is_bf) {
    if (is_bf) { const unsigned long long w = ((const unsigned long long*)((const bf16*)base + row * DM))[idx]; const unsigned lo = (unsigned)w, hi = (unsigned)(w >> 32);
        return (f32x4){__uint_as_float(lo << 16), __uint_as_float(lo & 0xffff0000u), __uint_as_float(hi << 16), __uint_as_float(hi & 0xffff0000u)}; }
    return ((const f32x4*)((const float*)base + row * DM))[idx];
}
template <bool HAS_Y>
__device__ __forceinline__ void norm_phase(Frame& F, const void* xin, bool xin_bf, const bf16* y, void* xout, bool xout_bf, bf16* h, const float* Gv, const float* Av, const float* Bv, int bstride) {
    int tid_ = threadIdx.x; asm volatile("" : "+v"(tid_)); const int tid = tid_, lane = tid & 63, wave = __builtin_amdgcn_readfirstlane(tid >> 6);
    LAS f32x4* Gs = (LAS f32x4*)(F.lds); LAS f32x4* As = (LAS f32x4*)(F.lds + 16384); LAS f32x4* Bs = (LAS f32x4*)(F.lds + 32768);
    for (int chunk = blockIdx.x; chunk < M / 64; chunk += F.G) {
        const int b = chunk / (SEQ / 64);
        __syncthreads();
        for (int i = tid; i < 1024; i += NWAVES * 64) { if (HAS_Y) Gs[i] = ((const f32x4*)(Gv + (size_t)b * bstride))[i]; if (h) { As[i] = ((const f32x4*)(Av + (size_t)b * bstride))[i]; Bs[i] = ((const f32x4*)(Bv + (size_t)b * bstride))[i]; } }
        __syncthreads();
        for (int rr = wave; rr < 64; rr += NWAVES) {
            const size_t row = (size_t)chunk * 64 + rr;
            f32x4 xv[16];
            if (HAS_Y) {
                f32x4 yv[16]; float ss = 0.f;
#pragma unroll
                for (int j = 0; j < 16; ++j) yv[j] = ld_row4(y, row, lane + 64 * j, true);
#pragma unroll
                for (int j = 0; j < 16; ++j) xv[j] = ld_row4(xin, row, lane + 64 * j, xin_bf);
#pragma unroll
                for (int j = 0; j < 16; ++j) { asm volatile("" : "+v"(xv[j]));
                    ss += (yv[j].x * yv[j].x + yv[j].y * yv[j].y) + (yv[j].z * yv[j].z + yv[j].w * yv[j].w); }
                const float ry = 1.0f / sqrtf(wave_sum(ss) * (1.0f / DM) + EPS);
#pragma unroll
                for (int j = 0; j < 16; ++j) { const f32x4 g = Gs[lane + 64 * j]; xv[j] = xv[j] + g * (yv[j] * ry); }
                if (xout_bf) { unsigned long long* xo = (unsigned long long*)((bf16*)xout + row * DM) + lane;
#pragma unroll
                    for (int j = 0; j < 16; ++j) xo[64 * j] = (unsigned long long)pg8::cvt_pk_bf16(xv[j].x, xv[j].y) | ((unsigned long long)pg8::cvt_pk_bf16(xv[j].z, xv[j].w) << 32);
                } else { f32x4* xo = (f32x4*)((float*)xout + row * DM) + lane;
#pragma unroll
                    for (int j = 0; j < 16; ++j) xo[64 * j] = xv[j]; }
            } else {
#pragma unroll
                for (int j = 0; j < 16; ++j) xv[j] = ld_row4(xin, row, lane + 64 * j, xin_bf);
            }
            if (h) {
                float ss = 0.f;
#pragma unroll
                for (int j = 0; j < 16; ++j) ss += (xv[j].x * xv[j].x + xv[j].y * xv[j].y) + (xv[j].z * xv[j].z + xv[j].w * xv[j].w);
                const float rx = 1.0f / sqrtf(wave_sum(ss) * (1.0f / DM) + EPS);
                unsigned long long* ho = (unsigned long long*)(h + row * DM) + lane;
#pragma unroll
                for (int j = 0; j < 16; ++j) { const f32x4 a = As[lane + 64 * j], bb = Bs[lane + 64 * j]; const f32x4 v = a * (xv[j] * rx) + bb;
                    ho[64 * j] = (unsigned long long)pg8::cvt_pk_bf16(v.x, v.y) | ((unsigned long long)pg8::cvt_pk_bf16(v.z, v.w) << 32); }
            }
        }
    }
}

__device__ __forceinline__ void norm_phase_bf(Frame& F, const bf16* xin, const bf16* y, void* xout, bool xout_bf, bf16* h, const float* Gv, const float* Av, const float* Bv, int bstride) {
    int tid_ = threadIdx.x; asm volatile("" : "+v"(tid_)); const int tid = tid_, lane = tid & 63, wave = __builtin_amdgcn_readfirstlane(tid >> 6);
    LAS f32x4* Gs = (LAS f32x4*)(F.lds); LAS f32x4* As = (LAS f32x4*)(F.lds + 16384); LAS f32x4* Bs = (LAS f32x4*)(F.lds + 32768);
    typedef unsigned long long u64;
#define NB_CVT(W) ((f32x4){__uint_as_float((unsigned)(W) << 16), __uint_as_float((unsigned)(W) & 0xffff0000u), __uint_as_float((unsigned)((W) >> 32) << 16), __uint_as_float((unsigned)((W) >> 32) & 0xffff0000u)})
#define NB_LOAD(YR, XR, ROW) do { _Pragma("unroll") for (int j = 0; j < 16; ++j) { YR[j] = ((const u64*)(y + (ROW) * DM))[lane + 64 * j]; XR[j] = ((const u64*)(xin + (ROW) * DM))[lane + 64 * j]; } } while (0)
#define NB_PIN(YR, XR) do { _Pragma("unroll") for (int j = 0; j < 16; ++j) { asm volatile("" : "+v"(YR[j])); asm volatile("" : "+v"(XR[j])); } } while (0)
#define NB_ROW(YR, XR, ROW) do { int lq = lane; asm volatile("" : "+v"(lq)); float ss = 0.f; f32x4 xv[16]; \
        _Pragma("unroll") for (int j = 0; j < 16; ++j) { const f32x4 yv = NB_CVT(YR[j]); ss += (yv.x * yv.x + yv.y * yv.y) + (yv.z * yv.z + yv.w * yv.w); } \
        const float ry = 1.0f / sqrtf(wave_sum(ss) * (1.0f / DM) + EPS); \
        _Pragma("unroll") for (int j = 0; j < 16; ++j) { const f32x4 g = Gs[lq + 64 * j]; xv[j] = NB_CVT(XR[j]) + g * (NB_CVT(YR[j]) * ry); } \
        if (xout_bf) { u64* xo = (u64*)((bf16*)xout + (ROW) * DM) + lane; \
            _Pragma("unroll") for (int j = 0; j < 16; ++j) xo[64 * j] = (u64)pg8::cvt_pk_bf16(xv[j].x, xv[j].y) | ((u64)pg8::cvt_pk_bf16(xv[j].z, xv[j].w) << 32); \
        } else { f32x4* xo = (f32x4*)((float*)xout + (ROW) * DM) + lane; \
            _Pragma("unroll") for (int j = 0; j < 16; ++j) xo[64 * j] = xv[j]; } \
        if (h) { float s2 = 0.f; \
            _Pragma("unroll") for (int j = 0; j < 16; ++j) s2 += (xv[j].x * xv[j].x + xv[j].y * xv[j].y) + (xv[j].z * xv[j].z + xv[j].w * xv[j].w); \
            const float rx = 1.0f / sqrtf(wave_sum(s2) * (1.0f / DM) + EPS); \
            u64* ho = (u64*)(h + (ROW) * DM) + lane; \
            _Pragma("unroll") for (int j = 0; j < 16; ++j) { const f32x4 a = As[lq + 64 * j], bb = Bs[lq + 64 * j]; const f32x4 v = a * (xv[j] * rx) + bb; \
                ho[64 * j] = (u64)pg8::cvt_pk_bf16(v.x, v.y) | ((u64)pg8::cvt_pk_bf16(v.z, v.w) << 32); } } } while (0)
    for (int chunk = blockIdx.x; chunk < M / 64; chunk += F.G) {
        const int b = chunk / (SEQ / 64);
        const size_t row0 = (size_t)chunk * 64 + wave;
        u64 yA[16], xA[16], yB[16], xB[16];
        NB_LOAD(yA, xA, row0);
        __syncthreads();
        for (int i = tid; i < 1024; i += NWAVES * 64) { Gs[i] = ((const f32x4*)(Gv + (size_t)b * bstride))[i]; if (h) { As[i] = ((const f32x4*)(Av + (size_t)b * bstride))[i]; Bs[i] = ((const f32x4*)(Bv + (size_t)b * bstride))[i]; } }
        __syncthreads();
#pragma unroll 1
        for (int it = 0; it < 4; ++it) {
            const size_t ra = row0 + 16 * it, rb = ra + 8;
            NB_LOAD(yB, xB, rb); NB_PIN(yA, xA);
            NB_ROW(yA, xA, ra);
            if (it < 3) { NB_LOAD(yA, xA, rb + 8); }
            NB_PIN(yB, xB);
            NB_ROW(yB, xB, rb);
        }
    }
#undef NB_CVT
#undef NB_LOAD
#undef NB_PIN
#undef NB_ROW
}

typedef __attribute__((address_space(4))) const unsigned char ckb_t;
__device__ __forceinline__ const void* karg(int i) { ckb_t* kp = (ckb_t*)__builtin_amdgcn_kernarg_segment_ptr(); asm volatile("" : "+s"(kp)); return *(const void* const __attribute__((address_space(4)))*)(kp + 8 * i); }
#define KIN(i) ((const float*)karg(i))
#define KOUT() ((float*)karg(14))
#define KWS() ((unsigned char*)karg(15))
__global__ void __launch_bounds__(NWAVES * 64, 2) mega_fwd(Args args_unused) {
    extern __shared__ __attribute__((aligned(16))) unsigned char lds[];
    Frame F;
    F.lds = (LAS unsigned char*)lds; F.MISC = (volatile LAS unsigned*)(F.lds + MISC_OFF); F.G = gridDim.x;
    for (int u = threadIdx.x; u < (LDS_BYTES - LDSCTL_OFF) / 4; u += NWAVES * 64) ((LAS unsigned*)(F.lds + LDSCTL_OFF))[u] = 0u;
    __syncthreads();
    (void)xcd_barrier_post((unsigned*)((gu32*)(KWS() + WS_CTL) + CW_BAR), F.MISC + 8);
#define GRID_BAR() do { XcdBarrier bar_; bar_.bar = (unsigned*)((gu32*)(KWS() + WS_CTL) + CW_BAR); bar_.x = xb_xcc_id(); bar_.st = (volatile LAS unsigned*)(F.lds + MISC_OFF) + 8; xcd_barrier(bar_); } while (0)
#define FRESH_IDS() int tid_ = threadIdx.x; asm volatile("" : "+v"(tid_)); const int ftid = tid_, flane = ftid & 63, fwave = __builtin_amdgcn_readfirstlane(ftid >> 6); \
    const int gw = blockIdx.x * NWAVES + fwave, NGW = F.G * NWAVES, gtid = blockIdx.x * (NWAVES * 64) + ftid, NGT = F.G * NWAVES * 64; (void)flane; (void)gw; (void)NGW; (void)gtid; (void)NGT
#define WSP(T, off) ((T*)(ws + (off)))
#ifndef DUP_GEMM
#define DUP_GEMM 0
#endif
#ifndef XBF16
#define XBF16 1
#endif
#ifndef DUP_NORM
#define DUP_NORM 0
#endif
#ifndef DUP_P0C
#define DUP_P0C 0
#endif
#ifndef XBAR
#define XBAR 0
#endif
#ifndef DUP_G0
#define DUP_G0 0
#endif
#ifndef DUP_G1
#define DUP_G1 0
#endif
#ifndef DUP_G2
#define DUP_G2 0
#endif
#ifndef DUP_G3
#define DUP_G3 0
#endif
#ifndef DUP_NA
#define DUP_NA 0
#endif
#ifndef DUP_DIL
#define DUP_DIL 0
#endif
#ifndef DUP_GQA
#define DUP_GQA 0
#endif
#ifndef DUP_ATT
#define DUP_ATT 0
#endif
#ifndef DUP_P0A
#define DUP_P0A 0
#endif
#ifndef DUPBAR
#define DUPBAR 0
#endif
#define REPBAR() do { if (DUPBAR && rep_ > 0) GRID_BAR(); } while (0)
#define REPEAT(n) for (int rep_ = 0, nrep_ = __builtin_amdgcn_readfirstlane(1 + (n)); rep_ < nrep_; ++rep_)

    if (ON(0)) REPEAT(DUP_P0A)
    {
        FRESH_IDS(); unsigned char* ws = KWS(); const float* in_c = KIN(1); const float* ada_w = KIN(2); float* MODP = WSP(float, WS_MODP);
        for (int task = gw; task < 96 * 16; task += NGW) {
            const int cg = task % 96, kc = task / 96; const int col = cg * 256 + flane * 4;
            f32x4 a0 = {0.f, 0.f, 0.f, 0.f}, a1 = {0.f, 0.f, 0.f, 0.f};
            const float* wp = ada_w + (size_t)(kc * 256) * (NMOD * DM) + col;
#pragma unroll 8
            for (int k = 0; k < 256; ++k) {
                const f32x4 w = *(const f32x4*)(wp + (size_t)k * (NMOD * DM));
                const float c0 = in_c[kc * 256 + k], c1 = in_c[DM + kc * 256 + k];
                const float s0 = c0 / (1.0f + __expf(-c0)), s1 = c1 / (1.0f + __expf(-c1));
                a0 = a0 + w * s0; a1 = a1 + w * s1;
            }
            *(f32x4*)(MODP + ((size_t)(kc * 2 + 0) * (NMOD * DM)) + col) = a0;
            *(f32x4*)(MODP + ((size_t)(kc * 2 + 1) * (NMOD * DM)) + col) = a1;
        }
        LAS float* scr = (LAS float*)(F.lds + RING_OFF + fwave * 16384);
        const float* w_in = KIN(6); const float* w_out = KIN(7); const float* w_mlp_in = KIN(12); const float* w_mlp_out = KIN(13);
        bf16* WIN = WSP(bf16, WS_WIN); bf16* WOUT = WSP(bf16, WS_WOUT); bf16* W1 = WSP(bf16, WS_W1); bf16* W2 = WSP(bf16, WS_W2);
        if (CONV_IN_QUEUE) conv_run_t<false>(0, gw, NGW, I_IN, w_in, w_out, w_mlp_in, w_mlp_out, WIN, WOUT, W1, W2, scr, flane);
        else for (int cl_ = 0; cl_ < DEPTH; ++cl_) conv_run_t<false>(cl_, gw, NGW, I_LAYER, w_in, w_out, w_mlp_in, w_mlp_out, WIN, WOUT, W1, W2, scr, flane);
    }
    GRID_BAR();
    if (ON(1))
    {
        FRESH_IDS(); unsigned char* ws = KWS(); const float* ada_b = KIN(3); const float* ada_emb = KIN(4); const float* gains = KIN(5); const float* t5_table = KIN(11);
        float* MODP = WSP(float, WS_MODP); float* MODV = WSP(float, WS_MODV); float* ROPE = WSP(float, WS_ROPE); float* DILTB = WSP(float, WS_DILTB);
        for (int i = gtid; i < DEPTH * 2 * NMOD * DM; i += NGT) {
            const int col = i % DM, j = (i / DM) % NMOD, b = (i / (DM * NMOD)) % 2, l = i / (DM * NMOD * 2);
            float m = ada_b[j * DM + col];
#pragma unroll
            for (int kc = 0; kc < 16; ++kc) m += MODP[(size_t)(kc * 2 + b) * (NMOD * DM) + j * DM + col];
            m += ada_emb[((size_t)l * NMOD + j) * DM + col];
            const float* gl = gains + (size_t)l * 4 * DM;
            float v;
            if (j == 0) v = m; else if (j == 1) v = gl[0 * DM + col] * (1.0f + m); else if (j == 2) v = m * gl[1 * DM + col];
            else if (j == 3) v = m; else if (j == 4) v = gl[2 * DM + col] * (1.0f + m); else v = m * gl[3 * DM + col];
            MODV[i] = v;
        }
        if (blockIdx.x == 0 && ftid < 32) {
            const int f = ftid; const double th = (double)__builtin_amdgcn_exp2f(-(float)f * 0.41524101186092029f);
            double c1 = 1.0, s1 = th, tc = 1.0, ts = th; const double x2 = th * th;
            for (int n = 1; n <= 12; ++n) { tc *= -x2 / (double)((2 * n - 1) * (2 * n)); ts *= -x2 / (double)((2 * n) * (2 * n + 1)); c1 += tc; s1 += ts; }
            double c = 1.0, s = 0.0;
            for (int pos = 0; pos < 128; ++pos) { ROPE[pos * 32 + f] = (float)c; ROPE[4096 + pos * 32 + f] = (float)s; const double cn = c * c1 - s * s1; s = s * c1 + c * s1; c = cn; }
        }
        if (blockIdx.x == 1 || F.G == 1) {
            for (int i = ftid; i < 3 * H_DIL * 129; i += NWAVES * 64) { const int p = i / (H_DIL * 129), hh = (i / 129) % H_DIL, jj = i % 129 - 64; const int d = p == 0 ? 1 : (p == 1 ? 4 : 16);
                DILTB[i] = t5_table[t5_bucket_dev(jj * d) * H_DIL + hh]; }
        }
    }
    GRID_BAR();
    if (ON(2))
    REPEAT(DUP_P0C) { unsigned char* ws = KWS(); float* MODV = WSP(float, WS_MODV);
      norm_phase<false>(F, KIN(0), false, nullptr, nullptr, false, WSP(bf16, WS_H), nullptr, MODV + 1 * DM, MODV + 0 * DM, NMOD * DM); }
    GRID_BAR();

    for (int l = 0; l < DEPTH; ++l) {
        for (int xb_ = 0; xb_ < XBAR; ++xb_) GRID_BAR();
    if (ON(3)) REPEAT(DUP_GEMM + DUP_G0)
        {
            REPBAR();
            unsigned char* ws = KWS();
            pg8::Gemm g{WSP(bf16, WS_H), WSP(bf16, WS_WIN) + (size_t)l * NQKV * DM, M, NQKV, DM}; pg8::StaticOrder S; S.init(M, NQKV, F.G, (int)blockIdx.x);
            pg8::EpiQKV E{WSP(bf16, WS_QKV), M};
            pg8::gemm_phase<pg8::EpiQKV, pg8::StaticOrder, true, true>(F.lds + RING_OFF, g, S, E);
        }
        GRID_BAR();
    if (ON(4))
        {
            FRESH_IDS(); const int i16 = ftid & 15; const int g16 = gtid >> 4, NG16 = NGT >> 4;
            unsigned char* ws = KWS(); bf16* QKV = WSP(bf16, WS_QKV); const float* ROPE = WSP(float, WS_ROPE); const float* q_gain = KIN(8); const float* k_gain = KIN(9);
            for (int task = g16; task < KV_GQA * (M / 8); task += NG16) {
                const int hh = task >> 11, row0 = (task & (M / 8 - 1)) * 8;
                const int head = K_GQA / HDIM + hh;
                const float* gp = k_gain + l * HDIM + 8 * i16;
                bf16* p = QKVH(head, row0) + 8 * i16;
                const int jj = i16 & 7, fb = 8 * (jj & 3);
                v4u raw[8]; f32x4 c0[8], c1[8], s0[8], s1[8];
#pragma unroll
                for (int k = 0; k < 8; ++k) raw[k] = *(const v4u*)(p + (size_t)k * HDIM);
                const f32x4 g0 = *(const f32x4*)gp, g1 = *(const f32x4*)(gp + 4);
#pragma unroll
                for (int k = 0; k < 8; ++k) { const int t = (row0 + k) & (SEQ - 1); const int pos = (i16 < 8) ? (t >> 6) : (t & 63); const float* rp = ROPE + pos * 32 + fb;
                    c0[k] = *(const f32x4*)rp; c1[k] = *(const f32x4*)(rp + 4); s0[k] = *(const f32x4*)(rp + 4096); s1[k] = *(const f32x4*)(rp + 4100); }
#pragma unroll
                for (int k = 0; k < 8; ++k) {
                    float x[8];
                    x[0] = __uint_as_float(raw[k].x << 16); x[1] = __uint_as_float(raw[k].x & 0xffff0000u); x[2] = __uint_as_float(raw[k].y << 16); x[3] = __uint_as_float(raw[k].y & 0xffff0000u);
                    x[4] = __uint_as_float(raw[k].z << 16); x[5] = __uint_as_float(raw[k].z & 0xffff0000u); x[6] = __uint_as_float(raw[k].w << 16); x[7] = __uint_as_float(raw[k].w & 0xffff0000u);
                    float ss = 0.f;
#pragma unroll
                    for (int e = 0; e < 8; ++e) ss += x[e] * x[e];
                    ss += __shfl_xor(ss, 1); ss += __shfl_xor(ss, 2); ss += __shfl_xor(ss, 4); ss += __shfl_xor(ss, 8);
                    const float rstd = 1.0f / sqrtf(ss * (1.0f / HDIM) + EPS);
                    x[0] *= rstd * g0.x; x[1] *= rstd * g0.y; x[2] *= rstd * g0.z; x[3] *= rstd * g0.w; x[4] *= rstd * g1.x; x[5] *= rstd * g1.y; x[6] *= rstd * g1.z; x[7] *= rstd * g1.w;
                    const float cs[8] = {c0[k].x, c0[k].y, c0[k].z, c0[k].w, c1[k].x, c1[k].y, c1[k].z, c1[k].w}; const float sn[8] = {s0[k].x, s0[k].y, s0[k].z, s0[k].w, s1[k].x, s1[k].y, s1[k].z, s1[k].w};
                    float o[8];
#pragma unroll
                    for (int e = 0; e < 8; ++e) { const float pv = __shfl_xor(x[e], 4); o[e] = (jj < 4) ? (x[e] * cs[e] - pv * sn[e]) : (pv * sn[e] + x[e] * cs[e]); }
                    v4u w; w.x = pg8::cvt_pk_bf16(o[0], o[1]); w.y = pg8::cvt_pk_bf16(o[2], o[3]); w.z = pg8::cvt_pk_bf16(o[4], o[5]); w.w = pg8::cvt_pk_bf16(o[6], o[7]);
                    *(v4u*)(p + (size_t)k * HDIM) = w;
                }
            }
        }
    if (ON(5))
        {
            char* alds = (char*)lds + RING_OFF;
            (void)alds;
        }
        GRID_BAR();
    if (ON(5)) REPEAT(DUP_ATT)
        {
            char* alds = (char*)lds + RING_OFF;
            { unsigned char* ws = KWS(); bf16* QKV = WSP(bf16, WS_QKV); bf16* O = WSP(bf16, WS_O); const float* na_rpb = KIN(10);
              bf16* DILP = WSP(bf16, WS_DILP); float* DILST = WSP(float, WS_DILST); const float* DILTB = WSP(float, WS_DILTB);
              gu32* qhead = (gu32*)(ws + WS_CTL) + CW_QUEUE + 64 * l; volatile LAS unsigned* qslot = (volatile LAS unsigned*)(F.lds + MISC_OFF) + 16;
              const int nconv = CONV_IN_QUEUE ? NCONV : 0;
              bool gqa_fast;
              { int tid_ = threadIdx.x; asm volatile("" : "+v"(tid_)); const int gl = tid_ & 63; const float* qgp = KIN(8) + l * HDIM; const float* kgp = KIN(9) + l * HDIM;
                const bool small = fabsf(qgp[gl]) <= 1.96f && fabsf(qgp[gl + 64]) <= 1.96f && fabsf(kgp[gl]) <= 1.96f && fabsf(kgp[gl + 64]) <= 1.96f;
                gqa_fast = __all(small) != 0; }
              unsigned nx_ = 0u; if (threadIdx.x == 0) nx_ = __hip_atomic_fetch_add(qhead, 1u, RLX_AGENT);
              for (int guard_ = 0; guard_ < 4096; ++guard_) {
                __syncthreads();
                if (threadIdx.x == 0) qslot[0] = nx_;
                __syncthreads();
                const int uq = (int)__builtin_amdgcn_readfirstlane(qslot[0]);
                if (uq >= 768 + nconv + 2816) break;
                if (threadIdx.x == 0) nx_ = __hip_atomic_fetch_add(qhead, 1u, RLX_AGENT);
                int u;
                if (uq < 768 + nconv) {
                    if (nconv && uq % 7 == 6) {
                        int tid_ = threadIdx.x; asm volatile("" : "+v"(tid_)); const int cl = tid_ & 63, cw = __builtin_amdgcn_readfirstlane(tid_ >> 6);
                        LAS float* scr = (LAS float*)(F.lds + RING_OFF + cw * 16384); const int citems = (l + 1 < DEPTH) ? CONV_ITEMS : (I_LAYER - I_IN) / NCONV, c0 = (uq / 7) * citems;
                        const float* w_in = KIN(6); const float* w_out = KIN(7); const float* w_mlp_in = KIN(12); const float* w_mlp_out = KIN(13);
                        conv_run_t<true>(l, c0 + cw, NWAVES, c0 + citems, w_in, w_out, w_mlp_in, w_mlp_out, WSP(bf16, WS_WIN), WSP(bf16, WS_WOUT), WSP(bf16, WS_W1), WSP(bf16, WS_W2), scr, cl);
                        continue;
                    }
                    u = nconv ? uq - uq / 7 : uq;
                } else u = uq - nconv;
                if (u < 768) {
                    const int grp = u / 96, within = u % 96; const int b = grp >> 2, kvh = grp & 3, hq = kvh * 3 + within / 32, qb = within % 32;
                    const size_t r0 = (size_t)b * SEQ + (size_t)qb * 256;
                    if (gqa_fast) att::attn_unit<0, true>(QKVH(Q_GQA / HDIM + hq, r0), HDIM, QKVH(K_GQA / HDIM + kvh, (size_t)b * SEQ), QKVH(V_GQA / HDIM + kvh, (size_t)b * SEQ), HDIM,
                                      0, SEQ / 64, SEQ / 64, O + r0 * DM + O_GQA + hq * HDIM, DM, nullptr, 0, 0, nullptr, 0, alds, KIN(8) + l * HDIM, WSP(float, WS_ROPE), qb * 256);
                    else att::attn_unit<0, false>(QKVH(Q_GQA / HDIM + hq, r0), HDIM, QKVH(K_GQA / HDIM + kvh, (size_t)b * SEQ), QKVH(V_GQA / HDIM + kvh, (size_t)b * SEQ), HDIM,
                                      0, SEQ / 64, SEQ / 64, O + r0 * DM + O_GQA + hq * HDIM, DM, nullptr, 0, 0, nullptr, 0, alds, KIN(8) + l * HDIM, WSP(float, WS_ROPE), qb * 256);
                    continue;
                }
                if (u < 768 + 512) {
                    const int un = u - 768; const int b = un >> 8, hh = (un >> 5) & 7, qb = un & 31; const size_t r0 = (size_t)b * SEQ + (size_t)qb * 256;
                    att::attn_unit<1>(QKVH(Q_NA / HDIM + hh, r0), HDIM, QKVH(K_NA / HDIM + hh, (size_t)b * SEQ), QKVH(V_NA / HDIM + hh, (size_t)b * SEQ), HDIM,
                                      qb * 4 - 4, 12, SEQ / 64, O + r0 * DM + O_NA + hh * HDIM, DM, nullptr, 0, qb * 4, na_rpb + ((size_t)l * H_NA + hh) * 465, 465, alds);
                } else {
                    const int v = u - 768 - 512, p = v / 768, w = v % 768, pair = w >> 5, b = pair / H_DIL, hh = pair % H_DIL, blk = w & 31;
                    const int d = p == 0 ? 1 : (p == 1 ? 4 : 16), nub = 32 / d, res = blk / nub, ub = blk % nub, u0 = ub * 256, L = SEQ / d;
                    const size_t rq = (size_t)b * SEQ + (size_t)u0 * d + res, rk = (size_t)b * SEQ + res;
                    att::attn_unit<2>(QKVH(Q_DIL / HDIM + hh, rq), (long)d * HDIM, QKVH(K_DIL / HDIM + hh, rk), QKVH(V_DIL / HDIM + hh, rk), (long)d * HDIM,
                                      u0 / 64 - 1, 6, L / 64, DILP + (size_t)p * M * DILW + rq * DILW + hh * HDIM, (long)d * DILW,
                                      DILST + (((size_t)p * M + rq) * H_DIL + hh) * 2, (long)d * H_DIL * 2, u0, DILTB + (p * H_DIL + hh) * 129, 129, alds);
                }
              } }
        }
        GRID_BAR();
    if (ON(6))
        {
            FRESH_IDS(); const int i16 = ftid & 15; const int g16 = gtid >> 4, NG16 = NGT >> 4;
            unsigned char* ws = KWS(); bf16* O = WSP(bf16, WS_O); const bf16* DILP = WSP(bf16, WS_DILP); const float* DILST = WSP(float, WS_DILST);
            typedef float f32x2v __attribute__((ext_vector_type(2)));
            for (int task0 = g16; task0 < M * H_DIL; task0 += 8 * NG16) {
                f32x2v st[8][3]; v4u raw[8][3];
#pragma unroll
                for (int k = 0; k < 8; ++k) { const int task = task0 + k * NG16; const bool on = task < M * H_DIL; const int tt = on ? task : task0; const int row = tt / H_DIL, hh = tt % H_DIL;
#pragma unroll
                    for (int p = 0; p < 3; ++p) { st[k][p] = *(const f32x2v*)(DILST + (((size_t)p * M + row) * H_DIL + hh) * 2); raw[k][p] = *(const v4u*)(DILP + (size_t)p * M * DILW + (size_t)row * DILW + hh * HDIM + 8 * i16); } }
#pragma unroll
                for (int k = 0; k < 8; ++k) { const int task = task0 + k * NG16; if (task < M * H_DIL) { const int row = task / H_DIL, hh = task % H_DIL;
                    const float mx = fmaxf(st[k][0].x, fmaxf(st[k][1].x, st[k][2].x));
                    float wv[3]; float wsum = 0.f;
#pragma unroll
                    for (int p = 0; p < 3; ++p) { wv[p] = st[k][p].y * __builtin_amdgcn_exp2f(st[k][p].x - mx); wsum += wv[p]; }
                    const float inv = 1.0f / wsum;
                    float acc[8] = {0.f, 0.f, 0.f, 0.f, 0.f, 0.f, 0.f, 0.f};
#pragma unroll
                    for (int p = 0; p < 3; ++p) { const v4u r = raw[k][p]; const float wp = wv[p] * inv;
                        acc[0] += wp * __uint_as_float(r.x << 16); acc[1] += wp * __uint_as_float(r.x & 0xffff0000u); acc[2] += wp * __uint_as_float(r.y << 16); acc[3] += wp * __uint_as_float(r.y & 0xffff0000u);
                        acc[4] += wp * __uint_as_float(r.z << 16); acc[5] += wp * __uint_as_float(r.z & 0xffff0000u); acc[6] += wp * __uint_as_float(r.w << 16); acc[7] += wp * __uint_as_float(r.w & 0xffff0000u); }
                    v4u w; w.x = pg8::cvt_pk_bf16(acc[0], acc[1]); w.y = pg8::cvt_pk_bf16(acc[2], acc[3]); w.z = pg8::cvt_pk_bf16(acc[4], acc[5]); w.w = pg8::cvt_pk_bf16(acc[6], acc[7]);
                    *(v4u*)(O + (size_t)row * DM + O_DIL + hh * HDIM + 8 * i16) = w; } }
            }
        }
        GRID_BAR();
    if (ON(7)) REPEAT(DUP_GEMM + DUP_G1)
        {
            REPBAR();
            unsigned char* ws = KWS();
            pg8::Gemm g{WSP(bf16, WS_O), WSP(bf16, WS_WOUT) + (size_t)l * DM * DM, M, DM, DM}; pg8::StaticOrder S; S.init(M, DM, F.G, (int)blockIdx.x);
            pg8::EpiBf16<0> E{WSP(bf16, WS_Y), DM};
            pg8::gemm_phase<pg8::EpiBf16<0>, pg8::StaticOrder, true, true>(F.lds + RING_OFF, g, S, E);
        }
        GRID_BAR();
    if (ON(8))
        { unsigned char* ws = KWS(); const float* mv = WSP(float, WS_MODV) + (size_t)l * 2 * NMOD * DM;
#if DUP_NORM
          norm_phase<true>(F, l == 0 ? (const void*)KIN(0) : (const void*)KOUT(), false, WSP(bf16, WS_Y), WSP(float, WS_U), false, WSP(bf16, WS_U + 256 * MiB), mv + 2 * DM, mv + 4 * DM, mv + 3 * DM, NMOD * DM);
#endif
#if XBF16
          if (l == 0) norm_phase<true>(F, (const void*)KIN(0), false, WSP(bf16, WS_Y), WSP(bf16, WS_XB), true, WSP(bf16, WS_H), mv + 2 * DM, mv + 4 * DM, mv + 3 * DM, NMOD * DM);
          else norm_phase_bf(F, WSP(bf16, WS_XB), WSP(bf16, WS_Y), WSP(bf16, WS_XB), true, WSP(bf16, WS_H), mv + 2 * DM, mv + 4 * DM, mv + 3 * DM, NMOD * DM); }
#else
          norm_phase<true>(F, l == 0 ? (const void*)KIN(0) : (const void*)KOUT(), false, WSP(bf16, WS_Y), KOUT(), false, WSP(bf16, WS_H), mv + 2 * DM, mv + 4 * DM, mv + 3 * DM, NMOD * DM); }
#endif
        GRID_BAR();
    if (ON(9)) REPEAT(DUP_GEMM + DUP_G2)
        {
            REPBAR();
            unsigned char* ws = KWS();
            pg8::Gemm g{WSP(bf16, WS_H), WSP(bf16, WS_W1) + (size_t)l * DFF * DM, M, DFF, DM}; pg8::StaticOrder S; S.init(M, DFF, F.G, (int)blockIdx.x);
            pg8::EpiBf16<3> E{WSP(bf16, WS_U), DFF};
            pg8::gemm_phase<pg8::EpiBf16<3>, pg8::StaticOrder, true, true>(F.lds + RING_OFF, g, S, E);
        }
        GRID_BAR();
    if (ON(10)) REPEAT(DUP_GEMM + DUP_G3)
        {
            REPBAR();
            unsigned char* ws = KWS();
            pg8::Gemm g{WSP(bf16, WS_U), WSP(bf16, WS_W2) + (size_t)l * DM * DFF, M, DM, DFF}; pg8::StaticOrder S; S.init(M, DM, F.G, (int)blockIdx.x);
            pg8::EpiBf16<0> E{WSP(bf16, WS_Y), DM};
            pg8::gemm_phase<pg8::EpiBf16<0>, pg8::StaticOrder, true, true>(F.lds + RING_OFF, g, S, E);
        }
        GRID_BAR();
    if (ON(11))
        {
            unsigned char* ws = KWS(); const float* mv = WSP(float, WS_MODV) + (size_t)l * 2 * NMOD * DM; float* out = KOUT();
            const float* mvn = WSP(float, WS_MODV) + (size_t)(l + 1 < DEPTH ? l + 1 : l) * 2 * NMOD * DM;
#if XBF16
            norm_phase_bf(F, WSP(bf16, WS_XB), WSP(bf16, WS_Y), (l + 1 < DEPTH) ? (void*)WSP(bf16, WS_XB) : (void*)out, l + 1 < DEPTH, (l + 1 < DEPTH) ? WSP(bf16, WS_H) : (bf16*)nullptr, mv + 5 * DM, mvn + 1 * DM, mvn + 0 * DM, NMOD * DM);
#else
            norm_phase<true>(F, out, false, WSP(bf16, WS_Y), out, false, (l + 1 < DEPTH) ? WSP(bf16, WS_H) : (bf16*)nullptr, mv + 5 * DM, mvn + 1 * DM, mvn + 0 * DM, NMOD * DM);
#endif
        }
        if (l + 1 < DEPTH) GRID_BAR();
    }
    __syncthreads();
    if (__hip_atomic_load((gu32*)(KWS() + WS_CTL) + CW_BAR + XB_TMO, RLX_AGENT) != 0u) {
        const float q = __builtin_nanf(""); float* out = KOUT();
        for (int chunk = blockIdx.x; chunk < M / 64; chunk += F.G) for (int i = threadIdx.x; i < 64 * DM / 4; i += NWAVES * 64) ((f32x4*)(out + (size_t)chunk * 64 * DM))[i] = (f32x4){q, q, q, q};
    }
}

extern "C" void kernel_launch(void* const* d_in, const int* in_sizes, int n_in, void* d_out, int out_size, void* d_ws, size_t ws_size, hipStream_t stream) {
    static int grid = 0;
    if (grid == 0) {
        if (n_in != 14 || in_sizes[0] != M * DM || out_size != M * DM || ws_size < WS_END) { fprintf(stderr, "kernel_launch: shape/workspace mismatch (n_in %d, in0 %d, out %d, ws %zu, need %zu)\n", n_in, n_in > 0 ? in_sizes[0] : -1, out_size, ws_size, (size_t)WS_END); grid = -1; return; }
        int dev = 0, cus = 0, per_cu = 0;
        if (hipGetDevice(&dev) != hipSuccess || hipDeviceGetAttribute(&cus, hipDeviceAttributeMultiprocessorCount, dev) != hipSuccess) { grid = -1; return; }
        if (hipFuncSetAttribute((const void*)mega_fwd, hipFuncAttributeMaxDynamicSharedMemorySize, LDS_BYTES) != hipSuccess) { fprintf(stderr, "kernel_launch: hipFuncSetAttribute failed\n"); grid = -1; return; }
        if (hipOccupancyMaxActiveBlocksPerMultiprocessor(&per_cu, (const void*)mega_fwd, NWAVES * 64, LDS_BYTES) != hipSuccess || per_cu < 1) { fprintf(stderr, "kernel_launch: occupancy query reports %d blocks per CU\n", per_cu); }
        (void)hipGetLastError();
        grid = cus;
    }
    if (grid < 0) return;
    if (hipMemsetAsync((char*)d_ws + WS_CTL, 0, CTL_ZERO_BYTES, stream) != hipSuccess) return;
    Args a{};
    for (int i = 0; i < 14; ++i) a.in[i] = (const float*)d_in[i];
    a.out = (float*)d_out; a.ws = (unsigned char*)d_ws;
    hipLaunchKernelGGL(mega_fwd, dim3(grid), dim3(NWAVES * 64), LDS_BYTES, stream, a);
    const hipError_t le = hipPeekAtLastError();
    if (le != hipSuccess) fprintf(stderr, "kernel_launch: launch failed: %s\n", hipGetErrorName(le));
}
```
